# Optimizing an MI355X kernel written in HIP

```python
import math
import jax, jax.numpy as jnp
from jax import lax
import numpy as np

D_MODEL = 2048
BATCH = 8
SEQ = 2048
DEPTH = 2

GRID_W = 64
CTX_LEN = 256
N_EVEN = (DEPTH + 1) // 2
N_ODD = DEPTH // 2
EPS = 1e-6
N_MOD = 6
D_FF = 4 * D_MODEL

HEAD_DIM = 128
NA_HEADS = 8
NA_WIDTH = NA_HEADS * HEAD_DIM
NA_KR = 8
NA_KC = 16
LRU_WIDTH = D_MODEL - NA_WIDTH
LRU_BLOCKS = 8
LRU_BLOCK = LRU_WIDTH // LRU_BLOCKS
LRU_C = 8.0
CONV_W = 4
CONV_PAD_LO = 2
AB_IN = 3 * NA_WIDTH + 2 * LRU_WIDTH
MIX_WIDTH = NA_WIDTH + LRU_WIDTH

MLA_HEADS = 16
Q_LORA = 512
KV_LORA = 512
NOPE_DIM = 128
ROPE_DIM = 64
V_DIM = 128
ROPE_BASE = 10000.0
Q_BLOCK = 128
NEG_INF = -1e30

kernel_name = "hybrid_natten_rglru_mla_prefix_dit"


def rms_norm(x, gain):
    x32 = x.astype(jnp.float32)
    y = x32 * lax.rsqrt(jnp.mean(jnp.square(x32), axis=-1, keepdims=True) + EPS)
    return (y * gain.astype(jnp.float32)).astype(x.dtype)


def modulate(h, shift, scale):
    return h * (1.0 + scale) + shift


def split_heads(t, n_heads):
    b, n, _ = t.shape
    return t.reshape(b, n, n_heads, -1).transpose(0, 2, 1, 3)


def merge_heads(t):
    b, h, n, d = t.shape
    return t.transpose(0, 2, 1, 3).reshape(b, n, h * d)


def softmax_attend(q, k, v, scale):
    s = jnp.einsum("bhqd,bhkd->bhqk", q, k).astype(jnp.float32) * scale
    p = jax.nn.softmax(s, axis=-1).astype(v.dtype)
    return jnp.einsum("bhqk,bhkd->bhqd", p, v)


def blocked_attend(q, k, v, scale):
    b, h, n, d = q.shape
    nb = n // Q_BLOCK
    qb = q.reshape(b, h, nb, Q_BLOCK, d).transpose(2, 0, 1, 3, 4)
    ob = lax.map(lambda qi: softmax_attend(qi, k, v, scale), qb)
    return ob.transpose(1, 2, 0, 3, 4).reshape(b, h, n, -1)


def squared_relu_mlp(h, w1, w2):
    return jnp.square(jax.nn.relu(h @ w1)) @ w2


def rope_tables(n):
    pos = jnp.arange(n)
    row = (pos // GRID_W).astype(jnp.float32)
    col = (pos % GRID_W).astype(jnp.float32)
    axis_dim = ROPE_DIM // 2
    inv = jnp.power(ROPE_BASE, -jnp.arange(0, axis_dim, 2, dtype=jnp.float32) / axis_dim)
    ang = jnp.stack([row[:, None] * inv, col[:, None] * inv], axis=1)
    return jnp.cos(ang), jnp.sin(ang)


def apply_rope(t, cos, sin):
    t32 = t.astype(jnp.float32).reshape(t.shape[:-1] + (2, 2, ROPE_DIM // 4))
    x1, x2 = t32[..., 0, :], t32[..., 1, :]
    out = jnp.stack([x1 * cos - x2 * sin, x1 * sin + x2 * cos], axis=-2)
    return out.reshape(t.shape).astype(t.dtype)


def neighbourhood_attention(q, k, v, q_c, k_c, v_c, rpb):
    b, h, s, d = q.shape
    rows = s // GRID_W
    kr = min(NA_KR, rows)
    scale = d ** -0.5
    r = jnp.arange(rows)
    row_start = jnp.clip(r - kr // 2, 0, rows - kr)
    row_idx = row_start[:, None] + jnp.arange(kr)[None, :]
    col = jnp.arange(GRID_W)
    col_start = jnp.clip(col - NA_KC // 2, 0, GRID_W - NA_KC)
    col_ok = (col[None, :] >= col_start[:, None]) & (col[None, :] < col_start[:, None] + NA_KC)
    dr = row_idx - r[:, None] + (NA_KR - 1)
    dc = jnp.clip(col[None, :] - col[:, None], -(NA_KC - 1), NA_KC - 1) + (NA_KC - 1)
    bias = rpb[:, dr[:, None, :, None], dc[None, :, None, :]]

    qg = q.reshape(b, h, rows, GRID_W, d)
    kg = k.reshape(b, h, rows, GRID_W, d)
    vg = v.reshape(b, h, rows, GRID_W, d)
    k_win = jnp.take(kg, row_idx, axis=2)
    v_win = jnp.take(vg, row_idx, axis=2)
    s_win = (jnp.einsum("bhrqd,bhrkcd->bhrqkc", qg, k_win).astype(jnp.float32) * scale
             + bias[None].astype(jnp.float32))
    s_win = jnp.where(col_ok[:, None, :], s_win, NEG_INF)
    s_ctx = jnp.einsum("bhrqd,bhnd->bhrqn", qg, k_c).astype(jnp.float32) * scale
    n_win = kr * GRID_W
    s_all = jnp.concatenate([s_win.reshape(b, h, rows, GRID_W, n_win), s_ctx], axis=-1)
    p = jax.nn.softmax(s_all, axis=-1).astype(v.dtype)
    p_win = p[..., :n_win].reshape(b, h, rows, GRID_W, kr, GRID_W)
    p_ctx = p[..., n_win:]
    o = (jnp.einsum("bhrqkc,bhrkcd->bhrqd", p_win, v_win)
         + jnp.einsum("bhrqn,bhnd->bhrqd", p_ctx, v_c))
    o_lat = o.reshape(b, h, s, d)
    o_ctx = None if q_c is None else softmax_attend(q_c, k_c, v_c, scale)
    return o_lat, o_ctx


def depthwise_conv(x, w, bias):
    n = x.shape[1]
    xp = jnp.pad(x, ((0, 0), (CONV_PAD_LO, CONV_W - 1 - CONV_PAD_LO), (0, 0)))
    y = bias
    for tap in range(CONV_W):
        y = y + xp[:, tap:tap + n] * w[tap]
    return y


def rglru_coeffs(xc, wa, ba, wx, bx, lam):
    b, n, _ = xc.shape
    xb = xc.reshape(b, n, LRU_BLOCKS, LRU_BLOCK)
    gate_r = jax.nn.sigmoid(jnp.einsum("btni,nij->btnj", xb, wa).reshape(b, n, -1) + ba)
    gate_i = jax.nn.sigmoid(jnp.einsum("btni,nij->btnj", xb, wx).reshape(b, n, -1) + bx)
    log_a = -LRU_C * gate_r.astype(jnp.float32) * jax.nn.softplus(-lam.astype(jnp.float32))
    a = jnp.exp(log_a)
    u = jnp.sqrt(-jnp.expm1(2.0 * log_a)) * (gate_i * xc).astype(jnp.float32)
    return a, u


def linear_scan(a, u, reverse):
    def combine(left, right):
        a_l, u_l = left
        a_r, u_r = right
        return a_l * a_r, a_r * u_l + u_r
    _, hs = lax.associative_scan(combine, (a, u), reverse=reverse, axis=1)
    return hs


def bidirectional_rglru(u_lat, u_ctx, conv_w, conv_b, wa, ba, wx, bx, lam, want_ctx):
    xc_l = depthwise_conv(u_lat, conv_w, conv_b)
    xc_c = depthwise_conv(u_ctx, conv_w, conv_b)
    outs_l, outs_c = [], []
    for d, rev in ((0, False), (1, True)):
        a_c, v_c = rglru_coeffs(xc_c, wa[d], ba[d], wx[d], bx[d], lam[d])
        h_c = linear_scan(a_c, v_c, rev)
        end = 0 if rev else -1
        h0 = h_c[:, end]
        a_l, v_l = rglru_coeffs(xc_l, wa[d], ba[d], wx[d], bx[d], lam[d])
        start = -1 if rev else 0
        v_l = v_l.at[:, start].add(a_l[:, start] * h0)
        outs_l.append(linear_scan(a_l, v_l, rev))
        outs_c.append(h_c)
    y_lat = (outs_l[0] + outs_l[1]).astype(u_lat.dtype)
    y_ctx = (outs_c[0] + outs_c[1]).astype(u_ctx.dtype) if want_ctx else None
    return y_lat, y_ctx


def na_rglru_mixer(h_lat, h_ctx, w_in, w_out, rpb, conv_w, conv_b, wa, ba, wx, bx, lam, want_ctx):
    cuts = [NA_WIDTH, 2 * NA_WIDTH, 3 * NA_WIDTH, 3 * NA_WIDTH + LRU_WIDTH]
    q_l, k_l, v_l, u_l, g_l = jnp.split(h_lat @ w_in, cuts, axis=-1)
    w_q, w_k, w_v, w_u, w_g = jnp.split(w_in, cuts, axis=1)
    k_c, v_c, u_c = h_ctx @ w_k, h_ctx @ w_v, h_ctx @ w_u
    q_c = split_heads(h_ctx @ w_q, NA_HEADS) if want_ctx else None
    na_l, na_c = neighbourhood_attention(
        split_heads(q_l, NA_HEADS), split_heads(k_l, NA_HEADS), split_heads(v_l, NA_HEADS),
        q_c, split_heads(k_c, NA_HEADS), split_heads(v_c, NA_HEADS), rpb)
    r_l, r_c = bidirectional_rglru(u_l, u_c, conv_w, conv_b, wa, ba, wx, bx, lam, want_ctx)
    y_lat = jnp.concatenate([merge_heads(na_l), r_l * jax.nn.gelu(g_l)], axis=-1) @ w_out
    y_ctx = None
    if want_ctx:
        y_ctx = jnp.concatenate([merge_heads(na_c), r_c * jax.nn.gelu(h_ctx @ w_g)], axis=-1) @ w_out
    return y_lat, y_ctx


def mla_queries(h, w_dq, q_norm, w_uq, rope):
    q = split_heads(rms_norm(h @ w_dq, q_norm) @ w_uq, MLA_HEADS)
    if rope is not None:
        q = jnp.concatenate([q[..., :NOPE_DIM], apply_rope(q[..., NOPE_DIM:], *rope)], axis=-1)
    return q


def mla_keys_values(h, w_dkv, kv_norm, w_ukv, rope):
    p = h @ w_dkv
    c_kv, k_pe = p[..., :KV_LORA], p[..., KV_LORA:]
    kv = split_heads(rms_norm(c_kv, kv_norm) @ w_ukv, MLA_HEADS)
    k_nope, v = kv[..., :NOPE_DIM], kv[..., NOPE_DIM:]
    k_pe = k_pe[:, None]
    if rope is not None:
        k_pe = apply_rope(k_pe, *rope)
    k = jnp.concatenate([k_nope, jnp.broadcast_to(k_pe, k_nope.shape[:-1] + (ROPE_DIM,))], axis=-1)
    return k, v


def mla_mixer(h_lat, h_ctx, w_dq, w_dkv, q_norm, w_uq, kv_norm, w_ukv, w_o, want_ctx):
    scale = (NOPE_DIM + ROPE_DIM) ** -0.5
    rope = rope_tables(h_lat.shape[1])
    q_l = mla_queries(h_lat, w_dq, q_norm, w_uq, rope)
    k_l, v_l = mla_keys_values(h_lat, w_dkv, kv_norm, w_ukv, rope)
    k_c, v_c = mla_keys_values(h_ctx, w_dkv, kv_norm, w_ukv, None)
    k_all = jnp.concatenate([k_l, k_c], axis=2)
    v_all = jnp.concatenate([v_l, v_c], axis=2)
    y_lat = merge_heads(blocked_attend(q_l, k_all, v_all, scale)) @ w_o
    y_ctx = None
    if want_ctx:
        q_c = mla_queries(h_ctx, w_dq, q_norm, w_uq, None)
        y_ctx = merge_heads(softmax_attend(q_c, k_c, v_c, scale)) @ w_o
    return y_lat, y_ctx


def _dense(key, shape, fan_in, gain=1.0):
    return gain * jax.random.normal(key, shape, jnp.float32) * fan_in ** -0.5


def _normal(key, shape, std=1.0):
    return std * jax.random.normal(key, shape, jnp.float32)


def setup_inputs(seed: int = 0) -> dict:
    key = jax.random.key(seed)
    ks = jax.random.split(key, 28)
    D = D_MODEL
    a_base = jax.random.uniform(ks[19], (N_EVEN, 2, LRU_WIDTH), jnp.float32, 0.9, 0.999) ** (1.0 / LRU_C)
    return {
        "x": _normal(ks[0], (BATCH, SEQ, D)),
        "c": _normal(ks[1], (BATCH, D)),
        "ctx": _normal(ks[2], (BATCH, CTX_LEN, D)),
        "c_ctx": _normal(ks[3], (D,)),
        "mod_w": _dense(ks[4], (DEPTH, D, N_MOD * D), D, 0.5),
        "mod_b": _normal(ks[5], (DEPTH, N_MOD * D), 0.02),
        "norm_mix": 1.0 + _normal(ks[6], (DEPTH, D), 0.02),
        "norm_mlp": 1.0 + _normal(ks[7], (DEPTH, D), 0.02),
        "mlp_w1": _dense(ks[8], (DEPTH, D, D_FF), D),
        "mlp_w2": _dense(ks[9], (DEPTH, D_FF, D), D_FF),
        "ab_w_in": _dense(ks[10], (N_EVEN, D, AB_IN), D),
        "ab_w_out": _dense(ks[11], (N_EVEN, MIX_WIDTH, D), MIX_WIDTH),
        "na_rpb": _normal(ks[12], (N_EVEN, NA_HEADS, 2 * NA_KR - 1, 2 * NA_KC - 1), 0.1),
        "lru_conv_w": _dense(ks[13], (N_EVEN, CONV_W, LRU_WIDTH), CONV_W),
        "lru_conv_b": _normal(ks[14], (N_EVEN, LRU_WIDTH), 0.02),
        "lru_wa": _dense(ks[15], (N_EVEN, 2, LRU_BLOCKS, LRU_BLOCK, LRU_BLOCK), LRU_BLOCK),
        "lru_ba": _normal(ks[16], (N_EVEN, 2, LRU_WIDTH), 0.02),
        "lru_wx": _dense(ks[17], (N_EVEN, 2, LRU_BLOCKS, LRU_BLOCK, LRU_BLOCK), LRU_BLOCK),
        "lru_bx": _normal(ks[18], (N_EVEN, 2, LRU_WIDTH), 0.02),
        "lru_lambda": jnp.log(a_base) - jnp.log1p(-a_base),
        "mla_w_dq": _dense(ks[20], (N_ODD, D, Q_LORA), D),
        "mla_w_dkv": _dense(ks[21], (N_ODD, D, KV_LORA + ROPE_DIM), D),
        "mla_q_norm": 1.0 + _normal(ks[22], (N_ODD, Q_LORA), 0.02),
        "mla_w_uq": _dense(ks[23], (N_ODD, Q_LORA, MLA_HEADS * (NOPE_DIM + ROPE_DIM)), Q_LORA),
        "mla_kv_norm": 1.0 + _normal(ks[24], (N_ODD, KV_LORA), 0.02),
        "mla_w_ukv": _dense(ks[25], (N_ODD, KV_LORA, MLA_HEADS * (NOPE_DIM + V_DIM)), KV_LORA),
        "mla_w_o": _dense(ks[26], (N_ODD, MLA_HEADS * V_DIM, D), MLA_HEADS * V_DIM),
        "final_norm": 1.0 + _normal(ks[27], (D,), 0.02),
    }


def reference(x, c, ctx, c_ctx, mod_w, mod_b, norm_mix, norm_mlp, mlp_w1, mlp_w2,
              ab_w_in, ab_w_out, na_rpb, lru_conv_w, lru_conv_b, lru_wa, lru_ba, lru_wx, lru_bx,
              lru_lambda, mla_w_dq, mla_w_dkv, mla_q_norm, mla_w_uq, mla_kv_norm, mla_w_ukv,
              mla_w_o, final_norm):
    z = ctx
    cond_lat = jax.nn.silu(c)
    cond_ctx = jax.nn.silu(c_ctx)
    for layer in range(DEPTH):
        last = layer == DEPTH - 1
        want_ctx = not last
        j = layer // 2
        m_l = jnp.split((cond_lat @ mod_w[layer] + mod_b[layer])[:, None, :], N_MOD, axis=-1)
        m_c = jnp.split(cond_ctx @ mod_w[layer] + mod_b[layer], N_MOD, axis=-1)
        h_lat = modulate(rms_norm(x, norm_mix[layer]), m_l[0], m_l[1])
        h_ctx = modulate(rms_norm(z, norm_mix[layer]), m_c[0], m_c[1])
        if layer % 2 == 0:
            y_lat, y_ctx = na_rglru_mixer(
                h_lat, h_ctx, ab_w_in[j], ab_w_out[j], na_rpb[j], lru_conv_w[j], lru_conv_b[j],
                lru_wa[j], lru_ba[j], lru_wx[j], lru_bx[j], lru_lambda[j], want_ctx)
        else:
            y_lat, y_ctx = mla_mixer(
                h_lat, h_ctx, mla_w_dq[j], mla_w_dkv[j], mla_q_norm[j], mla_w_uq[j],
                mla_kv_norm[j], mla_w_ukv[j], mla_w_o[j], want_ctx)
        x = x + m_l[2] * y_lat
        x = x + m_l[5] * squared_relu_mlp(
            modulate(rms_norm(x, norm_mlp[layer]), m_l[3], m_l[4]), mlp_w1[layer], mlp_w2[layer])
        if want_ctx:
            z = z + m_c[2] * y_ctx
            z = z + m_c[5] * squared_relu_mlp(
                modulate(rms_norm(z, norm_mlp[layer]), m_c[3], m_c[4]), mlp_w1[layer], mlp_w2[layer])
    return rms_norm(x, final_norm)
```

```cpp
#include <hip/hip_runtime.h>
#include <hip/hip_cooperative_groups.h>
#include <cstdio>
#include <cmath>
#include <cstdint>
namespace cg = cooperative_groups;

#define LAS __attribute__((address_space(3)))
typedef unsigned short bf16_t;
typedef short bf16x8 __attribute__((ext_vector_type(8)));
typedef short s16x4 __attribute__((ext_vector_type(4)));
typedef float f32x4 __attribute__((ext_vector_type(4)));
typedef float f32x2 __attribute__((ext_vector_type(2)));
typedef float f32x16 __attribute__((ext_vector_type(16)));
typedef unsigned u32x4 __attribute__((ext_vector_type(4)));
typedef unsigned u32x2 __attribute__((ext_vector_type(2)));

constexpr int DM = 2048, NBATCH = 8, SEQ = 2048, CTXL = 256, ML = NBATCH * SEQ, MC = NBATCH * CTXL, MT = ML + MC;
constexpr int DFF = 8192, ABIN = 5120, NMOD6 = 6 * DM;
constexpr int LDS_BYTES = 155648;

constexpr size_t OFF_WIN  = 0;
constexpr size_t OFF_WOUT = OFF_WIN  + (size_t)5120 * 2048 * 2;
constexpr size_t OFF_W1   = OFF_WOUT + (size_t)2048 * 2048 * 2;
constexpr size_t OFF_W2   = OFF_W1   + (size_t)2 * 8192 * 2048 * 2;
constexpr size_t OFF_WD   = OFF_W2   + (size_t)2 * 2048 * 8192 * 2;
constexpr size_t OFF_WUQ  = OFF_WD   + (size_t)1280 * 2048 * 2;
constexpr size_t OFF_WUKV = OFF_WUQ  + (size_t)3072 * 512 * 2;
constexpr size_t OFF_WO   = OFF_WUKV + (size_t)4096 * 512 * 2;
constexpr size_t OFF_WL   = OFF_WO   + (size_t)2048 * 2048 * 2;
constexpr size_t OFF_MODV = OFF_WL   + (size_t)8 * 512 * 128 * 2;
constexpr size_t OFF_ROPE = OFF_MODV + (size_t)2 * 9 * NMOD6 * 4;
constexpr size_t OFF_LSUM = OFF_ROPE + (size_t)64 * 16 * 2 * 4;
constexpr size_t OFF_X    = OFF_LSUM + (size_t)8 * 8 * 18 * 2 * 128 * 2 * 4;
constexpr size_t OFF_H    = OFF_X    + (size_t)MT * DM * 4;
constexpr size_t OFF_R    = OFF_H    + (size_t)MT * DM * 2;
constexpr size_t OFF_P    = OFF_R;
constexpr size_t OFF_MIX  = OFF_R + (size_t)MT * ABIN * 2;
constexpr size_t OFF_QA   = OFF_R;
constexpr size_t OFF_QN   = OFF_QA   + (size_t)MT * 1280 * 2;
constexpr size_t OFF_CKVN = OFF_QN   + (size_t)ML * 512 * 2;
constexpr size_t OFF_KPE  = OFF_CKVN + (size_t)MT * 512 * 2;
constexpr size_t OFF_Q    = OFF_KPE  + (size_t)MT * 64 * 2;
constexpr size_t OFF_KV   = OFF_Q    + (size_t)ML * 3072 * 2;
constexpr size_t WS_END   = OFF_KV   + (size_t)MT * 4096 * 2;
constexpr size_t OFF_HID  = OFF_R;
constexpr size_t OFF_PART = OFF_R + (size_t)MT * DFF * 2;
constexpr size_t OFF_BAR  = OFF_PART + (size_t)4 * MC * DM * 4;
constexpr size_t WS_NEED  = OFF_BAR + 16384;

struct Params {
  const float* in[28];
  float* out;
  char* ws;
  float inv[16];
};

__device__ __forceinline__ unsigned cvt_pk_bf16(float lo, float hi) { unsigned r; asm volatile("v_cvt_pk_bf16_f32 %0, %1, %2" : "=v"(r) : "v"(lo), "v"(hi)); return r; }
__device__ __forceinline__ float bf2f(bf16_t b) { return __uint_as_float(((unsigned)b) << 16); }
__device__ __forceinline__ float bflo(unsigned w) { return __uint_as_float(w << 16); }
__device__ __forceinline__ float bfhi(unsigned w) { return __uint_as_float(w & 0xffff0000u); }
__device__ __forceinline__ float wave_sum(float v) {
#pragma unroll
  for (int o = 32; o >= 1; o >>= 1) v += __shfl_xor(v, o, 64);
  return v;
}
__device__ __forceinline__ int otid() { int t = threadIdx.x; asm volatile("" : "+v"(t)); return t; }
__device__ __forceinline__ float sigmoidf_(float x) { return 1.f / (1.f + __expf(-x)); }

namespace pg8 {
constexpr int BM = 256, BK = 64, HALF = 128, HTB = HALF * BK * 2, NXCD = 8, WGM = 8;
__device__ __forceinline__ int lds_byte(int r, int c) { const int st = (r >> 4) * 2 + (c >> 5), rr = r & 15, cc = c & 31, ob = rr * 64 + cc * 2; return st * 1024 + (ob ^ (((ob >> 9) & 1) << 5)); }
__device__ __forceinline__ void stage_rc(int b, int& R, int& C) { const int st = b / 1024, sb = b % 1024, swz = sb ^ (((sb >> 9) & 1) << 5); R = (st >> 1) * 16 + swz / 64; C = (st & 1) * 32 + (swz % 64) / 2; }
__device__ __forceinline__ int perm32(int rho) { const int n = rho >> 4, i = rho & 15; return 8 * (i >> 2) + 4 * n + (i & 3); }
struct Unit { int pm, pn, kb; };
struct Gemm { const bf16_t* A; const bf16_t* Bt; int lda, ldb, K, nM, nN; };
struct StaticOrder {
  int nM, nN, nwg, G, c;
  __device__ void init(int nM_, int nN_, int G_, int c_) { nM = nM_; nN = nN_; nwg = nM * nN; G = G_; c = c_; }
  __device__ bool next(int i, Unit& u) const {
    const long L = (long)i * G + c; if (L >= nwg) return false;
    int wgid = (int)L; { const int q = nwg / NXCD, r = nwg % NXCD, xcd = wgid % NXCD, off = wgid / NXCD; wgid = (xcd < r ? xcd * (q + 1) : r * (q + 1) + (xcd - r) * q) + off; }
    const int nig = WGM * nN, gid = wgid / nig, fm = gid * WGM, gsz = (nM - fm) < WGM ? (nM - fm) : WGM;
    u.pm = fm + ((wgid % nig) % gsz); u.pn = (wgid % nig) / gsz; u.kb = 0; return true;
  }
};
struct SplitOrder {
  int pm0, nMs, nN, NS, Kp, nwg, G, c;
  __device__ void init(int pm0_, int nMs_, int nN_, int NS_, int Kp_, int G_, int c_) { pm0 = pm0_; nMs = nMs_; nN = nN_; NS = NS_; Kp = Kp_; nwg = nMs * nN * NS; G = G_; c = c_; }
  __device__ bool next(int i, Unit& u) const {
    const long L = (long)i * G + c; if (L >= nwg) return false;
    const int l = (int)L; const int part = l % NS, tile = l / NS;
    u.pm = pm0 + tile % nMs; u.pn = tile / nMs; u.kb = part * Kp * 2; return true;
  }
};

template <class Epi, class Sched, bool ALIGN_EPI = true>
__device__ __forceinline__ void gemm_phase(LAS unsigned char* lds, const Gemm g, const Sched& S, const Epi& E) {
  const int tid = otid(), wid = __builtin_amdgcn_readfirstlane(tid >> 6), lane = tid & 63, wr = wid >> 2, wc = wid & 3, fr = lane & 15, fq = lane >> 4;
  const int K = g.K, nt = K / BK;
  unsigned voffA[2], voffB[2];
#pragma unroll
  for (int i = 0; i < 2; ++i) { int R, C; stage_rc(tid * 16 + i * 8192, R, C); const int Rb = Epi::PERM ? ((R & ~31) + perm32(R & 31)) : R;
    voffA[i] = (unsigned)(R * g.lda + C) * 2u; voffB[i] = (unsigned)(Rb * g.ldb + C) * 2u; }
  const size_t kstep = (size_t)(BK * 2);
  const size_t hstepA = (size_t)HALF * g.lda * 2, hstepB = (size_t)HALF * g.ldb * 2;
  const size_t tstepA = 2 * hstepA, tstepB = 2 * hstepB;
  const unsigned ldsw = (unsigned)wid * 1024u;
  const int aoff = lds_byte(wr * 64 + fr, fq * 8), boff = lds_byte(wc * 32 + fr, fq * 8);
#define PG8_SA(b, h) (((b) * 2 + (h)) * HTB)
#define PG8_SB(b, h) ((4 + (b) * 2 + (h)) * HTB)
#define PG8_STAGE(bufoff, gbase, voff) do { _Pragma("unroll") for (int _i = 0; _i < 2; ++_i) \
    __builtin_amdgcn_global_load_lds((const unsigned*)((const char*)(gbase) + (voff)[_i]), (LAS unsigned*)(lds + (bufoff) + ldsw + _i * 8192), 16, 0, 0); } while (0)
#define PG8_LDA(dst, b, h) do { _Pragma("unroll") for (int m = 0; m < 4; ++m) _Pragma("unroll") for (int k = 0; k < 2; ++k) dst[m][k] = *(const LAS bf16x8*)(lds + PG8_SA(b, h) + aoff + m * 2048 + k * 1024); } while (0)
#define PG8_LDB(dst, b, h) do { _Pragma("unroll") for (int n = 0; n < 2; ++n) _Pragma("unroll") for (int k = 0; k < 2; ++k) dst[n][k] = *(const LAS bf16x8*)(lds + PG8_SB(b, h) + boff + n * 2048 + k * 1024); } while (0)
#define PG8_MMA(ai, bj, At, Bt) do { __builtin_amdgcn_s_setprio(1); _Pragma("unroll") for (int m = 0; m < 4; ++m) _Pragma("unroll") for (int n = 0; n < 2; ++n) _Pragma("unroll") for (int k = 0; k < 2; ++k) \
    acc[ai][bj][m][n] = __builtin_amdgcn_mfma_f32_16x16x32_bf16(Bt[n][k], At[m][k], acc[ai][bj][m][n], 0, 0, 0); __builtin_amdgcn_s_setprio(0); } while (0)
#define PG8_WAIT_V(n) asm volatile("s_waitcnt vmcnt(" #n ")" ::: "memory")
#define PG8_WAIT_L(n) asm volatile("s_waitcnt lgkmcnt(" #n ")" ::: "memory")
#define PG8_BAR __builtin_amdgcn_s_barrier()
#define PG8_SCHED __builtin_amdgcn_sched_barrier(0)
  Unit cur, nxt; int ui = 0;
  if (!S.next(0, cur)) return;
  f32x4 acc[2][2][4][2];
#pragma unroll
  for (int a = 0; a < 2; ++a)
#pragma unroll
    for (int b = 0; b < 2; ++b)
#pragma unroll
      for (int m = 0; m < 4; ++m)
#pragma unroll
        for (int n = 0; n < 2; ++n) acc[a][b][m][n] = (f32x4){0.f, 0.f, 0.f, 0.f};
  bf16x8 At[4][2], B0[2][2], B1[2][2];
  const char* cA = (const char*)g.A + (size_t)cur.pm * tstepA + cur.kb; const char* cB = (const char*)g.Bt + (size_t)cur.pn * tstepB + cur.kb;
  PG8_STAGE(PG8_SB(0, 0), cB, voffB); PG8_STAGE(PG8_SB(0, 1), cB + hstepB, voffB); PG8_STAGE(PG8_SA(0, 0), cA, voffA); PG8_STAGE(PG8_SA(0, 1), cA + hstepA, voffA);
  if (wr == 1) PG8_BAR;
  PG8_WAIT_V(2); PG8_BAR;
  PG8_STAGE(PG8_SB(1, 0), cB + kstep, voffB); PG8_STAGE(PG8_SA(1, 0), cA + kstep, voffA); PG8_STAGE(PG8_SB(1, 1), cB + hstepB + kstep, voffB);
  PG8_WAIT_V(6); PG8_BAR;
  for (;;) {
    const bool has_next = S.next(ui + 1, nxt);
    const char* nA = has_next ? (const char*)g.A + (size_t)nxt.pm * tstepA + nxt.kb : cA; const char* nB = has_next ? (const char*)g.Bt + (size_t)nxt.pn * tstepB + nxt.kb : cB;
    for (int t = 0; t < nt; t += 2) {
      const bool last = (t == nt - 2);
      const char* a1 = cA + (size_t)(t + 1) * kstep;
      const char* a2 = last ? nA : cA + (size_t)(t + 2) * kstep; const char* b2 = last ? nB : cB + (size_t)(t + 2) * kstep;
      const char* a3 = a2 + kstep; const char* b3 = b2 + kstep;
      PG8_LDB(B0, 0, 0); PG8_LDB(B1, 0, 1); PG8_SCHED; PG8_LDA(At, 0, 0); PG8_STAGE(PG8_SA(1, 1), a1 + hstepA, voffA);
      PG8_WAIT_V(8); PG8_WAIT_L(0); PG8_BAR; PG8_MMA(0, 0, At, B0); PG8_MMA(0, 1, At, B1); PG8_BAR; PG8_SCHED;
      PG8_LDA(At, 0, 1); PG8_STAGE(PG8_SB(0, 0), b2, voffB); PG8_STAGE(PG8_SB(0, 1), b2 + hstepB, voffB); PG8_STAGE(PG8_SA(0, 0), a2, voffA);
      PG8_WAIT_V(8); PG8_WAIT_L(0); PG8_BAR; PG8_MMA(1, 0, At, B0); PG8_MMA(1, 1, At, B1); PG8_BAR; PG8_SCHED;
      PG8_LDB(B0, 1, 0); PG8_LDB(B1, 1, 1); PG8_SCHED; PG8_LDA(At, 1, 0); PG8_STAGE(PG8_SA(0, 1), a2 + hstepA, voffA);
      PG8_WAIT_V(8); PG8_WAIT_L(0); PG8_BAR; PG8_MMA(0, 0, At, B0); PG8_MMA(0, 1, At, B1); PG8_BAR; PG8_SCHED;
      PG8_LDA(At, 1, 1); PG8_STAGE(PG8_SB(1, 0), b3, voffB); PG8_STAGE(PG8_SB(1, 1), b3 + hstepB, voffB); PG8_STAGE(PG8_SA(1, 0), a3, voffA);
      PG8_WAIT_V(8); PG8_WAIT_L(0); PG8_BAR; PG8_MMA(1, 0, At, B0); PG8_MMA(1, 1, At, B1); PG8_BAR; PG8_SCHED;
    }
    if constexpr (ALIGN_EPI) { if (wr == 0) PG8_BAR; }
    E(acc, cur, wr, wc, fr, fq);
    if (!has_next) break;
#pragma unroll
    for (int a = 0; a < 2; ++a)
#pragma unroll
      for (int b = 0; b < 2; ++b)
#pragma unroll
        for (int m = 0; m < 4; ++m)
#pragma unroll
          for (int n = 0; n < 2; ++n) acc[a][b][m][n] = (f32x4){0.f, 0.f, 0.f, 0.f};
    cur = nxt; cA = nA; cB = nB; ++ui;
    if constexpr (ALIGN_EPI) { if (wr == 1) PG8_BAR; }
  }
  PG8_WAIT_V(0);
  if constexpr (!ALIGN_EPI) { if (wr == 0) PG8_BAR; }
  PG8_BAR;
#undef PG8_SA
#undef PG8_SB
#undef PG8_STAGE
#undef PG8_LDA
#undef PG8_LDB
#undef PG8_MMA
#undef PG8_WAIT_V
#undef PG8_WAIT_L
#undef PG8_BAR
#undef PG8_SCHED
}

template <int ACT  > struct EpiBf16 {
  static constexpr bool PERM = true;
  bf16_t* O; int ldc;
  __device__ __forceinline__ void operator()(const f32x4 (&acc)[2][2][4][2], const Unit& u, int wr, int wc, int fr, int fq) const {
    const int row0 = u.pm * BM + wr * 64 + fr, col0 = u.pn * BM + wc * 32 + 8 * fq;
#pragma unroll
    for (int ai = 0; ai < 2; ++ai)
#pragma unroll
      for (int m = 0; m < 4; ++m) { bf16_t* rowp = O + (size_t)(row0 + ai * HALF + m * 16) * ldc + col0;
#pragma unroll
        for (int bj = 0; bj < 2; ++bj) { f32x4 v0 = acc[ai][bj][m][0], v1 = acc[ai][bj][m][1];
          if (ACT == 1) {
#pragma unroll
            for (int j = 0; j < 4; ++j) { float a = fmaxf(v0[j], 0.f), b = fmaxf(v1[j], 0.f); v0[j] = a * a; v1[j] = b * b; } }
          u32x4 w; w.x = cvt_pk_bf16(v0[0], v0[1]); w.y = cvt_pk_bf16(v0[2], v0[3]); w.z = cvt_pk_bf16(v1[0], v1[1]); w.w = cvt_pk_bf16(v1[2], v1[3]);
          *(u32x4*)(rowp + bj * HALF) = w; } }
  }
};
template <bool XIN_F32> struct EpiResid {
  static constexpr bool PERM = true;
  const void* xin; bf16_t* xout; const float* gate;
  __device__ __forceinline__ void operator()(const f32x4 (&acc)[2][2][4][2], const Unit& u, int wr, int wc, int fr, int fq) const {
    const int rowt = u.pm * BM; const int b = rowt >> 11;
    const int row0 = rowt + wr * 64 + fr, col0 = u.pn * BM + wc * 32 + 8 * fq;
    f32x4 gv[2][2];
#pragma unroll
    for (int bj = 0; bj < 2; ++bj)
#pragma unroll
      for (int n = 0; n < 2; ++n) gv[bj][n] = *(const f32x4*)(gate + (size_t)b * NMOD6 + col0 + bj * HALF + 4 * n);
#pragma unroll
    for (int ai = 0; ai < 2; ++ai)
#pragma unroll
      for (int m = 0; m < 4; ++m) { const size_t ro = (size_t)(row0 + ai * HALF + m * 16) * DM + col0;
#pragma unroll
        for (int bj = 0; bj < 2; ++bj) { f32x4 x0, x1;
          if constexpr (XIN_F32) { x0 = *(const f32x4*)((const float*)xin + ro + bj * HALF); x1 = *(const f32x4*)((const float*)xin + ro + bj * HALF + 4); }
          else { const u32x4 w = *(const u32x4*)((const bf16_t*)xin + ro + bj * HALF);
            x0 = (f32x4){bflo(w.x), bfhi(w.x), bflo(w.y), bfhi(w.y)}; x1 = (f32x4){bflo(w.z), bfhi(w.z), bflo(w.w), bfhi(w.w)}; }
          const f32x4 v0 = x0 + gv[bj][0] * acc[ai][bj][m][0], v1 = x1 + gv[bj][1] * acc[ai][bj][m][1];
          u32x4 o; o.x = cvt_pk_bf16(v0[0], v0[1]); o.y = cvt_pk_bf16(v0[2], v0[3]); o.z = cvt_pk_bf16(v1[0], v1[1]); o.w = cvt_pk_bf16(v1[2], v1[3]);
          *(u32x4*)(xout + ro + bj * HALF) = o; } }
  }
};
struct EpiPartial {
  static constexpr bool PERM = false;
  float* part; const float* gate; int kp2;
  __device__ __forceinline__ void operator()(const f32x4 (&acc)[2][2][4][2], const Unit& u, int wr, int wc, int fr, int fq) const {
    const int row0 = u.pm * BM - ML + wr * 64 + fr, col0 = u.pn * BM + wc * 32 + 4 * fq;
    float* base = part + (size_t)(u.kb / kp2) * MC * DM;
    f32x4 gv[2][2];
#pragma unroll
    for (int bj = 0; bj < 2; ++bj)
#pragma unroll
      for (int n = 0; n < 2; ++n) gv[bj][n] = *(const f32x4*)(gate + (size_t)8 * NMOD6 + col0 + bj * HALF + n * 16);
#pragma unroll
    for (int ai = 0; ai < 2; ++ai)
#pragma unroll
      for (int m = 0; m < 4; ++m) { const size_t ro = (size_t)(row0 + ai * HALF + m * 16) * DM + col0;
#pragma unroll
        for (int bj = 0; bj < 2; ++bj)
#pragma unroll
          for (int n = 0; n < 2; ++n) *(f32x4*)(base + ro + bj * HALF + n * 16) = gv[bj][n] * acc[ai][bj][m][n]; }
  }
};
}

namespace att {
constexpr int NW = 8, QBLK = 32, KVBLK = 64;
constexpr size_t SHM_V = KVBLK * 128 * 2;
#define SBAR() __builtin_amdgcn_sched_barrier(0)
__device__ __forceinline__ int crow(int r, int hi) { return (r & 3) + 8 * (r >> 2) + 4 * hi; }

__device__ __forceinline__ void partialSM(f32x16& p0, f32x16& p1, float& m_reg, float& mn, float& alpha, const float C, const float THRS) {
  float pmax = p0[0];
#pragma unroll
  for (int r = 1; r < 16; ++r) pmax = fmaxf(pmax, p0[r]);
#pragma unroll
  for (int r = 0; r < 16; ++r) pmax = fmaxf(pmax, p1[r]);
  { auto rr = __builtin_amdgcn_permlane32_swap(__float_as_uint(pmax), __float_as_uint(pmax), false, false);
    pmax = fmaxf(__uint_as_float(rr[0]), __uint_as_float(rr[1])); }
  if (__builtin_expect(__all(pmax - m_reg <= THRS), 1)) { mn = m_reg; alpha = 1.f; }
  else { mn = fmaxf(m_reg, pmax); alpha = __builtin_amdgcn_exp2f((m_reg - mn) * C); m_reg = mn; }
  float mnC = -mn * C;
#pragma unroll
  for (int r = 0; r < 16; ++r) p0[r] = fmaf(p0[r], C, mnC);
#pragma unroll
  for (int r = 0; r < 16; ++r) p1[r] = fmaf(p1[r], C, mnC);
#pragma unroll
  for (int r = 0; r < 16; ++r) p0[r] = __builtin_amdgcn_exp2f(p0[r]);
}
__device__ __forceinline__ void finishSM(f32x16& p0, f32x16& p1, float alpha, float& l_reg, bf16x8& pa0, bf16x8& pa1, bf16x8& pa2, bf16x8& pa3) {
#pragma unroll
  for (int r = 0; r < 16; ++r) p1[r] = __builtin_amdgcn_exp2f(p1[r]);
  float ps = 0;
#pragma unroll
  for (int r = 0; r < 16; ++r) ps += p0[r];
#pragma unroll
  for (int r = 0; r < 16; ++r) ps += p1[r];
  { auto rr = __builtin_amdgcn_permlane32_swap(__float_as_uint(ps), __float_as_uint(ps), false, false);
    ps = __uint_as_float(rr[0]) + __uint_as_float(rr[1]); }
  l_reg = l_reg * alpha + ps;
#define PK4(P, BASE, OUT) do { unsigned a0 = cvt_pk_bf16(P[BASE + 0], P[BASE + 1]), a1 = cvt_pk_bf16(P[BASE + 2], P[BASE + 3]);   \
    unsigned b0 = cvt_pk_bf16(P[BASE + 4], P[BASE + 5]), b1 = cvt_pk_bf16(P[BASE + 6], P[BASE + 7]);                              \
    auto r0 = __builtin_amdgcn_permlane32_swap(a0, b0, false, false); auto r1 = __builtin_amdgcn_permlane32_swap(a1, b1, false, false); \
    u32x4 w = {r0[0], r1[0], r0[1], r1[1]}; OUT = *reinterpret_cast<bf16x8*>(&w); } while (0)
  PK4(p0, 0, pa0); PK4(p0, 8, pa1); PK4(p1, 0, pa2); PK4(p1, 8, pa3);
#undef PK4
}
template <int DQK>
__device__ __forceinline__ void qkt(f32x16& p0, f32x16& p1, const char* Ks, const bf16x8* qr, const char* ql, int r32, int hi) {
  p0 = f32x16{}; p1 = f32x16{};
#pragma unroll
  for (int d0 = 0; d0 < DQK / 16; ++d0) { const int cb = (d0 * 16 + hi * 8) * 2;
    bf16x8 b0 = *reinterpret_cast<const bf16x8*>(Ks + r32 * (DQK * 2) + (cb ^ ((r32 & 7) << 4)));
    bf16x8 b1 = *reinterpret_cast<const bf16x8*>(Ks + (32 + r32) * (DQK * 2) + (cb ^ ((r32 & 7) << 4)));
    constexpr int NQR = DQK == 192 ? 4 : 8;
    bf16x8 qv; if (d0 < NQR) qv = qr[d0 < NQR ? d0 : 0]; else qv = *reinterpret_cast<const bf16x8*>(ql + (d0 - NQR) * 1024);
    p0 = __builtin_amdgcn_mfma_f32_32x32x16_bf16(b0, qv, p0, 0, 0, 0);
    p1 = __builtin_amdgcn_mfma_f32_32x32x16_bf16(b1, qv, p1, 0, 0, 0); }
}
__device__ __forceinline__ int v_st(int k, int c) { const int kk = (k & ~0xC) | ((k & 4) << 1) | ((k & 8) >> 1); return ((kk >> 3) * 4 + (c >> 5)) * 512 + ((kk & 7) * 32 + (c & 31)) * 2; }
__device__ __forceinline__ int v_rd_base(int lane) { return ((lane & 3) << 3) | (((lane >> 2) & 3) << 6) | (((lane >> 4) & 1) << 5) | (((lane >> 5) & 1) << 8); }
constexpr int v_rd_off(int d0, int ks, int half) { return d0 * 512 + ks * 4096 + half * 2048; }
template <int OFF> __device__ __forceinline__ s16x4 tr_read(int vb) {
  s16x4 r; asm volatile("ds_read_b64_tr_b16 %0, %1 offset:%2" : "=&v"(r) : "v"(vb), "i"(OFF) : "memory"); return r;
}
template <int D0> __device__ __forceinline__ void pv_one(f32x16& od, int vb, bf16x8 pa0, bf16x8 pa1, bf16x8 pa2, bf16x8 pa3) {
  const s16x4 l0 = tr_read<v_rd_off(D0, 0, 0)>(vb), h0 = tr_read<v_rd_off(D0, 0, 1)>(vb), l1 = tr_read<v_rd_off(D0, 1, 0)>(vb), h1 = tr_read<v_rd_off(D0, 1, 1)>(vb);
  const s16x4 l2 = tr_read<v_rd_off(D0, 2, 0)>(vb), h2 = tr_read<v_rd_off(D0, 2, 1)>(vb), l3 = tr_read<v_rd_off(D0, 3, 0)>(vb), h3 = tr_read<v_rd_off(D0, 3, 1)>(vb);
  asm volatile("s_waitcnt lgkmcnt(0)" ::: "memory"); SBAR();
#define PK(L, H) (bf16x8){L[0], L[1], L[2], L[3], H[0], H[1], H[2], H[3]}
  od = __builtin_amdgcn_mfma_f32_32x32x16_bf16(pa0, PK(l0, h0), od, 0, 0, 0);
  od = __builtin_amdgcn_mfma_f32_32x32x16_bf16(pa1, PK(l1, h1), od, 0, 0, 0);
  od = __builtin_amdgcn_mfma_f32_32x32x16_bf16(pa2, PK(l2, h2), od, 0, 0, 0);
  od = __builtin_amdgcn_mfma_f32_32x32x16_bf16(pa3, PK(l3, h3), od, 0, 0, 0);
#undef PK
}
__device__ __forceinline__ void pv_d0(f32x16* o, int vb, bf16x8 pa0, bf16x8 pa1, bf16x8 pa2, bf16x8 pa3) {
  pv_one<0>(o[0], vb, pa0, pa1, pa2, pa3); pv_one<1>(o[1], vb, pa0, pa1, pa2, pa3); pv_one<2>(o[2], vb, pa0, pa1, pa2, pa3); pv_one<3>(o[3], vb, pa0, pa1, pa2, pa3);
}

struct Job {
  const bf16_t* Qb; int ldq;
  const bf16_t* Kb; const bf16_t* Vb; int ldk;
  const bf16_t* Pe;
  bf16_t* Ob; int ldo;
  int NT;
  int rowA, nA, rowB;
  int qb4;
  int lo, nwin;
  const float* rope; int tok0;
};

template <int MODE>
__device__ __forceinline__ void attn_body(const Job J, char* lds) {
  constexpr int DQK = (MODE == 2) ? 192 : 128;
  constexpr size_t SHM_K = KVBLK * DQK * 2;
  constexpr float SCALE = (MODE == 2) ? 0.07216878364870323f : 0.08838834764831845f;
  constexpr float C = SCALE * 1.4426950408889634f;
  constexpr float THRS = 8.f / SCALE;
  const int tid = otid(), wid = tid >> 6, lane = tid & 63, r32 = lane & 31, hi = lane >> 5;
  char* V_lds = lds; char* K_lds = lds + 2 * SHM_V;
  float* wsf = (float*)(lds + 2 * SHM_V + 2 * SHM_K) + wid * 64; float* li_l = wsf; float* al_l = wsf + 32;
  const float* tab = (const float*)(lds + 2 * SHM_V + 2 * SHM_K + NW * 256) + 64;
  constexpr int NQR = (MODE == 2) ? 4 : 8;
  float m_reg = -1e30f, l_reg = 0; f32x16 o[4] = {}; bf16x8 qr[NQR];
  const bf16_t* Qw = J.Qb + (size_t)(wid * QBLK + r32) * J.ldq + hi * 8;
  char* ql = lds + 2 * SHM_V + 2 * SHM_K + NW * 256 + (wid * 8 * 64 + lane) * 16;
#pragma unroll
  for (int d0 = 0; d0 < NQR; ++d0) qr[d0] = *reinterpret_cast<const bf16x8*>(Qw + d0 * 16);
  if constexpr (MODE == 2) {
#pragma unroll
    for (int d0 = 4; d0 < 8; ++d0) *reinterpret_cast<bf16x8*>(ql + (d0 - 4) * 1024) = *reinterpret_cast<const bf16x8*>(Qw + d0 * 16);
    const int tok = J.tok0 + wid * QBLK + r32; const int prow = tok >> 6, pcol = tok & 63;
#pragma unroll
    for (int ax = 0; ax < 2; ++ax) {
      const float* cs = J.rope + (size_t)((ax == 0 ? prow : pcol) * 16 + hi * 8) * 2;
      bf16x8 x1 = *reinterpret_cast<const bf16x8*>(Qw + (8 + 2 * ax) * 16), x2 = *reinterpret_cast<const bf16x8*>(Qw + (9 + 2 * ax) * 16); u32x4 w1, w2;
#pragma unroll
      for (int i = 0; i < 4; ++i) {
        const f32x4 t = *(const f32x4*)(cs + 4 * i);
        const float a0 = bf2f((bf16_t)x1[2 * i]), a1 = bf2f((bf16_t)x1[2 * i + 1]), b0 = bf2f((bf16_t)x2[2 * i]), b1 = bf2f((bf16_t)x2[2 * i + 1]);
        w1[i] = cvt_pk_bf16(a0 * t[0] - b0 * t[1], a1 * t[2] - b1 * t[3]);
        w2[i] = cvt_pk_bf16(a0 * t[1] + b0 * t[0], a1 * t[3] + b1 * t[2]);
      }
      *reinterpret_cast<u32x4*>(ql + (4 + 2 * ax) * 1024) = w1; *reinterpret_cast<u32x4*>(ql + (5 + 2 * ax) * 1024) = w2;
    }
  }
  const int sr = tid >> 4, sc = (tid & 15) * 8, vst0 = v_st(sr, sc), vst1 = v_st(32 + sr, sc);
  const int pr = tid >> 3, pc = (tid & 7) * 8;
  const int vb0 = (int)(uintptr_t)V_lds + v_rd_base(lane);
  bf16x8 vs0, vs1, ks0, ks1, kp;
  const int rq = J.qb4 + (wid >> 1), qc = (wid & 1) * 32 + r32;
  const int rs = min(max(rq - 4, 0), 24), cs_ = min(max(qc - 8, 0), 48);
#define TROW(t) ((t) < J.nA ? J.rowA + 64 * (t) : J.rowB + 64 * ((t) - J.nA))
#define SLOAD(t) do { const int _r0 = TROW(t); \
    vs0 = *reinterpret_cast<const bf16x8*>(J.Vb + (size_t)(_r0 + sr) * J.ldk + sc); vs1 = *reinterpret_cast<const bf16x8*>(J.Vb + (size_t)(_r0 + 32 + sr) * J.ldk + sc); \
    ks0 = *reinterpret_cast<const bf16x8*>(J.Kb + (size_t)(_r0 + sr) * J.ldk + sc); ks1 = *reinterpret_cast<const bf16x8*>(J.Kb + (size_t)(_r0 + 32 + sr) * J.ldk + sc); \
    if constexpr (MODE == 2) kp = *reinterpret_cast<const bf16x8*>(J.Pe + (size_t)(_r0 + pr) * 64 + pc); } while (0)
#define SWRITE(b) do { *(bf16x8*)(V_lds + (b) * SHM_V + vst0) = vs0; *(bf16x8*)(V_lds + (b) * SHM_V + vst1) = vs1; const int kc = sc * 2; \
    *(bf16x8*)(K_lds + (b) * SHM_K + sr * (DQK * 2) + (kc ^ ((sr & 7) << 4))) = ks0; \
    *(bf16x8*)(K_lds + (b) * SHM_K + (32 + sr) * (DQK * 2) + (kc ^ ((sr & 7) << 4))) = ks1; \
    if constexpr (MODE == 2) *(bf16x8*)(K_lds + (b) * SHM_K + pr * (DQK * 2) + (((128 + pc) * 2) ^ ((pr & 7) << 4))) = kp; } while (0)
#define SWAIT() asm volatile("s_waitcnt vmcnt(0)" ::: "memory")
#define RESC(a) do { if (__any((a) < 1.f)) { if (hi == 0) al_l[r32] = (a); asm volatile("s_waitcnt lgkmcnt(0)" ::: "memory"); \
    _Pragma("unroll") for (int d = 0; d < 4; ++d) _Pragma("unroll") for (int r = 0; r < 16; ++r) o[d][r] *= al_l[crow(r, hi)]; } } while (0)
#define MASK(P0, P1, t) do { if constexpr (MODE == 0) { if ((t) >= J.nA) { const int _w = (t) - J.nA; const int _kr = J.lo + _w; \
      if (_w < J.nwin && _kr >= rs && _kr < rs + 8) { const float* _tr = tab + (_kr - rq + 7) * 31 + 15 - qc; \
        _Pragma("unroll") for (int r = 0; r < 16; ++r) { const int kc0 = crow(r, hi); \
          const float b0 = _tr[kc0], b1 = _tr[kc0 + 32]; \
          P0[r] = ((unsigned)(kc0 - cs_) < 16u) ? P0[r] + b0 : -1e30f; P1[r] = ((unsigned)(kc0 + 32 - cs_) < 16u) ? P1[r] + b1 : -1e30f; } } \
      else { _Pragma("unroll") for (int r = 0; r < 16; ++r) { P0[r] = -1e30f; P1[r] = -1e30f; } } } } } while (0)
  f32x16 pA0, pA1, pB0, pB1; float mnA, mnB, alA, alB; bf16x8 pa0, pa1, pa2, pa3; const int NT = J.NT;
  SLOAD(0); SWAIT(); SWRITE(0); __syncthreads();
  qkt<DQK>(pA0, pA1, K_lds, qr, ql, r32, hi); MASK(pA0, pA1, 0); partialSM(pA0, pA1, m_reg, mnA, alA, C, THRS);
  SLOAD(1);
  SWAIT(); SWRITE(1); __syncthreads();
  for (int j = 1; j + 1 < NT; j += 2) {
    SBAR(); qkt<DQK>(pB0, pB1, K_lds + SHM_K, qr, ql, r32, hi);
    finishSM(pA0, pA1, alA, l_reg, pa0, pa1, pa2, pa3); SBAR();
    SLOAD(j + 1); SBAR();
    pv_d0(o, vb0, pa0, pa1, pa2, pa3); MASK(pB0, pB1, j); partialSM(pB0, pB1, m_reg, mnB, alB, C, THRS);
    __syncthreads(); SWAIT(); SWRITE(0);
    RESC(alB); __syncthreads();
    SBAR(); qkt<DQK>(pA0, pA1, K_lds, qr, ql, r32, hi);
    finishSM(pB0, pB1, alB, l_reg, pa0, pa1, pa2, pa3); SBAR();
    SLOAD(j + 2); SBAR();
    pv_d0(o, vb0 + (int)SHM_V, pa0, pa1, pa2, pa3); MASK(pA0, pA1, j + 1); partialSM(pA0, pA1, m_reg, mnA, alA, C, THRS);
    __syncthreads(); SWAIT(); SWRITE(1);
    RESC(alA); __syncthreads();
  }
  SBAR(); qkt<DQK>(pB0, pB1, K_lds + SHM_K, qr, ql, r32, hi);
  finishSM(pA0, pA1, alA, l_reg, pa0, pa1, pa2, pa3); SBAR();
  pv_d0(o, vb0, pa0, pa1, pa2, pa3); MASK(pB0, pB1, NT - 1); partialSM(pB0, pB1, m_reg, mnB, alB, C, THRS);
  __syncthreads(); RESC(alB);
  finishSM(pB0, pB1, alB, l_reg, pa0, pa1, pa2, pa3); SBAR();
  pv_d0(o, vb0 + (int)SHM_V, pa0, pa1, pa2, pa3);
  if (hi == 0) li_l[r32] = l_reg; asm volatile("s_waitcnt lgkmcnt(0)" ::: "memory");
  float rli[16];
#pragma unroll
  for (int r = 0; r < 16; ++r) rli[r] = __builtin_amdgcn_rcpf(li_l[crow(r, hi)]);
  bf16_t* Ow = J.Ob + (size_t)(wid * QBLK) * J.ldo;
#pragma unroll
  for (int r = 0; r < 16; ++r) { const int orow = crow(r, hi);
#pragma unroll
    for (int d0 = 0; d0 < 4; ++d0) Ow[(size_t)orow * J.ldo + d0 * 32 + r32] = (bf16_t)(cvt_pk_bf16(o[d0][r] * rli[r], 0.f) & 0xffffu); }
#undef TROW
#undef SLOAD
#undef SWRITE
#undef SWAIT
#undef RESC
#undef MASK
}
}

__constant__ int XJOB[11][6] = {
  {10, 0, 2048, 5120, 0, 0},
  {11, 0, 2048, 2048, 0, 640},
  {8, 0, 2048, 8192, 0, 896},
  {9, 0, 8192, 2048, 0, 1920},
  {20, 0, 2048, 512, 0, 2944},
  {21, 0, 2048, 576, 512, 3008},
  {8, 2048 * 8, 2048, 8192, 0, 3088},
  {9, 8192 * 2, 8192, 2048, 0, 4112},
  {23, 0, 512, 3072, 0, 5136},
  {25, 0, 512, 4096, 0, 5232},
  {26, 0, 2048, 2048, 0, 5360},
};
constexpr int N_XT = 5616, N_EARLY = 3088, N_GEMV = 192;

__device__ __forceinline__ size_t xjob_dst(int j) {
  switch (j) {
    case 0: return OFF_WIN; case 1: return OFF_WOUT; case 2: return OFF_W1; case 3: return OFF_W2;
    case 4: return OFF_WD; case 5: return OFF_WD; case 6: return OFF_W1 + (size_t)8192 * 2048 * 2; case 7: return OFF_W2 + (size_t)2048 * 8192 * 2;
    case 8: return OFF_WUQ; case 9: return OFF_WUKV; default: return OFF_WO;
  }
}

__device__ __forceinline__ void xpose_tile(const Params& p, int tt, float* fs, int tid) {
  int j = 0;
#pragma unroll
  for (int q = 1; q < 11; ++q) if (tt >= XJOB[q][5]) j = q;
  const int K = XJOB[j][2], N = XJOB[j][3], tl = tt - XJOB[j][5];
  const int tilesN = (N + 127) / 128; const int tk = tl / tilesN, tn = tl % tilesN;
  const float* src = p.in[XJOB[j][0]] + (size_t)XJOB[j][1] * 1024;
  bf16_t* dst = (bf16_t*)(p.ws + xjob_dst(j)) + (size_t)XJOB[j][4] * K;
  const int k0 = tk * 128, n0 = tn * 128;
  { const int nn = (tid & 31) * 4, kr = tid >> 5; f32x4 v[8];
#pragma unroll
    for (int q = 0; q < 8; ++q) v[q] = (n0 + nn < N) ? *(const f32x4*)(src + (size_t)(k0 + kr + 16 * q) * N + n0 + nn) : (f32x4){0.f, 0.f, 0.f, 0.f};
#pragma unroll
    for (int q = 0; q < 8; ++q) { float* d = fs + (kr + 16 * q) * 129 + nn; d[0] = v[q][0]; d[1] = v[q][1]; d[2] = v[q][2]; d[3] = v[q][3]; } }
  __syncthreads();
  { const int nl = tid >> 4, kc = (tid & 15) * 8;
#pragma unroll
    for (int q = 0; q < 4; ++q) { const int n = nl + 32 * q;
      if (n0 + n < N) { float e[8];
#pragma unroll
        for (int i = 0; i < 8; ++i) e[i] = fs[(kc + i) * 129 + n];
        u32x4 w; w.x = cvt_pk_bf16(e[0], e[1]); w.y = cvt_pk_bf16(e[2], e[3]); w.z = cvt_pk_bf16(e[4], e[5]); w.w = cvt_pk_bf16(e[6], e[7]);
        *(u32x4*)(dst + (size_t)(n0 + n) * K + k0 + kc) = w; } } }
}
__device__ __forceinline__ void xpose_deferred(const Params& p, char* shm, int lo, int hi, int c0) {
  if ((int)blockIdx.x < c0) return;
  const int tid = otid();
  for (int t = lo + (int)blockIdx.x - c0; t < hi; t += (int)gridDim.x - c0) { __syncthreads(); xpose_tile(p, N_EARLY + t, (float*)shm, tid); }
}

__device__ __forceinline__ void phase0(const Params& p, char* shm) {
  const int tid = otid();
  float* fs = (float*)shm;
  bool cond_ready = false;
  const int n_xt0 = (gridDim.x == 256) ? N_EARLY : N_XT;
  const int T0_TOTAL = N_GEMV + n_xt0 + 8 + 1 + 1;
  for (int task = blockIdx.x; task < T0_TOTAL; task += gridDim.x) {
    __syncthreads();
    if (task < N_GEMV) {
      float* condS = fs;
      float* red = fs + 9 * 2048;
      if (!cond_ready) {
        for (int i = tid; i < 9 * 2048; i += 512) { const int r = i >> 11, k = i & 2047; const float v = r < 8 ? p.in[1][r * 2048 + k] : p.in[3][k]; condS[i] = v / (1.f + __expf(-v)); }
        cond_ready = true;
        __syncthreads();
      }
      const int l = task / 96, col0 = (task % 96) * 128;
      const int cp = (tid & 63) * 2, ks = tid >> 6;
      const float* W = p.in[4] + ((size_t)l * 2048 + ks * 256) * NMOD6 + col0 + cp;
      float a0[9], a1[9];
#pragma unroll
      for (int r = 0; r < 9; ++r) { a0[r] = 0.f; a1[r] = 0.f; }
      for (int k = 0; k < 256; k += 8) {
        f32x2 w[8];
#pragma unroll
        for (int u = 0; u < 8; ++u) w[u] = *(const f32x2*)(W + (size_t)(k + u) * NMOD6);
#pragma unroll
        for (int u = 0; u < 8; ++u) {
#pragma unroll
          for (int r = 0; r < 9; ++r) { const float cv = condS[r * 2048 + ks * 256 + k + u]; a0[r] = fmaf(cv, w[u].x, a0[r]); a1[r] = fmaf(cv, w[u].y, a1[r]); }
        }
      }
#pragma unroll
      for (int r = 0; r < 9; ++r) { red[(ks * 9 + r) * 128 + cp] = a0[r]; red[(ks * 9 + r) * 128 + cp + 1] = a1[r]; }
      __syncthreads();
      float* modv = (float*)(p.ws + OFF_MODV);
      for (int i = tid; i < 9 * 128; i += 512) { const int r = i >> 7, c = i & 127; float s = 0.f;
#pragma unroll
        for (int q = 0; q < 8; ++q) s += red[(q * 9 + r) * 128 + c];
        modv[((size_t)l * 9 + r) * NMOD6 + col0 + c] = s + p.in[5][(size_t)l * NMOD6 + col0 + c]; }
    } else if (task < N_GEMV + n_xt0) {
      xpose_tile(p, task - N_GEMV, fs, tid);
    } else if (task < N_GEMV + n_xt0 + 8) {
      const int blk = task - (N_GEMV + n_xt0);
      bf16_t* WL = (bf16_t*)(p.ws + OFF_WL) + (size_t)blk * 512 * 128;
      for (int i = tid; i < 512 * 128; i += 512) { const int n = i >> 7, k = i & 127; const int d = n >> 8, g = (n >> 7) & 1, jj = n & 127;
        const float v = (g ? p.in[17] : p.in[15])[(((size_t)d * 8 + blk) * 128 + k) * 128 + jj];
        WL[i] = (bf16_t)(cvt_pk_bf16(v, 0.f) & 0xffffu); }
    } else if (task == N_GEMV + n_xt0 + 8) {
      u32x4* z = (u32x4*)(p.ws + OFF_WD + (size_t)1088 * 2048 * 2);
      for (int i = tid; i < 192 * 2048 * 2 / 16; i += 512) z[i] = (u32x4){0u, 0u, 0u, 0u};
    } else {
      float* rt = (float*)(p.ws + OFF_ROPE);
      for (int i = tid; i < 1024; i += 512) { const int pos = i >> 4, f = i & 15; const float ang = (float)pos * p.inv[f]; rt[2 * i] = cosf(ang); rt[2 * i + 1] = sinf(ang); }
    }
  }
}

template <int MODE, bool FIX, bool LAT_F32, bool CTX_F32>
__device__ __forceinline__ void norm_rows(const void* src_lat, const void* src_ctx, int nrows, const float* gain, const float* shift, const float* scale, void* dst,
                                          bf16_t* xfix = nullptr, const float* part = nullptr) {
  const int tid_ = otid(); const int lane = tid_ & 63, wv = tid_ >> 6;
  f32x4 g[4][2];
#pragma unroll
  for (int i = 0; i < 4; ++i) { g[i][0] = *(const f32x4*)(gain + i * 512 + lane * 8); g[i][1] = *(const f32x4*)(gain + i * 512 + lane * 8 + 4); }
  for (int row = blockIdx.x * 8 + wv; row < nrows; row += gridDim.x * 8) {
    f32x4 v[4][2];
    const bool islat = row < ML;
    const bool f32src = islat ? LAT_F32 : CTX_F32;
    const void* sp = islat ? src_lat : src_ctx;
    if (f32src) { const float* s = (const float*)sp + (size_t)row * DM + lane * 8;
#pragma unroll
      for (int i = 0; i < 4; ++i) { v[i][0] = *(const f32x4*)(s + i * 512); v[i][1] = *(const f32x4*)(s + i * 512 + 4); } }
    else { const bf16_t* s = (const bf16_t*)sp + (size_t)row * DM + lane * 8;
#pragma unroll
      for (int i = 0; i < 4; ++i) { const u32x4 w = *(const u32x4*)(s + i * 512);
        v[i][0] = (f32x4){bflo(w.x), bfhi(w.x), bflo(w.y), bfhi(w.y)}; v[i][1] = (f32x4){bflo(w.z), bfhi(w.z), bflo(w.w), bfhi(w.w)}; } }
    if constexpr (FIX) { if (!islat) {
      const float* pp = part + (size_t)(row - ML) * DM + lane * 8;
#pragma unroll
      for (int q = 0; q < 4; ++q)
#pragma unroll
        for (int i = 0; i < 4; ++i) { v[i][0] += *(const f32x4*)(pp + (size_t)q * MC * DM + i * 512); v[i][1] += *(const f32x4*)(pp + (size_t)q * MC * DM + i * 512 + 4); }
#pragma unroll
      for (int i = 0; i < 4; ++i) { u32x4 o; o.x = cvt_pk_bf16(v[i][0][0], v[i][0][1]); o.y = cvt_pk_bf16(v[i][0][2], v[i][0][3]); o.z = cvt_pk_bf16(v[i][1][0], v[i][1][1]); o.w = cvt_pk_bf16(v[i][1][2], v[i][1][3]);
        *(u32x4*)(xfix + (size_t)row * DM + i * 512 + lane * 8) = o;
        v[i][0] = (f32x4){bflo(o.x), bfhi(o.x), bflo(o.y), bfhi(o.y)}; v[i][1] = (f32x4){bflo(o.z), bfhi(o.z), bflo(o.w), bfhi(o.w)}; } } }
    float ss = 0.f;
#pragma unroll
    for (int i = 0; i < 4; ++i)
#pragma unroll
      for (int h = 0; h < 2; ++h) ss += v[i][h][0] * v[i][h][0] + v[i][h][1] * v[i][h][1] + v[i][h][2] * v[i][h][2] + v[i][h][3] * v[i][h][3];
    ss = wave_sum(ss);
    const float rstd = rsqrtf(ss * (1.f / DM) + 1e-6f);
    if constexpr (MODE == 0) {
      const int b = islat ? (row >> 11) : 8;
      const float* sh = shift + (size_t)b * NMOD6 + lane * 8; const float* sc = scale + (size_t)b * NMOD6 + lane * 8;
      bf16_t* d = (bf16_t*)dst + (size_t)row * DM + lane * 8;
#pragma unroll
      for (int i = 0; i < 4; ++i) { f32x4 y[2];
#pragma unroll
        for (int h = 0; h < 2; ++h) { const f32x4 a = *(const f32x4*)(sh + i * 512 + 4 * h), c = *(const f32x4*)(sc + i * 512 + 4 * h);
          y[h] = v[i][h] * rstd * g[i][h]; y[h] = y[h] * (c + 1.f) + a; }
        u32x4 o; o.x = cvt_pk_bf16(y[0][0], y[0][1]); o.y = cvt_pk_bf16(y[0][2], y[0][3]); o.z = cvt_pk_bf16(y[1][0], y[1][1]); o.w = cvt_pk_bf16(y[1][2], y[1][3]);
        *(u32x4*)(d + i * 512) = o; }
    } else {
      float* d = (float*)dst + (size_t)row * DM + lane * 8;
#pragma unroll
      for (int i = 0; i < 4; ++i) { *(f32x4*)(d + i * 512) = v[i][0] * rstd * g[i][0]; *(f32x4*)(d + i * 512 + 4) = v[i][1] * rstd * g[i][1]; }
    }
  }
}

__device__ __forceinline__ void mla_norm_rows(const Params& p) {
  const int tid_ = otid(); const int lane = tid_ & 63, wv = tid_ >> 6;
  const bf16_t* QA = (const bf16_t*)(p.ws + OFF_QA); bf16_t* QN = (bf16_t*)(p.ws + OFF_QN); bf16_t* CK = (bf16_t*)(p.ws + OFF_CKVN); bf16_t* KPE = (bf16_t*)(p.ws + OFF_KPE);
  const float* rope = (const float*)(p.ws + OFF_ROPE);
  float gq[8], gk[8];
#pragma unroll
  for (int i = 0; i < 8; ++i) { gq[i] = p.in[22][lane * 8 + i]; gk[i] = p.in[24][lane * 8 + i]; }
  for (int row = blockIdx.x * 8 + wv; row < MT; row += gridDim.x * 8) {
    const bf16_t* s = QA + (size_t)row * 1280;
    const u32x4 cw = *(const u32x4*)(s + 512 + lane * 8);
    float c[8] = {bflo(cw.x), bfhi(cw.x), bflo(cw.y), bfhi(cw.y), bflo(cw.z), bfhi(cw.z), bflo(cw.w), bfhi(cw.w)};
    float ssc = 0.f;
#pragma unroll
    for (int i = 0; i < 8; ++i) ssc += c[i] * c[i];
    ssc = wave_sum(ssc);
    { const float rstd = rsqrtf(ssc * (1.f / 512.f) + 1e-6f); u32x4 w;
      w.x = cvt_pk_bf16(c[0] * rstd * gk[0], c[1] * rstd * gk[1]); w.y = cvt_pk_bf16(c[2] * rstd * gk[2], c[3] * rstd * gk[3]);
      w.z = cvt_pk_bf16(c[4] * rstd * gk[4], c[5] * rstd * gk[5]); w.w = cvt_pk_bf16(c[6] * rstd * gk[6], c[7] * rstd * gk[7]);
      *(u32x4*)(CK + (size_t)row * 512 + lane * 8) = w; }
    if (row < ML) {
      const u32x4 qw = *(const u32x4*)(s + lane * 8);
      float q[8] = {bflo(qw.x), bfhi(qw.x), bflo(qw.y), bfhi(qw.y), bflo(qw.z), bfhi(qw.z), bflo(qw.w), bfhi(qw.w)};
      float ssq = 0.f;
#pragma unroll
      for (int i = 0; i < 8; ++i) ssq += q[i] * q[i];
      ssq = wave_sum(ssq);
      const float rstd = rsqrtf(ssq * (1.f / 512.f) + 1e-6f); u32x4 w;
      w.x = cvt_pk_bf16(q[0] * rstd * gq[0], q[1] * rstd * gq[1]); w.y = cvt_pk_bf16(q[2] * rstd * gq[2], q[3] * rstd * gq[3]);
      w.z = cvt_pk_bf16(q[4] * rstd * gq[4], q[5] * rstd * gq[5]); w.w = cvt_pk_bf16(q[6] * rstd * gq[6], q[7] * rstd * gq[7]);
      *(u32x4*)(QN + (size_t)row * 512 + lane * 8) = w;
    }
    {
      const int l8 = lane & 7;
      const u32x4 kw = *(const u32x4*)(s + 1024 + l8 * 8);
      float k[8] = {bflo(kw.x), bfhi(kw.x), bflo(kw.y), bfhi(kw.y), bflo(kw.z), bfhi(kw.z), bflo(kw.w), bfhi(kw.w)};
      float o[8];
      if (row < ML) {
        const int tok = row & 2047; const int ax = l8 >> 2, half = (l8 >> 1) & 1; const int pos = ax == 0 ? (tok >> 6) : (tok & 63);
        const float* cs = rope + (size_t)(pos * 16 + (l8 & 1) * 8) * 2;
#pragma unroll
        for (int i = 0; i < 8; ++i) { const float other = __shfl_xor(k[i], 2, 64); const float co = cs[2 * i], si = cs[2 * i + 1];
          o[i] = half == 0 ? (k[i] * co - other * si) : (other * si + k[i] * co); }
      } else {
#pragma unroll
        for (int i = 0; i < 8; ++i) o[i] = k[i];
      }
      if (lane < 8) { u32x4 w; w.x = cvt_pk_bf16(o[0], o[1]); w.y = cvt_pk_bf16(o[2], o[3]); w.z = cvt_pk_bf16(o[4], o[5]); w.w = cvt_pk_bf16(o[6], o[7]);
        *(u32x4*)(KPE + (size_t)row * 64 + lane * 8) = w; }
    }
  }
}

constexpr int XCP = 136;
template <int REV, int EMIT>
__device__ __forceinline__ void lru_dir(const LAS bf16_t* XC, LAS float* HF, const bf16x8 (&Wr)[4], const bf16x8 (&Wi)[4], float ba, float bx, float sp8,
                                        float& carry, float& Atot, int tid, int wv, int fr, int fq, const LAS bf16_t* GE, bf16_t* Op,
                                        unsigned* SDp, const unsigned (&sd)[8][4]) {
  const int lane = fq * 16 + fr;
#pragma unroll
  for (int mm = 0; mm < 8; ++mm) {
    const int m = REV ? 7 - mm : mm;
    float av[4], uv[4];
    if constexpr (EMIT == 0) {
      f32x4 gr = {0.f, 0.f, 0.f, 0.f}, gi = {0.f, 0.f, 0.f, 0.f};
#pragma unroll
      for (int ks = 0; ks < 4; ++ks) {
        const bf16x8 a = *(const LAS bf16x8*)(XC + (16 * m + fr) * XCP + ks * 32 + fq * 8);
        gr = __builtin_amdgcn_mfma_f32_16x16x32_bf16(a, Wr[ks], gr, 0, 0, 0);
        gi = __builtin_amdgcn_mfma_f32_16x16x32_bf16(a, Wi[ks], gi, 0, 0, 0);
      }
#pragma unroll
      for (int j = 0; j < 4; ++j) {
        const float xc = bf2f(XC[(16 * m + 4 * fq + j) * XCP + 16 * wv + fr]);
        const float r = __builtin_amdgcn_rcpf(1.f + __builtin_amdgcn_exp2f(fmaf(gr[j], -1.4426950408889634f, ba)));
        const float ig = __builtin_amdgcn_rcpf(1.f + __builtin_amdgcn_exp2f(fmaf(gi[j], -1.4426950408889634f, bx)));
        const float la = -sp8 * r;
        const float a = __builtin_amdgcn_exp2f(la);
        av[j] = a;
        uv[j] = __builtin_amdgcn_sqrtf(fmaf(-a, a, 1.f)) * (ig * xc);
        SDp[(size_t)(16 * m + 4 * fq + j) * 1024] = cvt_pk_bf16(la, uv[j]);
      }
    } else {
#pragma unroll
      for (int j = 0; j < 4; ++j) { av[j] = __builtin_amdgcn_exp2f(bflo(sd[m][j])); uv[j] = bfhi(sd[m][j]); }
    }
    float s[4], P[4];
    if (!REV) { s[0] = uv[0]; P[0] = av[0];
#pragma unroll
      for (int j = 1; j < 4; ++j) { s[j] = fmaf(av[j], s[j - 1], uv[j]); P[j] = av[j] * P[j - 1]; } }
    else { s[3] = uv[3]; P[3] = av[3];
#pragma unroll
      for (int j = 2; j >= 0; --j) { s[j] = fmaf(av[j], s[j + 1], uv[j]); P[j] = av[j] * P[j + 1]; } }
    float A = REV ? P[0] : P[3], U = REV ? s[0] : s[3];
    { const int src = REV ? lane + 16 : lane - 16; const float Ap = __shfl(A, src & 63, 64), Up = __shfl(U, src & 63, 64);
      const bool on = REV ? (fq <= 2) : (fq >= 1); if (on) { U = fmaf(A, Up, U); A = A * Ap; } }
    { const int src = REV ? lane + 32 : lane - 32; const float Ap = __shfl(A, src & 63, 64), Up = __shfl(U, src & 63, 64);
      const bool on = REV ? (fq <= 1) : (fq >= 2); if (on) { U = fmaf(A, Up, U); A = A * Ap; } }
    float Ae, Ue;
    { const int src = REV ? lane + 16 : lane - 16; Ae = __shfl(A, src & 63, 64); Ue = __shfl(U, src & 63, 64);
      const bool first = REV ? (fq == 3) : (fq == 0); if (first) { Ae = 1.f; Ue = 0.f; } }
    const float cr = fmaf(Ae, carry, Ue);
    if (EMIT == 1) {
#pragma unroll
      for (int j = 0; j < 4; ++j) HF[(m * 4 + j) * 512 + tid] = fmaf(P[j], cr, s[j]);
    }
    if (EMIT == 2) {
#pragma unroll
      for (int j = 0; j < 4; ++j) { const float hsum = HF[(m * 4 + j) * 512 + tid] + fmaf(P[j], cr, s[j]);
        const int tl = 16 * m + 4 * fq + j;
        const float ge = bf2f(GE[tl * XCP + 16 * wv + fr]);
        Op[(size_t)tl * DM] = (bf16_t)(cvt_pk_bf16(hsum * ge, 0.f) & 0xffffu); }
    }
    const int lastl = REV ? fr : 48 + fr;
    const float At = __shfl(A, lastl, 64), Ut = __shfl(U, lastl, 64);
    carry = fmaf(At, carry, Ut); Atot *= At;
  }
}

template <int PASS>
__device__ __forceinline__ void lru_task(const Params& p, int task, char* shm) {
  const int tid = otid(), lane = tid & 63, wv = tid >> 6, fr = lane & 15, fq = lane >> 4;
  const int ci = task % 18, blk = (task / 18) & 7, b = task / 144;
  const bf16_t* P = (const bf16_t*)(p.ws + OFF_P);
  LAS bf16_t* XC = (LAS bf16_t*)shm;
  LAS float* HF = (LAS float*)(shm + 128 * XCP * 2);
  LAS bf16_t* GE = (LAS bf16_t*)(shm + 128 * XCP * 2 + 32 * 512 * 4);
  const int L = ci < 2 ? 256 : 2048, tl0 = ci < 2 ? ci * 128 : (ci - 2) * 128;
  const size_t rowbase = ci < 2 ? (size_t)ML + b * 256 : (size_t)b * 2048;
  const int ch = blk * 128 + 16 * wv + fr;
  unsigned* SD0 = (unsigned*)(p.ws + OFF_X) + (rowbase + tl0) * 1024 + ch;
  unsigned* SD1 = SD0 + (size_t)MT * 1024;
  float* LS = (float*)(p.ws + OFF_LSUM) + (size_t)((b * 8 + blk) * 18) * 2 * 128 * 2;
  bf16_t* Op = (bf16_t*)(p.ws + OFF_MIX) + (rowbase + tl0) * DM + 1024 + ch;
  __syncthreads();
  if constexpr (PASS == 1) {
    {
      const int cg = tid & 15; const int ch0 = blk * 128 + cg * 8;
      float cw[4][8], cb[8];
#pragma unroll
      for (int e = 0; e < 8; ++e) { cb[e] = p.in[14][ch0 + e];
#pragma unroll
        for (int tp = 0; tp < 4; ++tp) cw[tp][e] = p.in[13][tp * 1024 + ch0 + e]; }
      u32x4 wld[4][4];
#pragma unroll
      for (int it = 0; it < 4; ++it)
#pragma unroll
        for (int tp = 0; tp < 4; ++tp) { const int tl = tl0 + (tid >> 4) + 32 * it + tp - 2; const int tlc = min(max(tl, 0), L - 1);
          wld[it][tp] = *(const u32x4*)(P + (rowbase + tlc) * ABIN + 3072 + ch0); }
#pragma unroll
      for (int it = 0; it < 4; ++it) { const int t = (tid >> 4) + 32 * it; float acc[8];
#pragma unroll
        for (int e = 0; e < 8; ++e) acc[e] = cb[e];
#pragma unroll
        for (int tp = 0; tp < 4; ++tp) { const int tl = tl0 + t + tp - 2; const bool ok = (tl >= 0 && tl < L);
          const u32x4 w = wld[it][tp];
          const float x[8] = {bflo(w.x), bfhi(w.x), bflo(w.y), bfhi(w.y), bflo(w.z), bfhi(w.z), bflo(w.w), bfhi(w.w)};
#pragma unroll
          for (int e = 0; e < 8; ++e) acc[e] = fmaf(cw[tp][e], ok ? x[e] : 0.f, acc[e]); }
        u32x4 o; o.x = cvt_pk_bf16(acc[0], acc[1]); o.y = cvt_pk_bf16(acc[2], acc[3]); o.z = cvt_pk_bf16(acc[4], acc[5]); o.w = cvt_pk_bf16(acc[6], acc[7]);
        *(LAS u32x4*)(XC + t * XCP + cg * 8) = o; }
    }
    __syncthreads();
    const bf16_t* WL = (const bf16_t*)(p.ws + OFF_WL) + (size_t)blk * 512 * 128;
    const unsigned nosd[8][4] = {};
#pragma unroll
    for (int d = 0; d < 2; ++d) {
      bf16x8 Wr[4], Wi[4];
#pragma unroll
      for (int ks = 0; ks < 4; ++ks) { Wr[ks] = *(const bf16x8*)(WL + (size_t)(256 * d + 16 * wv + fr) * 128 + ks * 32 + fq * 8); Wi[ks] = *(const bf16x8*)(WL + (size_t)(256 * d + 128 + 16 * wv + fr) * 128 + ks * 32 + fq * 8); }
      const float ba = -1.4426950408889634f * p.in[16][1024 * d + ch], bx = -1.4426950408889634f * p.in[18][1024 * d + ch]; const float lam = p.in[19][1024 * d + ch];
      const float sp8 = 1.4426950408889634f * 8.f * (fmaxf(-lam, 0.f) + log1pf(__expf(-fabsf(lam))));
      float carry = 0.f, Atot = 1.f;
      if (d == 0) lru_dir<0, 0>(XC, HF, Wr, Wi, ba, bx, sp8, carry, Atot, tid, wv, fr, fq, GE, Op, SD0, nosd);
      else        lru_dir<1, 0>(XC, HF, Wr, Wi, ba, bx, sp8, carry, Atot, tid, wv, fr, fq, GE, Op, SD1, nosd);
      if (fq == 0) *(f32x2*)(LS + ((size_t)(ci * 2 + d) * 128 + 16 * wv + fr) * 2) = (f32x2){Atot, carry};
    }
  } else {
    unsigned sdf[8][4], sdr[8][4];
#pragma unroll
    for (int m = 0; m < 8; ++m)
#pragma unroll
      for (int j = 0; j < 4; ++j) { sdf[m][j] = SD0[(size_t)(16 * m + 4 * fq + j) * 1024]; sdr[m][j] = SD1[(size_t)(16 * m + 4 * fq + j) * 1024]; }
    {
      const int cg = tid & 15; const int ch0 = blk * 128 + cg * 8;
      u32x4 gl[4];
#pragma unroll
      for (int it = 0; it < 4; ++it) gl[it] = *(const u32x4*)(P + (rowbase + tl0 + (tid >> 4) + 32 * it) * ABIN + 4096 + ch0);
#pragma unroll
      for (int it = 0; it < 4; ++it) { const u32x4 w = gl[it];
        float x[8] = {bflo(w.x), bfhi(w.x), bflo(w.y), bfhi(w.y), bflo(w.z), bfhi(w.z), bflo(w.w), bfhi(w.w)};
#pragma unroll
        for (int e = 0; e < 8; ++e) { const float g = x[e]; const float z = 0.7978845608028654f * (g + 0.044715f * g * g * g); x[e] = g * __builtin_amdgcn_rcpf(1.f + __builtin_amdgcn_exp2f(-2.8853900817779268f * z)); }
        u32x4 o; o.x = cvt_pk_bf16(x[0], x[1]); o.y = cvt_pk_bf16(x[2], x[3]); o.z = cvt_pk_bf16(x[4], x[5]); o.w = cvt_pk_bf16(x[6], x[7]);
        *(LAS u32x4*)(GE + ((tid >> 4) + 32 * it) * XCP + cg * 8) = o; }
    }
    float carryF = 0.f, carryR = 0.f;
    { f32x2 su[17];
#pragma unroll
      for (int c2 = 0; c2 < 17; ++c2) su[c2] = (c2 < ci) ? *(const f32x2*)(LS + ((size_t)(c2 * 2 + 0) * 128 + 16 * wv + fr) * 2) : (f32x2){1.f, 0.f};
#pragma unroll
      for (int c2 = 0; c2 < 17; ++c2) carryF = fmaf(su[c2].x, carryF, su[c2].y); }
    { const int pos = ci < 2 ? (1 - ci) : (19 - ci);
      f32x2 su[17];
#pragma unroll
      for (int q = 0; q < 17; ++q) { const int c2 = q < 2 ? 1 - q : 19 - q; su[q] = (q < pos) ? *(const f32x2*)(LS + ((size_t)(c2 * 2 + 1) * 128 + 16 * wv + fr) * 2) : (f32x2){1.f, 0.f}; }
#pragma unroll
      for (int q = 0; q < 17; ++q) carryR = fmaf(su[q].x, carryR, su[q].y); }
    __syncthreads();
    const bf16x8 nw[4] = {};
    float At0 = 1.f, At1 = 1.f;
    lru_dir<0, 1>(XC, HF, nw, nw, 0.f, 0.f, 0.f, carryF, At0, tid, wv, fr, fq, GE, Op, SD0, sdf);
    lru_dir<1, 2>(XC, HF, nw, nw, 0.f, 0.f, 0.f, carryR, At1, tid, wv, fr, fq, GE, Op, SD1, sdr);
  }
}

__device__ __forceinline__ void na_task(const Params& p, int task, char* shm) {
  const int qb = task & 7, h = (task >> 3) & 7, b = task >> 6;
  const bf16_t* P = (const bf16_t*)(p.ws + OFF_P); bf16_t* MIX = (bf16_t*)(p.ws + OFF_MIX);
  __syncthreads();
  { float* tb = (float*)(shm + 2 * att::SHM_V + 2 * (64 * 128 * 2) + att::NW * 256) + 64;
    for (int i = otid(); i < 15 * 31; i += 512) tb[i] = p.in[12][h * 465 + i] * 11.313708498984761f; }
  att::Job J;
  J.Qb = P + (size_t)(b * 2048 + qb * 256) * ABIN + h * 128; J.ldq = ABIN;
  J.Kb = P + 1024 + h * 128; J.Vb = P + 2048 + h * 128; J.ldk = ABIN; J.Pe = nullptr;
  J.Ob = MIX + (size_t)(b * 2048 + qb * 256) * DM + h * 128; J.ldo = DM;
  const int r0 = qb * 4; const int lo = min(max(r0 - 4, 0), 24), hiw = min(max(r0 - 1, 0), 24) + 7;
  J.lo = lo; J.nwin = hiw - lo + 1; J.qb4 = r0;
  J.nA = 4; J.rowA = ML + b * 256; J.rowB = b * 2048 + lo * 64;
  J.NT = (4 + J.nwin + 1) & ~1;
  J.rope = nullptr; J.tok0 = 0;
  __syncthreads();
  att::attn_body<0>(J, shm);
}
__device__ __forceinline__ void ctxattn_task(const Params& p, int task, char* shm) {
  const int h = task & 7, b = task >> 3;
  const bf16_t* P = (const bf16_t*)(p.ws + OFF_P); bf16_t* MIX = (bf16_t*)(p.ws + OFF_MIX);
  __syncthreads();
  att::Job J;
  J.Qb = P + (size_t)(ML + b * 256) * ABIN + h * 128; J.ldq = ABIN;
  J.Kb = P + 1024 + h * 128; J.Vb = P + 2048 + h * 128; J.ldk = ABIN; J.Pe = nullptr;
  J.Ob = MIX + (size_t)(ML + b * 256) * DM + h * 128; J.ldo = DM;
  J.NT = 4; J.nA = 4; J.rowA = ML + b * 256; J.rowB = 0; J.qb4 = 0; J.lo = 0; J.nwin = 0; J.rope = nullptr; J.tok0 = 0;
  att::attn_body<1>(J, shm);
}
__device__ __forceinline__ void mla_task(const Params& p, int task, char* shm) {
  const int qb = task & 7, h = (task >> 3) & 15, b = task >> 7;
  const bf16_t* Q = (const bf16_t*)(p.ws + OFF_Q); const bf16_t* KV = (const bf16_t*)(p.ws + OFF_KV); bf16_t* ATT = (bf16_t*)(p.ws + OFF_H);
  __syncthreads();
  att::Job J;
  J.Qb = Q + (size_t)(b * 2048 + qb * 256) * 3072 + h * 192; J.ldq = 3072;
  J.Kb = KV + h * 256; J.Vb = KV + h * 256 + 128; J.ldk = 4096; J.Pe = (const bf16_t*)(p.ws + OFF_KPE);
  J.Ob = ATT + (size_t)(b * 2048 + qb * 256) * DM + h * 128; J.ldo = DM;
  J.NT = 36; J.nA = 32; J.rowA = b * 2048; J.rowB = ML + b * 256; J.qb4 = 0; J.lo = 0; J.nwin = 0;
  J.rope = (const float*)(p.ws + OFF_ROPE); J.tok0 = qb * 256;
  att::attn_body<2>(J, shm);
}

#define XB_TMO      128
#define XB_XCNT(j)  (256  + 64 * (j))
#define XB_XSUB(j)  (1280 + 64 * (j))
#define XB_XGEN(j)  (2304 + 64 * (j))
#define XB_TOP      3328
#define XB_TOPGEN   3392
#define XCD_BAR_WORDS 3456
#define XB_SPIN_CAP (1u << 18)
__device__ __forceinline__ unsigned xb_ld(unsigned* p)              { return __hip_atomic_load(p, __ATOMIC_RELAXED, __HIP_MEMORY_SCOPE_AGENT); }
__device__ __forceinline__ unsigned xb_add(unsigned* p, unsigned v) { return __hip_atomic_fetch_add(p, v, __ATOMIC_RELAXED, __HIP_MEMORY_SCOPE_AGENT); }
__device__ __forceinline__ unsigned xb_xcc_id() { return (unsigned)__builtin_amdgcn_s_getreg((3 << 11) | 20) & 0xFu; }
#define XB_SPIN(cond, bar) do { unsigned _sp = 0; while (cond) { __builtin_amdgcn_s_sleep(1); \
    if ((++_sp & 255u) == 0u) { if (xb_ld(&(bar)[XB_TMO])) break; if (_sp > XB_SPIN_CAP) { atomicAdd(&(bar)[XB_TMO], 1u); break; } } } } while (0)
struct XcdBarrier { unsigned* bar; unsigned x; volatile LAS unsigned* st; };
__device__ __forceinline__ XcdBarrier xcd_barrier_post(unsigned* bar, volatile LAS unsigned* st) {
  XcdBarrier b; b.bar = bar; b.x = xb_xcc_id(); b.st = st;
  if (threadIdx.x == 0) (void)xb_add(&bar[XB_XCNT(b.x)], 1u);
  return b;
}
__device__ __forceinline__ void xcd_barrier_complete(unsigned* bar, unsigned x, unsigned& nloc, unsigned& nx) {
  const unsigned G = gridDim.x * gridDim.y * gridDim.z;
  unsigned sum, cnt, mine, sp = 0u;
  for (;;) {
    sum = 0u; cnt = 0u; mine = 0u;
#pragma unroll
    for (unsigned j = 0; j < 16; ++j) { const unsigned c = xb_ld(&bar[XB_XCNT(j)]); sum += c; cnt += (c > 0u) ? 1u : 0u; mine = (j == x) ? c : mine; }
    if (sum == G) break;
    __builtin_amdgcn_s_sleep(1);
    if ((++sp & 255u) == 0u) { if (xb_ld(&bar[XB_TMO])) break; if (sp > XB_SPIN_CAP) { atomicAdd(&bar[XB_TMO], 1u); break; } }
  }
  nloc = mine > 0u ? mine : 1u; nx = cnt > 0u ? cnt : 1u;
}
__device__ __forceinline__ void xcd_barrier(const XcdBarrier& b) {
  asm volatile("s_waitcnt vmcnt(0)" ::: "memory");
  __syncthreads();
  if (threadIdx.x == 0) {
    unsigned* bar = b.bar;
    __builtin_amdgcn_s_waitcnt(0);
    unsigned nloc = b.st[0], nx = b.st[1];
    if (nloc == 0u) { xcd_barrier_complete(bar, b.x, nloc, nx); b.st[0] = nloc; b.st[1] = nx; }
    const unsigned old = xb_add(&bar[XB_XSUB(b.x)], 1u);
    const unsigned gen = old / nloc;
    if (old + 1u == (gen + 1u) * nloc) {
      __builtin_amdgcn_fence(__ATOMIC_RELEASE, "agent");
      asm volatile("s_waitcnt vmcnt(0)" ::: "memory");
      const unsigned og = xb_add(&bar[XB_TOP], 1u);
      const unsigned tg = og / nx;
      if (og + 1u == (tg + 1u) * nx) xb_add(&bar[XB_TOPGEN], 1u);
      else XB_SPIN(xb_ld(&bar[XB_TOPGEN]) == tg, bar);
      __builtin_amdgcn_fence(__ATOMIC_ACQUIRE, "agent");
      xb_add(&bar[XB_XGEN(b.x)], 1u);
      asm volatile("s_waitcnt vmcnt(0)" ::: "memory");
    } else {
      XB_SPIN(xb_ld(&bar[XB_XGEN(b.x)]) == gen, bar);
      __builtin_amdgcn_fence(__ATOMIC_ACQUIRE, "agent");
      asm volatile("s_waitcnt vmcnt(0)" ::: "memory");
    }
  }
  __syncthreads();
}

template <class Epi>
__device__ __forceinline__ void run_gemm(char* shm, const bf16_t* A, int lda, const bf16_t* Bt, int ldb, int K, int nM, int nN, const Epi& E) {
  pg8::Gemm g; g.A = A; g.Bt = Bt; g.lda = lda; g.ldb = ldb; g.K = K; g.nM = nM; g.nN = nN;
  pg8::StaticOrder S; S.init(nM, nN, gridDim.x, blockIdx.x);
  __syncthreads();
  pg8::gemm_phase<Epi, pg8::StaticOrder>((LAS unsigned char*)shm, g, S, E);
}
template <class Epi>
__device__ __forceinline__ void run_gemm_split(char* shm, const bf16_t* A, int lda, const bf16_t* Bt, int ldb, int K, int pm0, int nMs, int nN, int NS, const Epi& E) {
  pg8::Gemm g; g.A = A; g.Bt = Bt; g.lda = lda; g.ldb = ldb; g.K = K / NS; g.nM = nMs; g.nN = nN;
  pg8::SplitOrder S; S.init(pm0, nMs, nN, NS, K / NS, gridDim.x, blockIdx.x);
  __syncthreads();
  pg8::gemm_phase<Epi, pg8::SplitOrder>((LAS unsigned char*)shm, g, S, E);
}

#ifndef NO_MEGA
__global__ void __launch_bounds__(512, 2) fwd_megakernel(Params p) {
  extern __shared__ __attribute__((aligned(16))) char shm[];
  cg::grid_group grid = cg::this_grid();
  char* ws = p.ws;
  const float* modv = (const float*)(ws + OFF_MODV);
  bf16_t* X = (bf16_t*)(ws + OFF_X);
  bf16_t* H = (bf16_t*)(ws + OFF_H);

  volatile LAS unsigned* xst = (volatile LAS unsigned*)((LAS char*)shm + (LDS_BYTES - 16));
  if (threadIdx.x == 0) { xst[0] = 0u; xst[1] = 0u; }
  __syncthreads();
  const XcdBarrier xbar = xcd_barrier_post((unsigned*)(ws + OFF_BAR), xst);
  phase0(p, shm);
  grid.sync();
  norm_rows<0, false, true, true>(p.in[0], p.in[2] - (size_t)ML * DM, MT, p.in[6], modv + 0 * DM, modv + 1 * DM, H);
  xcd_barrier(xbar);
  { pg8::EpiBf16<0> E; E.O = (bf16_t*)(ws + OFF_P); E.ldc = ABIN;
    run_gemm(shm, H, DM, (const bf16_t*)(ws + OFF_WIN), DM, DM, MT / 256, ABIN / 256, E); }
  if (gridDim.x == 256) xpose_deferred(p, shm, 0, 2112, 160);
  xcd_barrier(xbar);
  for (int t = blockIdx.x; t < 512 + 64 + 1152; t += gridDim.x) {
    if (t < 512) na_task(p, t, shm);
    else if (t < 576) ctxattn_task(p, t - 512, shm);
    else lru_task<1>(p, t - 576, shm);
  }
  xcd_barrier(xbar);
  for (int t = blockIdx.x; t < 1152; t += gridDim.x) lru_task<2>(p, t, shm);
  xcd_barrier(xbar);
  { pg8::EpiResid<true> E; E.xin = p.in[0]; E.xout = X; E.gate = modv + 2 * DM;
    run_gemm(shm, (const bf16_t*)(ws + OFF_MIX), DM, (const bf16_t*)(ws + OFF_WOUT), DM, DM, ML / 256, DM / 256, E); }
  { pg8::EpiPartial E; E.part = (float*)(ws + OFF_PART); E.gate = modv + 2 * DM; E.kp2 = (DM / 4) * 2;
    run_gemm_split(shm, (const bf16_t*)(ws + OFF_MIX), DM, (const bf16_t*)(ws + OFF_WOUT), DM, DM, ML / 256, MC / 256, DM / 256, 4, E); }
  xcd_barrier(xbar);
  norm_rows<0, true, false, true>(X, p.in[2] - (size_t)ML * DM, MT, p.in[7], modv + 3 * DM, modv + 4 * DM, H, X, (const float*)(ws + OFF_PART));
  xcd_barrier(xbar);
  { pg8::EpiBf16<1> E; E.O = (bf16_t*)(ws + OFF_HID); E.ldc = DFF;
    run_gemm(shm, H, DM, (const bf16_t*)(ws + OFF_W1), DM, DM, MT / 256, DFF / 256, E); }
  xcd_barrier(xbar);
  { pg8::EpiResid<false> E; E.xin = X; E.xout = X; E.gate = modv + 5 * DM;
    run_gemm(shm, (const bf16_t*)(ws + OFF_HID), DFF, (const bf16_t*)(ws + OFF_W2), DFF, DFF, ML / 256, DM / 256, E); }
  { pg8::EpiPartial E; E.part = (float*)(ws + OFF_PART); E.gate = modv + 5 * DM; E.kp2 = (DFF / 4) * 2;
    run_gemm_split(shm, (const bf16_t*)(ws + OFF_HID), DFF, (const bf16_t*)(ws + OFF_W2), DFF, DFF, ML / 256, MC / 256, DM / 256, 4, E); }
  xcd_barrier(xbar);
  const float* modv1 = modv + (size_t)9 * NMOD6;
  norm_rows<0, true, false, false>(X, X, MT, p.in[6] + DM, modv1 + 0 * DM, modv1 + 1 * DM, H, X, (const float*)(ws + OFF_PART));
  xcd_barrier(xbar);
  { pg8::EpiBf16<0> E; E.O = (bf16_t*)(ws + OFF_QA); E.ldc = 1280;
    run_gemm(shm, H, DM, (const bf16_t*)(ws + OFF_WD), DM, DM, MT / 256, 1280 / 256, E); }
  if (gridDim.x == 256) xpose_deferred(p, shm, 2112, N_XT - N_EARLY, 104);
  xcd_barrier(xbar);
  mla_norm_rows(p);
  xcd_barrier(xbar);
  { pg8::EpiBf16<0> E; E.O = (bf16_t*)(ws + OFF_Q); E.ldc = 3072;
    run_gemm(shm, (const bf16_t*)(ws + OFF_QN), 512, (const bf16_t*)(ws + OFF_WUQ), 512, 512, ML / 256, 3072 / 256, E); }
  { pg8::EpiBf16<0> E; E.O = (bf16_t*)(ws + OFF_KV); E.ldc = 4096;
    run_gemm(shm, (const bf16_t*)(ws + OFF_CKVN), 512, (const bf16_t*)(ws + OFF_WUKV), 512, 512, MT / 256, 4096 / 256, E); }
  xcd_barrier(xbar);
  for (int t = blockIdx.x; t < 1024; t += gridDim.x) mla_task(p, t, shm);
  xcd_barrier(xbar);
  { pg8::EpiResid<false> E; E.xin = X; E.xout = X; E.gate = modv1 + 2 * DM;
    run_gemm(shm, H, DM, (const bf16_t*)(ws + OFF_WO), DM, DM, ML / 256, DM / 256, E); }
  xcd_barrier(xbar);
  norm_rows<0, false, false, false>(X, X, ML, p.in[7] + DM, modv1 + 3 * DM, modv1 + 4 * DM, H);
  xcd_barrier(xbar);
  { pg8::EpiBf16<1> E; E.O = (bf16_t*)(ws + OFF_HID); E.ldc = DFF;
    run_gemm(shm, H, DM, (const bf16_t*)(ws + OFF_W1 + (size_t)8192 * 2048 * 2), DM, DM, ML / 256, DFF / 256, E); }
  xcd_barrier(xbar);
  { pg8::EpiResid<false> E; E.xin = X; E.xout = X; E.gate = modv1 + 5 * DM;
    run_gemm(shm, (const bf16_t*)(ws + OFF_HID), DFF, (const bf16_t*)(ws + OFF_W2 + (size_t)2048 * 8192 * 2), DFF, DFF, ML / 256, DM / 256, E); }
  xcd_barrier(xbar);
  norm_rows<1, false, false, false>(X, X, ML, p.in[27], nullptr, nullptr, p.out);
}

extern "C" void kernel_launch(void* const* d_in, const int* in_sizes, int n_in, void* d_out, int out_size, void* d_ws, size_t ws_size, hipStream_t stream) {
  static int grid_blocks = 0;
  if (!grid_blocks) {
    if (n_in != 28 || ws_size < WS_NEED || out_size != ML * DM) { fprintf(stderr, "kernel_launch: unexpected shapes (n_in %d, ws %zu need %zu, out %d)\n", n_in, ws_size, (size_t)WS_NEED, out_size); return; }
    if (hipFuncSetAttribute((const void*)fwd_megakernel, hipFuncAttributeMaxDynamicSharedMemorySize, LDS_BYTES) != hipSuccess) { fprintf(stderr, "kernel_launch: LDS attribute failed\n"); return; }
    int dev = 0, cus = 0, per_cu = 0;
    hipGetDevice(&dev);
    hipDeviceGetAttribute(&cus, hipDeviceAttributeMultiprocessorCount, dev);
    hipOccupancyMaxActiveBlocksPerMultiprocessor(&per_cu, fwd_megakernel, 512, LDS_BYTES);
    if (per_cu < 1) { fprintf(stderr, "kernel_launch: occupancy query gave %d\n", per_cu); return; }
    grid_blocks = cus;
  }
  Params p{};
  for (int i = 0; i < 28; ++i) p.in[i] = (const float*)d_in[i];
  p.out = (float*)d_out; p.ws = (char*)d_ws;
  for (int i = 0; i < 16; ++i) p.inv[i] = (float)pow(10000.0, -(double)i / 16.0);
  hipMemsetAsync((char*)d_ws + OFF_BAR, 0, 16384, stream);
  void* args[] = {&p};
  hipError_t e = hipLaunchCooperativeKernel((void*)fwd_megakernel, dim3(grid_blocks), dim3(512), args, LDS_BYTES, stream);
  if (e != hipSuccess) fprintf(stderr, "cooperative launch failed: %s (grid %d)\n", hipGetErrorString(e), grid_blocks);
}
#endif
```

```cpp
#include <hip/hip_runtime.h>
#include <hip/hip_cooperative_groups.h>
#include <cstdio>
#include <cmath>
#include <cstdint>
namespace cg = cooperative_groups;

#define LAS __attribute__((address_space(3)))
typedef unsigned short bf16_t;
typedef short bf16x8 __attribute__((ext_vector_type(8)));
typedef short s16x4 __attribute__((ext_vector_type(4)));
typedef float f32x4 __attribute__((ext_vector_type(4)));
typedef float f32x2 __attribute__((ext_vector_type(2)));
typedef float f32x16 __attribute__((ext_vector_type(16)));
typedef unsigned u32x4 __attribute__((ext_vector_type(4)));
typedef unsigned u32x2 __attribute__((ext_vector_type(2)));

constexpr int DM = 2048, NBATCH = 8, SEQ = 2048, CTXL = 256, ML = NBATCH * SEQ, MC = NBATCH * CTXL, MT = ML + MC;
constexpr int DFF = 8192, ABIN = 5120, NMOD6 = 6 * DM;
constexpr int LDS_BYTES = 155648;

constexpr size_t OFF_WIN  = 0;
constexpr size_t OFF_WOUT = OFF_WIN  + (size_t)5120 * 2048 * 2;
constexpr size_t OFF_W1   = OFF_WOUT + (size_t)2048 * 2048 * 2;
constexpr size_t OFF_W2   = OFF_W1   + (size_t)2 * 8192 * 2048 * 2;
constexpr size_t OFF_WD   = OFF_W2   + (size_t)2 * 2048 * 8192 * 2;
constexpr size_t OFF_WUQ  = OFF_WD   + (size_t)1280 * 2048 * 2;
constexpr size_t OFF_WUKV = OFF_WUQ  + (size_t)3072 * 512 * 2;
constexpr size_t OFF_WO   = OFF_WUKV + (size_t)4096 * 512 * 2;
constexpr size_t OFF_WL   = OFF_WO   + (size_t)2048 * 2048 * 2;
constexpr size_t OFF_MODV = OFF_WL   + (size_t)8 * 512 * 128 * 2;
constexpr size_t OFF_ROPE = OFF_MODV + (size_t)2 * 9 * NMOD6 * 4;
constexpr size_t OFF_LSUM = OFF_ROPE + (size_t)64 * 16 * 2 * 4;
constexpr size_t OFF_X    = OFF_LSUM + (size_t)8 * 8 * 18 * 2 * 128 * 2 * 4;
constexpr size_t OFF_H    = OFF_X    + (size_t)MT * DM * 4;
constexpr size_t OFF_R    = OFF_H    + (size_t)MT * DM * 2;
constexpr size_t OFF_P    = OFF_R;
constexpr size_t OFF_MIX  = OFF_R + (size_t)MT * ABIN * 2;
constexpr size_t OFF_QA   = OFF_R;
constexpr size_t OFF_QN   = OFF_QA   + (size_t)MT * 1280 * 2;
constexpr size_t OFF_CKVN = OFF_QN   + (size_t)ML * 512 * 2;
constexpr size_t OFF_KPE  = OFF_CKVN + (size_t)MT * 512 * 2;
constexpr size_t OFF_Q    = OFF_KPE  + (size_t)MT * 64 * 2;
constexpr size_t OFF_KV   = OFF_Q    + (size_t)ML * 3072 * 2;
constexpr size_t WS_END   = OFF_KV   + (size_t)MT * 4096 * 2;
constexpr size_t OFF_HID  = OFF_R;
constexpr size_t OFF_PART = OFF_R + (size_t)MT * DFF * 2;
constexpr size_t OFF_BAR  = OFF_PART + (size_t)4 * MC * DM * 4;
constexpr size_t WS_NEED  = OFF_BAR + 16384;

struct Params {
  const float* in[28];
  float* out;
  char* ws;
  float inv[16];
};

__device__ __forceinline__ unsigned cvt_pk_bf16(float lo, float hi) { unsigned r; asm volatile("v_cvt_pk_bf16_f32 %0, %1, %2" : "=v"(r) : "v"(lo), "v"(hi)); return r; }
__device__ __forceinline__ float bf2f(bf16_t b) { return __uint_as_float(((unsigned)b) << 16); }
__device__ __forceinline__ float bflo(unsigned w) { return __uint_as_float(w << 16); }
__device__ __forceinline__ float bfhi(unsigned w) { return __uint_as_float(w & 0xffff0000u); }
__device__ __forceinline__ float wave_sum(float v) {
#pragma unroll
  for (int o = 32; o >= 1; o >>= 1) v += __shfl_xor(v, o, 64);
  return v;
}
__device__ __forceinline__ int otid() { int t = threadIdx.x; asm volatile("" : "+v"(t)); return t; }
__device__ __forceinline__ float sigmoidf_(float x) { return 1.f / (1.f + __expf(-x)); }

namespace pg8 {
constexpr int BM = 256, BK = 64, HALF = 128, HTB = HALF * BK * 2, NXCD = 8, WGM = 8;
__device__ __forceinline__ int lds_byte(int r, int c) { const int st = (r >> 4) * 2 + (c >> 5), rr = r & 15, cc = c & 31, ob = rr * 64 + cc * 2; return st * 1024 + (ob ^ (((ob >> 9) & 1) << 5)); }
__device__ __forceinline__ void stage_rc(int b, int& R, int& C) { const int st = b / 1024, sb = b % 1024, swz = sb ^ (((sb >> 9) & 1) << 5); R = (st >> 1) * 16 + swz / 64; C = (st & 1) * 32 + (swz % 64) / 2; }
__device__ __forceinline__ int perm32(int rho) { const int n = rho >> 4, i = rho & 15; return 8 * (i >> 2) + 4 * n + (i & 3); }
struct Unit { int pm, pn, kb; };
struct Gemm { const bf16_t* A; const bf16_t* Bt; int lda, ldb, K, nM, nN; };
struct StaticOrder {
  int nM, nN, nwg, G, c;
  __device__ void init(int nM_, int nN_, int G_, int c_) { nM = nM_; nN = nN_; nwg = nM * nN; G = G_; c = c_; }
  __device__ bool next(int i, Unit& u) const {
    const long L = (long)i * G + c; if (L >= nwg) return false;
    int wgid = (int)L; { const int q = nwg / NXCD, r = nwg % NXCD, xcd = wgid % NXCD, off = wgid / NXCD; wgid = (xcd < r ? xcd * (q + 1) : r * (q + 1) + (xcd - r) * q) + off; }
    const int nig = WGM * nN, gid = wgid / nig, fm = gid * WGM, gsz = (nM - fm) < WGM ? (nM - fm) : WGM;
    u.pm = fm + ((wgid % nig) % gsz); u.pn = (wgid % nig) / gsz; u.kb = 0; return true;
  }
};
struct SplitOrder {
  int pm0, nMs, nN, NS, Kp, nwg, G, c;
  __device__ void init(int pm0_, int nMs_, int nN_, int NS_, int Kp_, int G_, int c_) { pm0 = pm0_; nMs = nMs_; nN = nN_; NS = NS_; Kp = Kp_; nwg = nMs * nN * NS; G = G_; c = c_; }
  __device__ bool next(int i, Unit& u) const {
    const long L = (long)i * G + c; if (L >= nwg) return false;
    const int l = (int)L; const int part = l % NS, tile = l / NS;
    u.pm = pm0 + tile % nMs; u.pn = tile / nMs; u.kb = part * Kp * 2; return true;
  }
};

template <class Epi, class Sched, bool ALIGN_EPI = true>
__device__ __forceinline__ void gemm_phase(LAS unsigned char* lds, const Gemm g, const Sched& S, const Epi& E) {
  const int tid = otid(), wid = __builtin_amdgcn_readfirstlane(tid >> 6), lane = tid & 63, wr = wid >> 2, wc = wid & 3, fr = lane & 15, fq = lane >> 4;
  const int K = g.K, nt = K / BK;
  unsigned voffA[2], voffB[2];
#pragma unroll
  for (int i = 0; i < 2; ++i) { int R, C; stage_rc(tid * 16 + i * 8192, R, C); const int Rb = Epi::PERM ? ((R & ~31) + perm32(R & 31)) : R;
    voffA[i] = (unsigned)(R * g.lda + C) * 2u; voffB[i] = (unsigned)(Rb * g.ldb + C) * 2u; }
  const size_t kstep = (size_t)(BK * 2);
  const size_t hstepA = (size_t)HALF * g.lda * 2, hstepB = (size_t)HALF * g.ldb * 2;
  const size_t tstepA = 2 * hstepA, tstepB = 2 * hstepB;
  const unsigned ldsw = (unsigned)wid * 1024u;
  const int aoff = lds_byte(wr * 64 + fr, fq * 8), boff = lds_byte(wc * 32 + fr, fq * 8);
#define PG8_SA(b, h) (((b) * 2 + (h)) * HTB)
#define PG8_SB(b, h) ((4 + (b) * 2 + (h)) * HTB)
#define PG8_STAGE(bufoff, gbase, voff) do { _Pragma("unroll") for (int _i = 0; _i < 2; ++_i) \
    __builtin_amdgcn_global_load_lds((const unsigned*)((const char*)(gbase) + (voff)[_i]), (LAS unsigned*)(lds + (bufoff) + ldsw + _i * 8192), 16, 0, 0); } while (0)
#define PG8_LDA(dst, b, h) do { _Pragma("unroll") for (int m = 0; m < 4; ++m) _Pragma("unroll") for (int k = 0; k < 2; ++k) dst[m][k] = *(const LAS bf16x8*)(lds + PG8_SA(b, h) + aoff + m * 2048 + k * 1024); } while (0)
#define PG8_LDB(dst, b, h) do { _Pragma("unroll") for (int n = 0; n < 2; ++n) _Pragma("unroll") for (int k = 0; k < 2; ++k) dst[n][k] = *(const LAS bf16x8*)(lds + PG8_SB(b, h) + boff + n * 2048 + k * 1024); } while (0)
#define PG8_MMA(ai, bj, At, Bt) do { __builtin_amdgcn_s_setprio(1); _Pragma("unroll") for (int m = 0; m < 4; ++m) _Pragma("unroll") for (int n = 0; n < 2; ++n) _Pragma("unroll") for (int k = 0; k < 2; ++k) \
    acc[ai][bj][m][n] = __builtin_amdgcn_mfma_f32_16x16x32_bf16(Bt[n][k], At[m][k], acc[ai][bj][m][n], 0, 0, 0); __builtin_amdgcn_s_setprio(0); } while (0)
#define PG8_WAIT_V(n) asm volatile("s_waitcnt vmcnt(" #n ")" ::: "memory")
#define PG8_WAIT_L(n) asm volatile("s_waitcnt lgkmcnt(" #n ")" ::: "memory")
#define PG8_BAR __builtin_amdgcn_s_barrier()
#define PG8_SCHED __builtin_amdgcn_sched_barrier(0)
  Unit cur, nxt; int ui = 0;
  if (!S.next(0, cur)) return;
  f32x4 acc[2][2][4][2];
#pragma unroll
  for (int a = 0; a < 2; ++a)
#pragma unroll
    for (int b = 0; b < 2; ++b)
#pragma unroll
      for (int m = 0; m < 4; ++m)
#pragma unroll
        for (int n = 0; n < 2; ++n) acc[a][b][m][n] = (f32x4){0.f, 0.f, 0.f, 0.f};
  bf16x8 At[4][2], B0[2][2], B1[2][2];
  const char* cA = (const char*)g.A + (size_t)cur.pm * tstepA + cur.kb; const char* cB = (const char*)g.Bt + (size_t)cur.pn * tstepB + cur.kb;
  PG8_STAGE(PG8_SB(0, 0), cB, voffB); PG8_STAGE(PG8_SB(0, 1), cB + hstepB, voffB); PG8_STAGE(PG8_SA(0, 0), cA, voffA); PG8_STAGE(PG8_SA(0, 1), cA + hstepA, voffA);
  if (wr == 1) PG8_BAR;
  PG8_WAIT_V(2); PG8_BAR;
  PG8_STAGE(PG8_SB(1, 0), cB + kstep, voffB); PG8_STAGE(PG8_SA(1, 0), cA + kstep, voffA); PG8_STAGE(PG8_SB(1, 1), cB + hstepB + kstep, voffB);
  PG8_WAIT_V(6); PG8_BAR;
  for (;;) {
    const bool has_next = S.next(ui + 1, nxt);
    const char* nA = has_next ? (const char*)g.A + (size_t)nxt.pm * tstepA + nxt.kb : cA; const char* nB = has_next ? (const char*)g.Bt + (size_t)nxt.pn * tstepB + nxt.kb : cB;
    for (int t = 0; t < nt; t += 2) {
      const bool last = (t == nt - 2);
      const char* a1 = cA + (size_t)(t + 1) * kstep;
      const char* a2 = last ? nA : cA + (size_t)(t + 2) * kstep; const char* b2 = last ? nB : cB + (size_t)(t + 2) * kstep;
      const char* a3 = a2 + kstep; const char* b3 = b2 + kstep;
      PG8_LDB(B0, 0, 0); PG8_LDB(B1, 0, 1); PG8_SCHED; PG8_LDA(At, 0, 0); PG8_STAGE(PG8_SA(1, 1), a1 + hstepA, voffA);
      PG8_WAIT_V(8); PG8_WAIT_L(0); PG8_BAR; PG8_MMA(0, 0, At, B0); PG8_MMA(0, 1, At, B1); PG8_BAR; PG8_SCHED;
      PG8_LDA(At, 0, 1); PG8_STAGE(PG8_SB(0, 0), b2, voffB); PG8_STAGE(PG8_SB(0, 1), b2 + hstepB, voffB); PG8_STAGE(PG8_SA(0, 0), a2, voffA);
      PG8_WAIT_V(8); PG8_WAIT_L(0); PG8_BAR; PG8_MMA(1, 0, At, B0); PG8_MMA(1, 1, At, B1); PG8_BAR; PG8_SCHED;
      PG8_LDB(B0, 1, 0); PG8_LDB(B1, 1, 1); PG8_SCHED; PG8_LDA(At, 1, 0); PG8_STAGE(PG8_SA(0, 1), a2 + hstepA, voffA);
      PG8_WAIT_V(8); PG8_WAIT_L(0); PG8_BAR; PG8_MMA(0, 0, At, B0); PG8_MMA(0, 1, At, B1); PG8_BAR; PG8_SCHED;
      PG8_LDA(At, 1, 1); PG8_STAGE(PG8_SB(1, 0), b3, voffB); PG8_STAGE(PG8_SB(1, 1), b3 + hstepB, voffB); PG8_STAGE(PG8_SA(1, 0), a3, voffA);
      PG8_WAIT_V(8); PG8_WAIT_L(0); PG8_BAR; PG8_MMA(1, 0, At, B0); PG8_MMA(1, 1, At, B1); PG8_BAR; PG8_SCHED;
    }
    if constexpr (ALIGN_EPI) { if (wr == 0) PG8_BAR; }
    E(acc, cur, wr, wc, fr, fq);
    if (!has_next) break;
#pragma unroll
    for (int a = 0; a < 2; ++a)
#pragma unroll
      for (int b = 0; b < 2; ++b)
#pragma unroll
        for (int m = 0; m < 4; ++m)
#pragma unroll
          for (int n = 0; n < 2; ++n) acc[a][b][m][n] = (f32x4){0.f, 0.f, 0.f, 0.f};
    cur = nxt; cA = nA; cB = nB; ++ui;
    if constexpr (ALIGN_EPI) { if (wr == 1) PG8_BAR; }
  }
  PG8_WAIT_V(0);
  if constexpr (!ALIGN_EPI) { if (wr == 0) PG8_BAR; }
  PG8_BAR;
#undef PG8_SA
#undef PG8_SB
#undef PG8_STAGE
#undef PG8_LDA
#undef PG8_LDB
#undef PG8_MMA
#undef PG8_WAIT_V
#undef PG8_WAIT_L
#undef PG8_BAR
#undef PG8_SCHED
}

template <int ACT  > struct EpiBf16 {
  static constexpr bool PERM = true;
  bf16_t* O; int ldc;
  __device__ __forceinline__ void operator()(const f32x4 (&acc)[2][2][4][2], const Unit& u, int wr, int wc, int fr, int fq) const {
    const int row0 = u.pm * BM + wr * 64 + fr, col0 = u.pn * BM + wc * 32 + 8 * fq;
#pragma unroll
    for (int ai = 0; ai < 2; ++ai)
#pragma unroll
      for (int m = 0; m < 4; ++m) { bf16_t* rowp = O + (size_t)(row0 + ai * HALF + m * 16) * ldc + col0;
#pragma unroll
        for (int bj = 0; bj < 2; ++bj) { f32x4 v0 = acc[ai][bj][m][0], v1 = acc[ai][bj][m][1];
          if (ACT == 1) {
#pragma unroll
            for (int j = 0; j < 4; ++j) { float a = fmaxf(v0[j], 0.f), b = fmaxf(v1[j], 0.f); v0[j] = a * a; v1[j] = b * b; } }
          u32x4 w; w.x = cvt_pk_bf16(v0[0], v0[1]); w.y = cvt_pk_bf16(v0[2], v0[3]); w.z = cvt_pk_bf16(v1[0], v1[1]); w.w = cvt_pk_bf16(v1[2], v1[3]);
          *(u32x4*)(rowp + bj * HALF) = w; } }
  }
};
template <bool XIN_F32> struct EpiResid {
  static constexpr bool PERM = true;
  const void* xin; bf16_t* xout; const float* gate;
  __device__ __forceinline__ void operator()(const f32x4 (&acc)[2][2][4][2], const Unit& u, int wr, int wc, int fr, int fq) const {
    const int rowt = u.pm * BM; const int b = rowt >> 11;
    const int row0 = rowt + wr * 64 + fr, col0 = u.pn * BM + wc * 32 + 8 * fq;
    f32x4 gv[2][2];
#pragma unroll
    for (int bj = 0; bj < 2; ++bj)
#pragma unroll
      for (int n = 0; n < 2; ++n) gv[bj][n] = *(const f32x4*)(gate + (size_t)b * NMOD6 + col0 + bj * HALF + 4 * n);
#pragma unroll
    for (int ai = 0; ai < 2; ++ai)
#pragma unroll
      for (int m = 0; m < 4; ++m) { const size_t ro = (size_t)(row0 + ai * HALF + m * 16) * DM + col0;
#pragma unroll
        for (int bj = 0; bj < 2; ++bj) { f32x4 x0, x1;
          if constexpr (XIN_F32) { x0 = *(const f32x4*)((const float*)xin + ro + bj * HALF); x1 = *(const f32x4*)((const float*)xin + ro + bj * HALF + 4); }
          else { const u32x4 w = *(const u32x4*)((const bf16_t*)xin + ro + bj * HALF);
            x0 = (f32x4){bflo(w.x), bfhi(w.x), bflo(w.y), bfhi(w.y)}; x1 = (f32x4){bflo(w.z), bfhi(w.z), bflo(w.w), bfhi(w.w)}; }
          const f32x4 v0 = x0 + gv[bj][0] * acc[ai][bj][m][0], v1 = x1 + gv[bj][1] * acc[ai][bj][m][1];
          u32x4 o; o.x = cvt_pk_bf16(v0[0], v0[1]); o.y = cvt_pk_bf16(v0[2], v0[3]); o.z = cvt_pk_bf16(v1[0], v1[1]); o.w = cvt_pk_bf16(v1[2], v1[3]);
          *(u32x4*)(xout + ro + bj * HALF) = o; } }
  }
};
struct EpiPartial {
  static constexpr bool PERM = false;
  float* part; const float* gate; int kp2;
  __device__ __forceinline__ void operator()(const f32x4 (&acc)[2][2][4][2], const Unit& u, int wr, int wc, int fr, int fq) const {
    const int row0 = u.pm * BM - ML + wr * 64 + fr, col0 = u.pn * BM + wc * 32 + 4 * fq;
    float* base = part + (size_t)(u.kb / kp2) * MC * DM;
    f32x4 gv[2][2];
#pragma unroll
    for (int bj = 0; bj < 2; ++bj)
#pragma unroll
      for (int n = 0; n < 2; ++n) gv[bj][n] = *(const f32x4*)(gate + (size_t)8 * NMOD6 + col0 + bj * HALF + n * 16);
#pragma unroll
    for (int ai = 0; ai < 2; ++ai)
#pragma unroll
      for (int m = 0; m < 4; ++m) { const size_t ro = (size_t)(row0 + ai * HALF + m * 16) * DM + col0;
#pragma unroll
        for (int bj = 0; bj < 2; ++bj)
#pragma unroll
          for (int n = 0; n < 2; ++n) *(f32x4*)(base + ro + bj * HALF + n * 16) = gv[bj][n] * acc[ai][bj][m][n]; }
  }
};
}

namespace att {
constexpr int NW = 8, QBLK = 32, KVBLK = 64;
constexpr size_t SHM_V = KVBLK * 128 * 2;
#define SBAR() __builtin_amdgcn_sched_barrier(0)
__device__ __forceinline__ int crow(int r, int hi) { return (r & 3) + 8 * (r >> 2) + 4 * hi; }

__device__ __forceinline__ void partialSM(f32x16& p0, f32x16& p1, float& m_reg, float& mn, float& alpha, const float C, const float THRS) {
  float pmax = p0[0];
#pragma unroll
  for (int r = 1; r < 16; ++r) pmax = fmaxf(pmax, p0[r]);
#pragma unroll
  for (int r = 0; r < 16; ++r) pmax = fmaxf(pmax, p1[r]);
  { auto rr = __builtin_amdgcn_permlane32_swap(__float_as_uint(pmax), __float_as_uint(pmax), false, false);
    pmax = fmaxf(__uint_as_float(rr[0]), __uint_as_float(rr[1])); }
  if (__builtin_expect(__all(pmax - m_reg <= THRS), 1)) { mn = m_reg; alpha = 1.f; }
  else { mn = fmaxf(m_reg, pmax); alpha = __builtin_amdgcn_exp2f((m_reg - mn) * C); m_reg = mn; }
  float mnC = -mn * C;
#pragma unroll
  for (int r = 0; r < 16; ++r) p0[r] = fmaf(p0[r], C, mnC);
#pragma unroll
  for (int r = 0; r < 16; ++r) p1[r] = fmaf(p1[r], C, mnC);
#pragma unroll
  for (int r = 0; r < 16; ++r) p0[r] = __builtin_amdgcn_exp2f(p0[r]);
}
__device__ __forceinline__ void finishSM(f32x16& p0, f32x16& p1, float alpha, float& l_reg, bf16x8& pa0, bf16x8& pa1, bf16x8& pa2, bf16x8& pa3) {
#pragma unroll
  for (int r = 0; r < 16; ++r) p1[r] = __builtin_amdgcn_exp2f(p1[r]);
  float ps = 0;
#pragma unroll
  for (int r = 0; r < 16; ++r) ps += p0[r];
#pragma unroll
  for (int r = 0; r < 16; ++r) ps += p1[r];
  { auto rr = __builtin_amdgcn_permlane32_swap(__float_as_uint(ps), __float_as_uint(ps), false, false);
    ps = __uint_as_float(rr[0]) + __uint_as_float(rr[1]); }
  l_reg = l_reg * alpha + ps;
#define PK4(P, BASE, OUT) do { unsigned a0 = cvt_pk_bf16(P[BASE + 0], P[BASE + 1]), a1 = cvt_pk_bf16(P[BASE + 2], P[BASE + 3]);   \
    unsigned b0 = cvt_pk_bf16(P[BASE + 4], P[BASE + 5]), b1 = cvt_pk_bf16(P[BASE + 6], P[BASE + 7]);                              \
    auto r0 = __builtin_amdgcn_permlane32_swap(a0, b0, false, false); auto r1 = __builtin_amdgcn_permlane32_swap(a1, b1, false, false); \
    u32x4 w = {r0[0], r1[0], r0[1], r1[1]}; OUT = *reinterpret_cast<bf16x8*>(&w); } while (0)
  PK4(p0, 0, pa0); PK4(p0, 8, pa1); PK4(p1, 0, pa2); PK4(p1, 8, pa3);
#undef PK4
}
template <int DQK>
__device__ __forceinline__ void qkt(f32x16& p0, f32x16& p1, const char* Ks, const bf16x8* qr, const char* ql, int r32, int hi) {
  p0 = f32x16{}; p1 = f32x16{};
#pragma unroll
  for (int d0 = 0; d0 < DQK / 16; ++d0) { const int cb = (d0 * 16 + hi * 8) * 2;
    bf16x8 b0 = *reinterpret_cast<const bf16x8*>(Ks + r32 * (DQK * 2) + (cb ^ ((r32 & 7) << 4)));
    bf16x8 b1 = *reinterpret_cast<const bf16x8*>(Ks + (32 + r32) * (DQK * 2) + (cb ^ ((r32 & 7) << 4)));
    constexpr int NQR = DQK == 192 ? 4 : 8;
    bf16x8 qv; if (d0 < NQR) qv = qr[d0 < NQR ? d0 : 0]; else qv = *reinterpret_cast<const bf16x8*>(ql + (d0 - NQR) * 1024);
    p0 = __builtin_amdgcn_mfma_f32_32x32x16_bf16(b0, qv, p0, 0, 0, 0);
    p1 = __builtin_amdgcn_mfma_f32_32x32x16_bf16(b1, qv, p1, 0, 0, 0); }
}
__device__ __forceinline__ int v_st(int k, int c) { const int kk = (k & ~0xC) | ((k & 4) << 1) | ((k & 8) >> 1); return ((kk >> 3) * 4 + (c >> 5)) * 512 + ((kk & 7) * 32 + (c & 31)) * 2; }
__device__ __forceinline__ int v_rd_base(int lane) { return ((lane & 3) << 3) | (((lane >> 2) & 3) << 6) | (((lane >> 4) & 1) << 5) | (((lane >> 5) & 1) << 8); }
constexpr int v_rd_off(int d0, int ks, int half) { return d0 * 512 + ks * 4096 + half * 2048; }
template <int OFF> __device__ __forceinline__ s16x4 tr_read(int vb) {
  s16x4 r; asm volatile("ds_read_b64_tr_b16 %0, %1 offset:%2" : "=&v"(r) : "v"(vb), "i"(OFF) : "memory"); return r;
}
template <int D0> __device__ __forceinline__ void pv_one(f32x16& od, int vb, bf16x8 pa0, bf16x8 pa1, bf16x8 pa2, bf16x8 pa3) {
  const s16x4 l0 = tr_read<v_rd_off(D0, 0, 0)>(vb), h0 = tr_read<v_rd_off(D0, 0, 1)>(vb), l1 = tr_read<v_rd_off(D0, 1, 0)>(vb), h1 = tr_read<v_rd_off(D0, 1, 1)>(vb);
  const s16x4 l2 = tr_read<v_rd_off(D0, 2, 0)>(vb), h2 = tr_read<v_rd_off(D0, 2, 1)>(vb), l3 = tr_read<v_rd_off(D0, 3, 0)>(vb), h3 = tr_read<v_rd_off(D0, 3, 1)>(vb);
  asm volatile("s_waitcnt lgkmcnt(0)" ::: "memory"); SBAR();
#define PK(L, H) (bf16x8){L[0], L[1], L[2], L[3], H[0], H[1], H[2], H[3]}
  od = __builtin_amdgcn_mfma_f32_32x32x16_bf16(pa0, PK(l0, h0), od, 0, 0, 0);
  od = __builtin_amdgcn_mfma_f32_32x32x16_bf16(pa1, PK(l1, h1), od, 0, 0, 0);
  od = __builtin_amdgcn_mfma_f32_32x32x16_bf16(pa2, PK(l2, h2), od, 0, 0, 0);
  od = __builtin_amdgcn_mfma_f32_32x32x16_bf16(pa3, PK(l3, h3), od, 0, 0, 0);
#undef PK
}
__device__ __forceinline__ void pv_d0(f32x16* o, int vb, bf16x8 pa0, bf16x8 pa1, bf16x8 pa2, bf16x8 pa3) {
  pv_one<0>(o[0], vb, pa0, pa1, pa2, pa3); pv_one<1>(o[1], vb, pa0, pa1, pa2, pa3); pv_one<2>(o[2], vb, pa0, pa1, pa2, pa3); pv_one<3>(o[3], vb, pa0, pa1, pa2, pa3);
}

struct Job {
  const bf16_t* Qb; int ldq;
  const bf16_t* Kb; const bf16_t* Vb; int ldk;
  const bf16_t* Pe;
  bf16_t* Ob; int ldo;
  int NT;
  int rowA, nA, rowB;
  int qb4;
  int lo, nwin;
  const float* rope; int tok0;
};

template <int MODE>
__device__ __forceinline__ void attn_body(const Job J, char* lds) {
  constexpr int DQK = (MODE == 2) ? 192 : 128;
  constexpr size_t SHM_K = KVBLK * DQK * 2;
  constexpr float SCALE = (MODE == 2) ? 0.07216878364870323f : 0.08838834764831845f;
  constexpr float C = SCALE * 1.4426950408889634f;
  constexpr float THRS = 8.f / SCALE;
  const int tid = otid(), wid = tid >> 6, lane = tid & 63, r32 = lane & 31, hi = lane >> 5;
  char* V_lds = lds; char* K_lds = lds + 2 * SHM_V;
  float* wsf = (float*)(lds + 2 * SHM_V + 2 * SHM_K) + wid * 64; float* li_l = wsf; float* al_l = wsf + 32;
  const float* tab = (const float*)(lds + 2 * SHM_V + 2 * SHM_K + NW * 256) + 64;
  constexpr int NQR = (MODE == 2) ? 4 : 8;
  float m_reg = -1e30f, l_reg = 0; f32x16 o[4] = {}; bf16x8 qr[NQR];
  const bf16_t* Qw = J.Qb + (size_t)(wid * QBLK + r32) * J.ldq + hi * 8;
  char* ql = lds + 2 * SHM_V + 2 * SHM_K + NW * 256 + (wid * 8 * 64 + lane) * 16;
#pragma unroll
  for (int d0 = 0; d0 < NQR; ++d0) qr[d0] = *reinterpret_cast<const bf16x8*>(Qw + d0 * 16);
  if constexpr (MODE == 2) {
#pragma unroll
    for (int d0 = 4; d0 < 8; ++d0) *reinterpret_cast<bf16x8*>(ql + (d0 - 4) * 1024) = *reinterpret_cast<const bf16x8*>(Qw + d0 * 16);
    const int tok = J.tok0 + wid * QBLK + r32; const int prow = tok >> 6, pcol = tok & 63;
#pragma unroll
    for (int ax = 0; ax < 2; ++ax) {
      const float* cs = J.rope + (size_t)((ax == 0 ? prow : pcol) * 16 + hi * 8) * 2;
      bf16x8 x1 = *reinterpret_cast<const bf16x8*>(Qw + (8 + 2 * ax) * 16), x2 = *reinterpret_cast<const bf16x8*>(Qw + (9 + 2 * ax) * 16); u32x4 w1, w2;
#pragma unroll
      for (int i = 0; i < 4; ++i) {
        const f32x4 t = *(const f32x4*)(cs + 4 * i);
        const float a0 = bf2f((bf16_t)x1[2 * i]), a1 = bf2f((bf16_t)x1[2 * i + 1]), b0 = bf2f((bf16_t)x2[2 * i]), b1 = bf2f((bf16_t)x2[2 * i + 1]);
        w1[i] = cvt_pk_bf16(a0 * t[0] - b0 * t[1], a1 * t[2] - b1 * t[3]);
        w2[i] = cvt_pk_bf16(a0 * t[1] + b0 * t[0], a1 * t[3] + b1 * t[2]);
      }
      *reinterpret_cast<u32x4*>(ql + (4 + 2 * ax) * 1024) = w1; *reinterpret_cast<u32x4*>(ql + (5 + 2 * ax) * 1024) = w2;
    }
  }
  const int sr = tid >> 4, sc = (tid & 15) * 8, vst0 = v_st(sr, sc), vst1 = v_st(32 + sr, sc);
  const int pr = tid >> 3, pc = (tid & 7) * 8;
  const int vb0 = (int)(uintptr_t)V_lds + v_rd_base(lane);
  bf16x8 vs0, vs1, ks0, ks1, kp;
  const int rq = J.qb4 + (wid >> 1), qc = (wid & 1) * 32 + r32;
  const int rs = min(max(rq - 4, 0), 24), cs_ = min(max(qc - 8, 0), 48);
#define TROW(t) ((t) < J.nA ? J.rowA + 64 * (t) : J.rowB + 64 * ((t) - J.nA))
#define SLOAD(t) do { const int _r0 = TROW(t); \
    vs0 = *reinterpret_cast<const bf16x8*>(J.Vb + (size_t)(_r0 + sr) * J.ldk + sc); vs1 = *reinterpret_cast<const bf16x8*>(J.Vb + (size_t)(_r0 + 32 + sr) * J.ldk + sc); \
    ks0 = *reinterpret_cast<const bf16x8*>(J.Kb + (size_t)(_r0 + sr) * J.ldk + sc); ks1 = *reinterpret_cast<const bf16x8*>(J.Kb + (size_t)(_r0 + 32 + sr) * J.ldk + sc); \
    if constexpr (MODE == 2) kp = *reinterpret_cast<const bf16x8*>(J.Pe + (size_t)(_r0 + pr) * 64 + pc); } while (0)
#define SWRITE(b) do { *(bf16x8*)(V_lds + (b) * SHM_V + vst0) = vs0; *(bf16x8*)(V_lds + (b) * SHM_V + vst1) = vs1; const int kc = sc * 2; \
    *(bf16x8*)(K_lds + (b) * SHM_K + sr * (DQK * 2) + (kc ^ ((sr & 7) << 4))) = ks0; \
    *(bf16x8*)(K_lds + (b) * SHM_K + (32 + sr) * (DQK * 2) + (kc ^ ((sr & 7) << 4))) = ks1; \
    if constexpr (MODE == 2) *(bf16x8*)(K_lds + (b) * SHM_K + pr * (DQK * 2) + (((128 + pc) * 2) ^ ((pr & 7) << 4))) = kp; } while (0)
#define SWAIT() asm volatile("s_waitcnt vmcnt(0)" ::: "memory")
#define RESC(a) do { if (__any((a) < 1.f)) { if (hi == 0) al_l[r32] = (a); asm volatile("s_waitcnt lgkmcnt(0)" ::: "memory"); \
    _Pragma("unroll") for (int d = 0; d < 4; ++d) _Pragma("unroll") for (int r = 0; r < 16; ++r) o[d][r] *= al_l[crow(r, hi)]; } } while (0)
#define MASK(P0, P1, t) do { if constexpr (MODE == 0) { if ((t) >= J.nA) { const int _w = (t) - J.nA; const int _kr = J.lo + _w; \
      if (_w < J.nwin && _kr >= rs && _kr < rs + 8) { const float* _tr = tab + (_kr - rq + 7) * 31 + 15 - qc; \
        _Pragma("unroll") for (int r = 0; r < 16; ++r) { const int kc0 = crow(r, hi); \
          const float b0 = _tr[kc0], b1 = _tr[kc0 + 32]; \
          P0[r] = ((unsigned)(kc0 - cs_) < 16u) ? P0[r] + b0 : -1e30f; P1[r] = ((unsigned)(kc0 + 32 - cs_) < 16u) ? P1[r] + b1 : -1e30f; } } \
      else { _Pragma("unroll") for (int r = 0; r < 16; ++r) { P0[r] = -1e30f; P1[r] = -1e30f; } } } } } while (0)
  f32x16 pA0, pA1, pB0, pB1; float mnA, mnB, alA, alB; bf16x8 pa0, pa1, pa2, pa3; const int NT = J.NT;
  SLOAD(0); SWAIT(); SWRITE(0); __syncthreads();
  qkt<DQK>(pA0, pA1, K_lds, qr, ql, r32, hi); MASK(pA0, pA1, 0); partialSM(pA0, pA1, m_reg, mnA, alA, C, THRS);
  SLOAD(1);
  SWAIT(); SWRITE(1); __syncthreads();
  for (int j = 1; j + 1 < NT; j += 2) {
    SBAR(); qkt<DQK>(pB0, pB1, K_lds + SHM_K, qr, ql, r32, hi);
    finishSM(pA0, pA1, alA, l_reg, pa0, pa1, pa2, pa3); SBAR();
    SLOAD(j + 1); SBAR();
    pv_d0(o, vb0, pa0, pa1, pa2, pa3); MASK(pB0, pB1, j); partialSM(pB0, pB1, m_reg, mnB, alB, C, THRS);
    __syncthreads(); SWAIT(); SWRITE(0);
    RESC(alB); __syncthreads();
    SBAR(); qkt<DQK>(pA0, pA1, K_lds, qr, ql, r32, hi);
    finishSM(pB0, pB1, alB, l_reg, pa0, pa1, pa2, pa3); SBAR();
    SLOAD(j + 2); SBAR();
    pv_d0(o, vb0 + (int)SHM_V, pa0, pa1, pa2, pa3); MASK(pA0, pA1, j + 1); partialSM(pA0, pA1, m_reg, mnA, alA, C, THRS);
    __syncthreads(); SWAIT(); SWRITE(1);
    RESC(alA); __syncthreads();
  }
  SBAR(); qkt<DQK>(pB0, pB1, K_lds + SHM_K, qr, ql, r32, hi);
  finishSM(pA0, pA1, alA, l_reg, pa0, pa1, pa2, pa3); SBAR();
  pv_d0(o, vb0, pa0, pa1, pa2, pa3); MASK(pB0, pB1, NT - 1); partialSM(pB0, pB1, m_reg, mnB, alB, C, THRS);
  __syncthreads(); RESC(alB);
  finishSM(pB0, pB1, alB, l_reg, pa0, pa1, pa2, pa3); SBAR();
  pv_d0(o, vb0 + (int)SHM_V, pa0, pa1, pa2, pa3);
  if (hi == 0) li_l[r32] = l_reg; asm volatile("s_waitcnt lgkmcnt(0)" ::: "memory");
  float rli[16];
#pragma unroll
  for (int r = 0; r < 16; ++r) rli[r] = __builtin_amdgcn_rcpf(li_l[crow(r, hi)]);
  bf16_t* Ow = J.Ob + (size_t)(wid * QBLK) * J.ldo;
#pragma unroll
  for (int r = 0; r < 16; ++r) { const int orow = crow(r, hi);
#pragma unroll
    for (int d0 = 0; d0 < 4; ++d0) Ow[(size_t)orow * J.ldo + d0 * 32 + r32] = (bf16_t)(cvt_pk_bf16(o[d0][r] * rli[r], 0.f) & 0xffffu); }
#undef TROW
#undef SLOAD
#undef SWRITE
#undef SWAIT
#undef RESC
#undef MASK
}
}

__constant__ int XJOB[11][6] = {
  {10, 0, 2048, 5120, 0, 0},
  {11, 0, 2048, 2048, 0, 640},
  {8, 0, 2048, 8192, 0, 896},
  {20, 0, 2048, 512, 0, 1920},
  {21, 0, 2048, 576, 512, 1984},
  {9, 0, 8192, 2048, 0, 2064},
  {8, 2048 * 8, 2048, 8192, 0, 3088},
  {9, 8192 * 2, 8192, 2048, 0, 4112},
  {23, 0, 512, 3072, 0, 5136},
  {25, 0, 512, 4096, 0, 5232},
  {26, 0, 2048, 2048, 0, 5360},
};
constexpr int N_XT = 5616, N_EARLY = 640, N_SLOTA_END = 2752, N_SLOTB_END = 3088, N_GEMV = 192;

__device__ __forceinline__ size_t xjob_dst(int j) {
  switch (j) {
    case 0: return OFF_WIN; case 1: return OFF_WOUT; case 2: return OFF_W1; case 3: return OFF_WD; case 4: return OFF_WD;
    case 5: return OFF_W2; case 6: return OFF_W1 + (size_t)8192 * 2048 * 2; case 7: return OFF_W2 + (size_t)2048 * 8192 * 2;
    case 8: return OFF_WUQ; case 9: return OFF_WUKV; default: return OFF_WO;
  }
}

__device__ __forceinline__ void xpose_tile(const Params& p, int tt, float* fs, int tid) {
  int j = 0;
#pragma unroll
  for (int q = 1; q < 11; ++q) if (tt >= XJOB[q][5]) j = q;
  const int K = XJOB[j][2], N = XJOB[j][3], tl = tt - XJOB[j][5];
  const int tilesN = (N + 127) / 128; const int tk = tl / tilesN, tn = tl % tilesN;
  const float* src = p.in[XJOB[j][0]] + (size_t)XJOB[j][1] * 1024;
  bf16_t* dst = (bf16_t*)(p.ws + xjob_dst(j)) + (size_t)XJOB[j][4] * K;
  const int k0 = tk * 128, n0 = tn * 128;
  { const int nn = (tid & 31) * 4, kr = tid >> 5; f32x4 v[8];
#pragma unroll
    for (int q = 0; q < 8; ++q) v[q] = (n0 + nn < N) ? *(const f32x4*)(src + (size_t)(k0 + kr + 16 * q) * N + n0 + nn) : (f32x4){0.f, 0.f, 0.f, 0.f};
#pragma unroll
    for (int q = 0; q < 8; ++q) { float* d = fs + (kr + 16 * q) * 129 + nn; d[0] = v[q][0]; d[1] = v[q][1]; d[2] = v[q][2]; d[3] = v[q][3]; } }
  __syncthreads();
  { const int nl = tid >> 4, kc = (tid & 15) * 8;
#pragma unroll
    for (int q = 0; q < 4; ++q) { const int n = nl + 32 * q;
      if (n0 + n < N) { float e[8];
#pragma unroll
        for (int i = 0; i < 8; ++i) e[i] = fs[(kc + i) * 129 + n];
        u32x4 w; w.x = cvt_pk_bf16(e[0], e[1]); w.y = cvt_pk_bf16(e[2], e[3]); w.z = cvt_pk_bf16(e[4], e[5]); w.w = cvt_pk_bf16(e[6], e[7]);
        *(u32x4*)(dst + (size_t)(n0 + n) * K + k0 + kc) = w; } } }
}
__device__ __forceinline__ void xpose_deferred(const Params& p, char* shm, int lo, int hi, int c0) {
  if ((int)blockIdx.x < c0) return;
  const int tid = otid();
  for (int t = lo + (int)blockIdx.x - c0; t < hi; t += (int)gridDim.x - c0) { __syncthreads(); xpose_tile(p, t, (float*)shm, tid); }
}

__device__ __forceinline__ void phase0(const Params& p, char* shm) {
  const int tid = otid();
  float* fs = (float*)shm;
  bool cond_ready = false;
  const int n_xt0 = (gridDim.x == 256) ? N_EARLY : N_XT;
  const int T0_TOTAL = N_GEMV + n_xt0 + 8 + 1 + 1;
  for (int it = 0; ; ++it) {
    int task;
    if (gridDim.x == 256) {
      const int c = blockIdx.x;
      if (c < 192) { if (it == 0) task = c; else if (it == 1 && c < 10) task = N_GEMV + n_xt0 + c; else break; }
      else { if (it < 10) task = N_GEMV + (c - 192) * 10 + it; else break; }
    } else { task = blockIdx.x + it * gridDim.x; if (task >= T0_TOTAL) break; }
    __syncthreads();
    if (task < N_GEMV) {
      float* condS = fs;
      float* red = fs + 9 * 2048;
      if (!cond_ready) {
        for (int i = tid; i < 9 * 2048; i += 512) { const int r = i >> 11, k = i & 2047; const float v = r < 8 ? p.in[1][r * 2048 + k] : p.in[3][k]; condS[i] = v / (1.f + __expf(-v)); }
        cond_ready = true;
        __syncthreads();
      }
      const int l = task / 96, col0 = (task % 96) * 128;
      const int cp = (tid & 63) * 2, ks = tid >> 6;
      const float* W = p.in[4] + ((size_t)l * 2048 + ks * 256) * NMOD6 + col0 + cp;
      float a0[9], a1[9];
#pragma unroll
      for (int r = 0; r < 9; ++r) { a0[r] = 0.f; a1[r] = 0.f; }
      const LAS float* condL = (const LAS float*)(LAS char*)shm;
      for (int k = 0; k < 256; k += 32) {
        f32x2 w[32];
#pragma unroll
        for (int u = 0; u < 32; ++u) w[u] = *(const f32x2*)(W + (size_t)(k + u) * NMOD6);
#pragma unroll
        for (int u4 = 0; u4 < 8; ++u4) {
#pragma unroll
          for (int r = 0; r < 9; ++r) { const f32x4 cv = *(const LAS f32x4*)(condL + r * 2048 + ks * 256 + k + 4 * u4);
#pragma unroll
            for (int e = 0; e < 4; ++e) { a0[r] = fmaf(cv[e], w[4 * u4 + e].x, a0[r]); a1[r] = fmaf(cv[e], w[4 * u4 + e].y, a1[r]); } }
        }
      }
#pragma unroll
      for (int r = 0; r < 9; ++r) { red[(ks * 9 + r) * 128 + cp] = a0[r]; red[(ks * 9 + r) * 128 + cp + 1] = a1[r]; }
      __syncthreads();
      float* modv = (float*)(p.ws + OFF_MODV);
      for (int i = tid; i < 9 * 128; i += 512) { const int r = i >> 7, c = i & 127; float s = 0.f;
#pragma unroll
        for (int q = 0; q < 8; ++q) s += red[(q * 9 + r) * 128 + c];
        modv[((size_t)l * 9 + r) * NMOD6 + col0 + c] = s + p.in[5][(size_t)l * NMOD6 + col0 + c]; }
    } else if (task < N_GEMV + n_xt0) {
      xpose_tile(p, task - N_GEMV, fs, tid);
    } else if (task < N_GEMV + n_xt0 + 8) {
      const int blk = task - (N_GEMV + n_xt0);
      bf16_t* WL = (bf16_t*)(p.ws + OFF_WL) + (size_t)blk * 512 * 128;
      for (int i = tid; i < 512 * 128; i += 512) { const int n = i >> 7, k = i & 127; const int d = n >> 8, g = (n >> 7) & 1, jj = n & 127;
        const float v = (g ? p.in[17] : p.in[15])[(((size_t)d * 8 + blk) * 128 + k) * 128 + jj];
        WL[i] = (bf16_t)(cvt_pk_bf16(v, 0.f) & 0xffffu); }
    } else if (task == N_GEMV + n_xt0 + 8) {
      u32x4* z = (u32x4*)(p.ws + OFF_WD + (size_t)1088 * 2048 * 2);
      for (int i = tid; i < 192 * 2048 * 2 / 16; i += 512) z[i] = (u32x4){0u, 0u, 0u, 0u};
    } else {
      float* rt = (float*)(p.ws + OFF_ROPE);
      for (int i = tid; i < 1024; i += 512) { const int pos = i >> 4, f = i & 15; const float ang = (float)pos * p.inv[f]; rt[2 * i] = cosf(ang); rt[2 * i + 1] = sinf(ang); }
    }
  }
}

template <int MODE, bool FIX, bool LAT_F32, bool CTX_F32>
__device__ __forceinline__ void norm_rows(const void* src_lat, const void* src_ctx, int nrows, const float* gain, const float* shift, const float* scale, void* dst,
                                          bf16_t* xfix = nullptr, const float* part = nullptr) {
  const int tid_ = otid(); const int lane = tid_ & 63, wv = tid_ >> 6;
  f32x4 g[4][2];
#pragma unroll
  for (int i = 0; i < 4; ++i) { g[i][0] = *(const f32x4*)(gain + i * 512 + lane * 8); g[i][1] = *(const f32x4*)(gain + i * 512 + lane * 8 + 4); }
  for (int row = blockIdx.x * 8 + wv; row < nrows; row += gridDim.x * 8) {
    f32x4 v[4][2];
    const bool islat = row < ML;
    const bool f32src = islat ? LAT_F32 : CTX_F32;
    const void* sp = islat ? src_lat : src_ctx;
    if (f32src) { const float* s = (const float*)sp + (size_t)row * DM + lane * 8;
#pragma unroll
      for (int i = 0; i < 4; ++i) { v[i][0] = *(const f32x4*)(s + i * 512); v[i][1] = *(const f32x4*)(s + i * 512 + 4); } }
    else { const bf16_t* s = (const bf16_t*)sp + (size_t)row * DM + lane * 8;
#pragma unroll
      for (int i = 0; i < 4; ++i) { const u32x4 w = *(const u32x4*)(s + i * 512);
        v[i][0] = (f32x4){bflo(w.x), bfhi(w.x), bflo(w.y), bfhi(w.y)}; v[i][1] = (f32x4){bflo(w.z), bfhi(w.z), bflo(w.w), bfhi(w.w)}; } }
    if constexpr (FIX) { if (!islat) {
      const float* pp = part + (size_t)(row - ML) * DM + lane * 8;
#pragma unroll
      for (int q = 0; q < 4; ++q)
#pragma unroll
        for (int i = 0; i < 4; ++i) { v[i][0] += *(const f32x4*)(pp + (size_t)q * MC * DM + i * 512); v[i][1] += *(const f32x4*)(pp + (size_t)q * MC * DM + i * 512 + 4); }
#pragma unroll
      for (int i = 0; i < 4; ++i) { u32x4 o; o.x = cvt_pk_bf16(v[i][0][0], v[i][0][1]); o.y = cvt_pk_bf16(v[i][0][2], v[i][0][3]); o.z = cvt_pk_bf16(v[i][1][0], v[i][1][1]); o.w = cvt_pk_bf16(v[i][1][2], v[i][1][3]);
        *(u32x4*)(xfix + (size_t)row * DM + i * 512 + lane * 8) = o;
        v[i][0] = (f32x4){bflo(o.x), bfhi(o.x), bflo(o.y), bfhi(o.y)}; v[i][1] = (f32x4){bflo(o.z), bfhi(o.z), bflo(o.w), bfhi(o.w)}; } } }
    float ss = 0.f;
#pragma unroll
    for (int i = 0; i < 4; ++i)
#pragma unroll
      for (int h = 0; h < 2; ++h) ss += v[i][h][0] * v[i][h][0] + v[i][h][1] * v[i][h][1] + v[i][h][2] * v[i][h][2] + v[i][h][3] * v[i][h][3];
    ss = wave_sum(ss);
    const float rstd = rsqrtf(ss * (1.f / DM) + 1e-6f);
    if constexpr (MODE == 0) {
      const int b = islat ? (row >> 11) : 8;
      const float* sh = shift + (size_t)b * NMOD6 + lane * 8; const float* sc = scale + (size_t)b * NMOD6 + lane * 8;
      bf16_t* d = (bf16_t*)dst + (size_t)row * DM + lane * 8;
#pragma unroll
      for (int i = 0; i < 4; ++i) { f32x4 y[2];
#pragma unroll
        for (int h = 0; h < 2; ++h) { const f32x4 a = *(const f32x4*)(sh + i * 512 + 4 * h), c = *(const f32x4*)(sc + i * 512 + 4 * h);
          y[h] = v[i][h] * rstd * g[i][h]; y[h] = y[h] * (c + 1.f) + a; }
        u32x4 o; o.x = cvt_pk_bf16(y[0][0], y[0][1]); o.y = cvt_pk_bf16(y[0][2], y[0][3]); o.z = cvt_pk_bf16(y[1][0], y[1][1]); o.w = cvt_pk_bf16(y[1][2], y[1][3]);
        *(u32x4*)(d + i * 512) = o; }
    } else {
      float* d = (float*)dst + (size_t)row * DM + lane * 8;
#pragma unroll
      for (int i = 0; i < 4; ++i) { *(f32x4*)(d + i * 512) = v[i][0] * rstd * g[i][0]; *(f32x4*)(d + i * 512 + 4) = v[i][1] * rstd * g[i][1]; }
    }
  }
}

__device__ __forceinline__ void mla_norm_rows(const Params& p) {
  const int tid_ = otid(); const int lane = tid_ & 63, wv = tid_ >> 6;
  const bf16_t* QA = (const bf16_t*)(p.ws + OFF_QA); bf16_t* QN = (bf16_t*)(p.ws + OFF_QN); bf16_t* CK = (bf16_t*)(p.ws + OFF_CKVN); bf16_t* KPE = (bf16_t*)(p.ws + OFF_KPE);
  const float* rope = (const float*)(p.ws + OFF_ROPE);
  float gq[8], gk[8];
#pragma unroll
  for (int i = 0; i < 8; ++i) { gq[i] = p.in[22][lane * 8 + i]; gk[i] = p.in[24][lane * 8 + i]; }
  for (int row = blockIdx.x * 8 + wv; row < MT; row += gridDim.x * 8) {
    const bf16_t* s = QA + (size_t)row * 1280;
    const u32x4 cw = *(const u32x4*)(s + 512 + lane * 8);
    float c[8] = {bflo(cw.x), bfhi(cw.x), bflo(cw.y), bfhi(cw.y), bflo(cw.z), bfhi(cw.z), bflo(cw.w), bfhi(cw.w)};
    float ssc = 0.f;
#pragma unroll
    for (int i = 0; i < 8; ++i) ssc += c[i] * c[i];
    ssc = wave_sum(ssc);
    { const float rstd = rsqrtf(ssc * (1.f / 512.f) + 1e-6f); u32x4 w;
      w.x = cvt_pk_bf16(c[0] * rstd * gk[0], c[1] * rstd * gk[1]); w.y = cvt_pk_bf16(c[2] * rstd * gk[2], c[3] * rstd * gk[3]);
      w.z = cvt_pk_bf16(c[4] * rstd * gk[4], c[5] * rstd * gk[5]); w.w = cvt_pk_bf16(c[6] * rstd * gk[6], c[7] * rstd * gk[7]);
      *(u32x4*)(CK + (size_t)row * 512 + lane * 8) = w; }
    if (row < ML) {
      const u32x4 qw = *(const u32x4*)(s + lane * 8);
      float q[8] = {bflo(qw.x), bfhi(qw.x), bflo(qw.y), bfhi(qw.y), bflo(qw.z), bfhi(qw.z), bflo(qw.w), bfhi(qw.w)};
      float ssq = 0.f;
#pragma unroll
      for (int i = 0; i < 8; ++i) ssq += q[i] * q[i];
      ssq = wave_sum(ssq);
      const float rstd = rsqrtf(ssq * (1.f / 512.f) + 1e-6f); u32x4 w;
      w.x = cvt_pk_bf16(q[0] * rstd * gq[0], q[1] * rstd * gq[1]); w.y = cvt_pk_bf16(q[2] * rstd * gq[2], q[3] * rstd * gq[3]);
      w.z = cvt_pk_bf16(q[4] * rstd * gq[4], q[5] * rstd * gq[5]); w.w = cvt_pk_bf16(q[6] * rstd * gq[6], q[7] * rstd * gq[7]);
      *(u32x4*)(QN + (size_t)row * 512 + lane * 8) = w;
    }
    {
      const int l8 = lane & 7;
      const u32x4 kw = *(const u32x4*)(s + 1024 + l8 * 8);
      float k[8] = {bflo(kw.x), bfhi(kw.x), bflo(kw.y), bfhi(kw.y), bflo(kw.z), bfhi(kw.z), bflo(kw.w), bfhi(kw.w)};
      float o[8];
      if (row < ML) {
        const int tok = row & 2047; const int ax = l8 >> 2, half = (l8 >> 1) & 1; const int pos = ax == 0 ? (tok >> 6) : (tok & 63);
        const float* cs = rope + (size_t)(pos * 16 + (l8 & 1) * 8) * 2;
#pragma unroll
        for (int i = 0; i < 8; ++i) { const float other = __shfl_xor(k[i], 2, 64); const float co = cs[2 * i], si = cs[2 * i + 1];
          o[i] = half == 0 ? (k[i] * co - other * si) : (other * si + k[i] * co); }
      } else {
#pragma unroll
        for (int i = 0; i < 8; ++i) o[i] = k[i];
      }
      if (lane < 8) { u32x4 w; w.x = cvt_pk_bf16(o[0], o[1]); w.y = cvt_pk_bf16(o[2], o[3]); w.z = cvt_pk_bf16(o[4], o[5]); w.w = cvt_pk_bf16(o[6], o[7]);
        *(u32x4*)(KPE + (size_t)row * 64 + lane * 8) = w; }
    }
  }
}

constexpr int XCP = 136;
template <int REV, int EMIT>
__device__ __forceinline__ void lru_dir(const LAS bf16_t* XC, LAS float* HF, const bf16x8 (&Wr)[4], const bf16x8 (&Wi)[4], float ba, float bx, float sp8,
                                        float& carry, float& Atot, int tid, int wv, int fr, int fq, const LAS bf16_t* GE, bf16_t* Op,
                                        unsigned* SDp, const unsigned (&sd)[8][4]) {
  const int lane = fq * 16 + fr;
#pragma unroll
  for (int mm = 0; mm < 8; ++mm) {
    const int m = REV ? 7 - mm : mm;
    float av[4], uv[4];
    if constexpr (EMIT == 0) {
      f32x4 gr = {0.f, 0.f, 0.f, 0.f}, gi = {0.f, 0.f, 0.f, 0.f};
#pragma unroll
      for (int ks = 0; ks < 4; ++ks) {
        const bf16x8 a = *(const LAS bf16x8*)(XC + (16 * m + fr) * XCP + ks * 32 + fq * 8);
        gr = __builtin_amdgcn_mfma_f32_16x16x32_bf16(a, Wr[ks], gr, 0, 0, 0);
        gi = __builtin_amdgcn_mfma_f32_16x16x32_bf16(a, Wi[ks], gi, 0, 0, 0);
      }
#pragma unroll
      for (int j = 0; j < 4; ++j) {
        const float xc = bf2f(XC[(16 * m + 4 * fq + j) * XCP + 16 * wv + fr]);
        const float r = __builtin_amdgcn_rcpf(1.f + __expf(-(gr[j] + ba))), ig = __builtin_amdgcn_rcpf(1.f + __expf(-(gi[j] + bx)));
        const float la = -sp8 * r;
        const float a = __expf(la);
        av[j] = a;
        uv[j] = __builtin_amdgcn_sqrtf(fmaxf(fmaf(-a, a, 1.f), 0.f)) * (ig * xc);
        SDp[(size_t)(16 * m + 4 * fq + j) * 1024] = cvt_pk_bf16(la, uv[j]);
      }
    } else {
#pragma unroll
      for (int j = 0; j < 4; ++j) { av[j] = __expf(bflo(sd[m][j])); uv[j] = bfhi(sd[m][j]); }
    }
    float s[4], P[4];
    if (!REV) { s[0] = uv[0]; P[0] = av[0];
#pragma unroll
      for (int j = 1; j < 4; ++j) { s[j] = fmaf(av[j], s[j - 1], uv[j]); P[j] = av[j] * P[j - 1]; } }
    else { s[3] = uv[3]; P[3] = av[3];
#pragma unroll
      for (int j = 2; j >= 0; --j) { s[j] = fmaf(av[j], s[j + 1], uv[j]); P[j] = av[j] * P[j + 1]; } }
    float A = REV ? P[0] : P[3], U = REV ? s[0] : s[3];
    { const int src = REV ? lane + 16 : lane - 16; const float Ap = __shfl(A, src & 63, 64), Up = __shfl(U, src & 63, 64);
      const bool on = REV ? (fq <= 2) : (fq >= 1); if (on) { U = fmaf(A, Up, U); A = A * Ap; } }
    { const int src = REV ? lane + 32 : lane - 32; const float Ap = __shfl(A, src & 63, 64), Up = __shfl(U, src & 63, 64);
      const bool on = REV ? (fq <= 1) : (fq >= 2); if (on) { U = fmaf(A, Up, U); A = A * Ap; } }
    float Ae, Ue;
    { const int src = REV ? lane + 16 : lane - 16; Ae = __shfl(A, src & 63, 64); Ue = __shfl(U, src & 63, 64);
      const bool first = REV ? (fq == 3) : (fq == 0); if (first) { Ae = 1.f; Ue = 0.f; } }
    const float cr = fmaf(Ae, carry, Ue);
    if (EMIT == 1) {
#pragma unroll
      for (int j = 0; j < 4; ++j) HF[(m * 4 + j) * 512 + tid] = fmaf(P[j], cr, s[j]);
    }
    if (EMIT == 2) {
#pragma unroll
      for (int j = 0; j < 4; ++j) { const float hsum = HF[(m * 4 + j) * 512 + tid] + fmaf(P[j], cr, s[j]);
        const int tl = 16 * m + 4 * fq + j;
        const float ge = bf2f(GE[tl * XCP + 16 * wv + fr]);
        Op[(size_t)tl * DM] = (bf16_t)(cvt_pk_bf16(hsum * ge, 0.f) & 0xffffu); }
    }
    const int lastl = REV ? fr : 48 + fr;
    const float At = __shfl(A, lastl, 64), Ut = __shfl(U, lastl, 64);
    carry = fmaf(At, carry, Ut); Atot *= At;
  }
}

template <int PASS>
__device__ __forceinline__ void lru_task(const Params& p, int task, char* shm) {
  const int tid = otid(), lane = tid & 63, wv = tid >> 6, fr = lane & 15, fq = lane >> 4;
  const int ci = task % 18, blk = (task / 18) & 7, b = task / 144;
  const bf16_t* P = (const bf16_t*)(p.ws + OFF_P);
  LAS bf16_t* XC = (LAS bf16_t*)shm;
  LAS float* HF = (LAS float*)(shm + 128 * XCP * 2);
  LAS bf16_t* GE = (LAS bf16_t*)(shm + 128 * XCP * 2 + 32 * 512 * 4);
  const int L = ci < 2 ? 256 : 2048, tl0 = ci < 2 ? ci * 128 : (ci - 2) * 128;
  const size_t rowbase = ci < 2 ? (size_t)ML + b * 256 : (size_t)b * 2048;
  const int ch = blk * 128 + 16 * wv + fr;
  unsigned* SD0 = (unsigned*)(p.ws + OFF_X) + (rowbase + tl0) * 1024 + ch;
  unsigned* SD1 = SD0 + (size_t)MT * 1024;
  float* LS = (float*)(p.ws + OFF_LSUM) + (size_t)((b * 8 + blk) * 18) * 2 * 128 * 2;
  bf16_t* Op = (bf16_t*)(p.ws + OFF_MIX) + (rowbase + tl0) * DM + 1024 + ch;
  __syncthreads();
  if constexpr (PASS == 1) {
    {
      const int cg = tid & 15; const int ch0 = blk * 128 + cg * 8;
      float cw[4][8], cb[8];
#pragma unroll
      for (int e = 0; e < 8; ++e) { cb[e] = p.in[14][ch0 + e];
#pragma unroll
        for (int tp = 0; tp < 4; ++tp) cw[tp][e] = p.in[13][tp * 1024 + ch0 + e]; }
      u32x4 wld[4][4];
#pragma unroll
      for (int it = 0; it < 4; ++it)
#pragma unroll
        for (int tp = 0; tp < 4; ++tp) { const int tl = tl0 + (tid >> 4) + 32 * it + tp - 2; const int tlc = min(max(tl, 0), L - 1);
          wld[it][tp] = *(const u32x4*)(P + (rowbase + tlc) * ABIN + 3072 + ch0); }
#pragma unroll
      for (int it = 0; it < 4; ++it) { const int t = (tid >> 4) + 32 * it; float acc[8];
#pragma unroll
        for (int e = 0; e < 8; ++e) acc[e] = cb[e];
#pragma unroll
        for (int tp = 0; tp < 4; ++tp) { const int tl = tl0 + t + tp - 2; const bool ok = (tl >= 0 && tl < L);
          const u32x4 w = wld[it][tp];
          const float x[8] = {bflo(w.x), bfhi(w.x), bflo(w.y), bfhi(w.y), bflo(w.z), bfhi(w.z), bflo(w.w), bfhi(w.w)};
#pragma unroll
          for (int e = 0; e < 8; ++e) acc[e] = fmaf(cw[tp][e], ok ? x[e] : 0.f, acc[e]); }
        u32x4 o; o.x = cvt_pk_bf16(acc[0], acc[1]); o.y = cvt_pk_bf16(acc[2], acc[3]); o.z = cvt_pk_bf16(acc[4], acc[5]); o.w = cvt_pk_bf16(acc[6], acc[7]);
        *(LAS u32x4*)(XC + t * XCP + cg * 8) = o; }
    }
    __syncthreads();
    const bf16_t* WL = (const bf16_t*)(p.ws + OFF_WL) + (size_t)blk * 512 * 128;
    const unsigned nosd[8][4] = {};
#pragma unroll
    for (int d = 0; d < 2; ++d) {
      bf16x8 Wr[4], Wi[4];
#pragma unroll
      for (int ks = 0; ks < 4; ++ks) { Wr[ks] = *(const bf16x8*)(WL + (size_t)(256 * d + 16 * wv + fr) * 128 + ks * 32 + fq * 8); Wi[ks] = *(const bf16x8*)(WL + (size_t)(256 * d + 128 + 16 * wv + fr) * 128 + ks * 32 + fq * 8); }
      const float ba = p.in[16][1024 * d + ch], bx = p.in[18][1024 * d + ch]; const float lam = p.in[19][1024 * d + ch];
      const float sp8 = 8.f * (fmaxf(-lam, 0.f) + log1pf(__expf(-fabsf(lam))));
      float carry = 0.f, Atot = 1.f;
      if (d == 0) lru_dir<0, 0>(XC, HF, Wr, Wi, ba, bx, sp8, carry, Atot, tid, wv, fr, fq, GE, Op, SD0, nosd);
      else        lru_dir<1, 0>(XC, HF, Wr, Wi, ba, bx, sp8, carry, Atot, tid, wv, fr, fq, GE, Op, SD1, nosd);
      if (fq == 0) *(f32x2*)(LS + ((size_t)(ci * 2 + d) * 128 + 16 * wv + fr) * 2) = (f32x2){Atot, carry};
    }
  } else {
    unsigned sdf[8][4], sdr[8][4];
#pragma unroll
    for (int m = 0; m < 8; ++m)
#pragma unroll
      for (int j = 0; j < 4; ++j) { sdf[m][j] = SD0[(size_t)(16 * m + 4 * fq + j) * 1024]; sdr[m][j] = SD1[(size_t)(16 * m + 4 * fq + j) * 1024]; }
    {
      const int cg = tid & 15; const int ch0 = blk * 128 + cg * 8;
      u32x4 gl[4];
#pragma unroll
      for (int it = 0; it < 4; ++it) gl[it] = *(const u32x4*)(P + (rowbase + tl0 + (tid >> 4) + 32 * it) * ABIN + 4096 + ch0);
#pragma unroll
      for (int it = 0; it < 4; ++it) { const u32x4 w = gl[it];
        float x[8] = {bflo(w.x), bfhi(w.x), bflo(w.y), bfhi(w.y), bflo(w.z), bfhi(w.z), bflo(w.w), bfhi(w.w)};
#pragma unroll
        for (int e = 0; e < 8; ++e) { const float g = x[e]; const float z = 0.7978845608028654f * (g + 0.044715f * g * g * g); x[e] = g * __builtin_amdgcn_rcpf(1.f + __expf(-2.f * z)); }
        u32x4 o; o.x = cvt_pk_bf16(x[0], x[1]); o.y = cvt_pk_bf16(x[2], x[3]); o.z = cvt_pk_bf16(x[4], x[5]); o.w = cvt_pk_bf16(x[6], x[7]);
        *(LAS u32x4*)(GE + ((tid >> 4) + 32 * it) * XCP + cg * 8) = o; }
    }
    float carryF = 0.f, carryR = 0.f;
    { f32x2 su[17];
#pragma unroll
      for (int c2 = 0; c2 < 17; ++c2) su[c2] = (c2 < ci) ? *(const f32x2*)(LS + ((size_t)(c2 * 2 + 0) * 128 + 16 * wv + fr) * 2) : (f32x2){1.f, 0.f};
#pragma unroll
      for (int c2 = 0; c2 < 17; ++c2) carryF = fmaf(su[c2].x, carryF, su[c2].y); }
    { const int pos = ci < 2 ? (1 - ci) : (19 - ci);
      f32x2 su[17];
#pragma unroll
      for (int q = 0; q < 17; ++q) { const int c2 = q < 2 ? 1 - q : 19 - q; su[q] = (q < pos) ? *(const f32x2*)(LS + ((size_t)(c2 * 2 + 1) * 128 + 16 * wv + fr) * 2) : (f32x2){1.f, 0.f}; }
#pragma unroll
      for (int q = 0; q < 17; ++q) carryR = fmaf(su[q].x, carryR, su[q].y); }
    __syncthreads();
    const bf16x8 nw[4] = {};
    float At0 = 1.f, At1 = 1.f;
    lru_dir<0, 1>(XC, HF, nw, nw, 0.f, 0.f, 0.f, carryF, At0, tid, wv, fr, fq, GE, Op, SD0, sdf);
    lru_dir<1, 2>(XC, HF, nw, nw, 0.f, 0.f, 0.f, carryR, At1, tid, wv, fr, fq, GE, Op, SD1, sdr);
  }
}

__device__ __forceinline__ void na_task(const Params& p, int task, char* shm) {
  const int qb = task & 7, h = (task >> 3) & 7, b = task >> 6;
  const bf16_t* P = (const bf16_t*)(p.ws + OFF_P); bf16_t* MIX = (bf16_t*)(p.ws + OFF_MIX);
  __syncthreads();
  { float* tb = (float*)(shm + 2 * att::SHM_V + 2 * (64 * 128 * 2) + att::NW * 256) + 64;
    for (int i = otid(); i < 15 * 31; i += 512) tb[i] = p.in[12][h * 465 + i] * 11.313708498984761f; }
  att::Job J;
  J.Qb = P + (size_t)(b * 2048 + qb * 256) * ABIN + h * 128; J.ldq = ABIN;
  J.Kb = P + 1024 + h * 128; J.Vb = P + 2048 + h * 128; J.ldk = ABIN; J.Pe = nullptr;
  J.Ob = MIX + (size_t)(b * 2048 + qb * 256) * DM + h * 128; J.ldo = DM;
  const int r0 = qb * 4; const int lo = min(max(r0 - 4, 0), 24), hiw = min(max(r0 - 1, 0), 24) + 7;
  J.lo = lo; J.nwin = hiw - lo + 1; J.qb4 = r0;
  J.nA = 4; J.rowA = ML + b * 256; J.rowB = b * 2048 + lo * 64;
  J.NT = (4 + J.nwin + 1) & ~1;
  J.rope = nullptr; J.tok0 = 0;
  __syncthreads();
  att::attn_body<0>(J, shm);
}
__device__ __forceinline__ void ctxattn_task(const Params& p, int task, char* shm) {
  const int h = task & 7, b = task >> 3;
  const bf16_t* P = (const bf16_t*)(p.ws + OFF_P); bf16_t* MIX = (bf16_t*)(p.ws + OFF_MIX);
  __syncthreads();
  att::Job J;
  J.Qb = P + (size_t)(ML + b * 256) * ABIN + h * 128; J.ldq = ABIN;
  J.Kb = P + 1024 + h * 128; J.Vb = P + 2048 + h * 128; J.ldk = ABIN; J.Pe = nullptr;
  J.Ob = MIX + (size_t)(ML + b * 256) * DM + h * 128; J.ldo = DM;
  J.NT = 4; J.nA = 4; J.rowA = ML + b * 256; J.rowB = 0; J.qb4 = 0; J.lo = 0; J.nwin = 0; J.rope = nullptr; J.tok0 = 0;
  att::attn_body<1>(J, shm);
}
__device__ __forceinline__ void mla_task(const Params& p, int task, char* shm) {
  const int qb = task & 7, h = (task >> 3) & 15, b = task >> 7;
  const bf16_t* Q = (const bf16_t*)(p.ws + OFF_Q); const bf16_t* KV = (const bf16_t*)(p.ws + OFF_KV); bf16_t* ATT = (bf16_t*)(p.ws + OFF_H);
  __syncthreads();
  att::Job J;
  J.Qb = Q + (size_t)(b * 2048 + qb * 256) * 3072 + h * 192; J.ldq = 3072;
  J.Kb = KV + h * 256; J.Vb = KV + h * 256 + 128; J.ldk = 4096; J.Pe = (const bf16_t*)(p.ws + OFF_KPE);
  J.Ob = ATT + (size_t)(b * 2048 + qb * 256) * DM + h * 128; J.ldo = DM;
  J.NT = 36; J.nA = 32; J.rowA = b * 2048; J.rowB = ML + b * 256; J.qb4 = 0; J.lo = 0; J.nwin = 0;
  J.rope = (const float*)(p.ws + OFF_ROPE); J.tok0 = qb * 256;
  att::attn_body<2>(J, shm);
}

#define XB_TMO      128
#define XB_XCNT(j)  (256  + 64 * (j))
#define XB_XSUB(j)  (1280 + 64 * (j))
#define XB_XGEN(j)  (2304 + 64 * (j))
#define XB_TOP      3328
#define XB_TOPGEN   3392
#define XCD_BAR_WORDS 3456
#define XB_SPIN_CAP (1u << 18)
__device__ __forceinline__ unsigned xb_ld(unsigned* p)              { return __hip_atomic_load(p, __ATOMIC_RELAXED, __HIP_MEMORY_SCOPE_AGENT); }
__device__ __forceinline__ unsigned xb_add(unsigned* p, unsigned v) { return __hip_atomic_fetch_add(p, v, __ATOMIC_RELAXED, __HIP_MEMORY_SCOPE_AGENT); }
__device__ __forceinline__ unsigned xb_xcc_id() { return (unsigned)__builtin_amdgcn_s_getreg((3 << 11) | 20) & 0xFu; }
#define XB_SPIN(cond, bar) do { unsigned _sp = 0; while (cond) { __builtin_amdgcn_s_sleep(1); \
    if ((++_sp & 255u) == 0u) { if (xb_ld(&(bar)[XB_TMO])) break; if (_sp > XB_SPIN_CAP) { atomicAdd(&(bar)[XB_TMO], 1u); break; } } } } while (0)
struct XcdBarrier { unsigned* bar; unsigned x; volatile LAS unsigned* st; };
__device__ __forceinline__ XcdBarrier xcd_barrier_post(unsigned* bar, volatile LAS unsigned* st) {
  XcdBarrier b; b.bar = bar; b.x = xb_xcc_id(); b.st = st;
  if (threadIdx.x == 0) (void)xb_add(&bar[XB_XCNT(b.x)], 1u);
  return b;
}
__device__ __forceinline__ void xcd_barrier_complete(unsigned* bar, unsigned x, unsigned& nloc, unsigned& nx) {
  const unsigned G = gridDim.x * gridDim.y * gridDim.z;
  unsigned sum, cnt, mine, sp = 0u;
  for (;;) {
    sum = 0u; cnt = 0u; mine = 0u;
#pragma unroll
    for (unsigned j = 0; j < 16; ++j) { const unsigned c = xb_ld(&bar[XB_XCNT(j)]); sum += c; cnt += (c > 0u) ? 1u : 0u; mine = (j == x) ? c : mine; }
    if (sum == G) break;
    __builtin_amdgcn_s_sleep(1);
    if ((++sp & 255u) == 0u) { if (xb_ld(&bar[XB_TMO])) break; if (sp > XB_SPIN_CAP) { atomicAdd(&bar[XB_TMO], 1u); break; } }
  }
  nloc = mine > 0u ? mine : 1u; nx = cnt > 0u ? cnt : 1u;
}
__device__ __forceinline__ void xcd_barrier(const XcdBarrier& b) {
  asm volatile("s_waitcnt vmcnt(0)" ::: "memory");
  __syncthreads();
  if (threadIdx.x == 0) {
    unsigned* bar = b.bar;
    __builtin_amdgcn_s_waitcnt(0);
    unsigned nloc = b.st[0], nx = b.st[1];
    if (nloc == 0u) { xcd_barrier_complete(bar, b.x, nloc, nx); b.st[0] = nloc; b.st[1] = nx; }
    const unsigned old = xb_add(&bar[XB_XSUB(b.x)], 1u);
    const unsigned gen = old / nloc;
    if (old + 1u == (gen + 1u) * nloc) {
      __builtin_amdgcn_fence(__ATOMIC_RELEASE, "agent");
      asm volatile("s_waitcnt vmcnt(0)" ::: "memory");
      const unsigned og = xb_add(&bar[XB_TOP], 1u);
      const unsigned tg = og / nx;
      if (og + 1u == (tg + 1u) * nx) xb_add(&bar[XB_TOPGEN], 1u);
      else XB_SPIN(xb_ld(&bar[XB_TOPGEN]) == tg, bar);
      __builtin_amdgcn_fence(__ATOMIC_ACQUIRE, "agent");
      xb_add(&bar[XB_XGEN(b.x)], 1u);
      asm volatile("s_waitcnt vmcnt(0)" ::: "memory");
    } else {
      XB_SPIN(xb_ld(&bar[XB_XGEN(b.x)]) == gen, bar);
      __builtin_amdgcn_fence(__ATOMIC_ACQUIRE, "agent");
      asm volatile("s_waitcnt vmcnt(0)" ::: "memory");
    }
  }
  __syncthreads();
}

template <class Epi>
__device__ __forceinline__ void run_gemm(char* shm, const bf16_t* A, int lda, const bf16_t* Bt, int ldb, int K, int nM, int nN, const Epi& E) {
  pg8::Gemm g; g.A = A; g.Bt = Bt; g.lda = lda; g.ldb = ldb; g.K = K; g.nM = nM; g.nN = nN;
  pg8::StaticOrder S; S.init(nM, nN, gridDim.x, blockIdx.x);
  __syncthreads();
  pg8::gemm_phase<Epi, pg8::StaticOrder>((LAS unsigned char*)shm, g, S, E);
}
template <class Epi>
__device__ __forceinline__ void run_gemm_split(char* shm, const bf16_t* A, int lda, const bf16_t* Bt, int ldb, int K, int pm0, int nMs, int nN, int NS, const Epi& E) {
  pg8::Gemm g; g.A = A; g.Bt = Bt; g.lda = lda; g.ldb = ldb; g.K = K / NS; g.nM = nMs; g.nN = nN;
  pg8::SplitOrder S; S.init(pm0, nMs, nN, NS, K / NS, gridDim.x, blockIdx.x);
  __syncthreads();
  pg8::gemm_phase<Epi, pg8::SplitOrder>((LAS unsigned char*)shm, g, S, E);
}

#ifndef NO_MEGA
__global__ void __launch_bounds__(512, 2) fwd_megakernel(Params p) {
  extern __shared__ __attribute__((aligned(16))) char shm[];
  cg::grid_group grid = cg::this_grid();
  char* ws = p.ws;
  const float* modv = (const float*)(ws + OFF_MODV);
  bf16_t* X = (bf16_t*)(ws + OFF_X);
  bf16_t* H = (bf16_t*)(ws + OFF_H);

  volatile LAS unsigned* xst = (volatile LAS unsigned*)((LAS char*)shm + (LDS_BYTES - 16));
  if (threadIdx.x == 0) { xst[0] = 0u; xst[1] = 0u; }
  __syncthreads();
  const XcdBarrier xbar = xcd_barrier_post((unsigned*)(ws + OFF_BAR), xst);
  phase0(p, shm);
  grid.sync();
  norm_rows<0, false, true, true>(p.in[0], p.in[2] - (size_t)ML * DM, MT, p.in[6], modv + 0 * DM, modv + 1 * DM, H);
  xcd_barrier(xbar);
  { pg8::EpiBf16<0> E; E.O = (bf16_t*)(ws + OFF_P); E.ldc = ABIN;
    run_gemm(shm, H, DM, (const bf16_t*)(ws + OFF_WIN), DM, DM, MT / 256, ABIN / 256, E); }
  if (gridDim.x == 256) xpose_deferred(p, shm, N_EARLY, N_SLOTA_END, 160);
  xcd_barrier(xbar);
  { const int nxb = (gridDim.x == 256) ? (N_SLOTB_END - N_SLOTA_END) : 0;
    const int tid0 = otid();
    for (int t = blockIdx.x; t < 512 + 64 + 1152 + nxb; t += gridDim.x) {
      if (t < 512) na_task(p, t, shm);
      else if (t < 576) ctxattn_task(p, t - 512, shm);
      else if (t < 1728) lru_task<1>(p, t - 576, shm);
      else { __syncthreads(); xpose_tile(p, N_SLOTA_END + (t - 1728), (float*)shm, tid0); }
    } }
  xcd_barrier(xbar);
  for (int t = blockIdx.x; t < 1152; t += gridDim.x) lru_task<2>(p, t, shm);
  xcd_barrier(xbar);
  { pg8::EpiResid<true> E; E.xin = p.in[0]; E.xout = X; E.gate = modv + 2 * DM;
    run_gemm(shm, (const bf16_t*)(ws + OFF_MIX), DM, (const bf16_t*)(ws + OFF_WOUT), DM, DM, ML / 256, DM / 256, E); }
  { pg8::EpiPartial E; E.part = (float*)(ws + OFF_PART); E.gate = modv + 2 * DM; E.kp2 = (DM / 4) * 2;
    run_gemm_split(shm, (const bf16_t*)(ws + OFF_MIX), DM, (const bf16_t*)(ws + OFF_WOUT), DM, DM, ML / 256, MC / 256, DM / 256, 4, E); }
  xcd_barrier(xbar);
  norm_rows<0, true, false, true>(X, p.in[2] - (size_t)ML * DM, MT, p.in[7], modv + 3 * DM, modv + 4 * DM, H, X, (const float*)(ws + OFF_PART));
  xcd_barrier(xbar);
  { pg8::EpiBf16<1> E; E.O = (bf16_t*)(ws + OFF_HID); E.ldc = DFF;
    run_gemm(shm, H, DM, (const bf16_t*)(ws + OFF_W1), DM, DM, MT / 256, DFF / 256, E); }
  xcd_barrier(xbar);
  { pg8::EpiResid<false> E; E.xin = X; E.xout = X; E.gate = modv + 5 * DM;
    run_gemm(shm, (const bf16_t*)(ws + OFF_HID), DFF, (const bf16_t*)(ws + OFF_W2), DFF, DFF, ML / 256, DM / 256, E); }
  { pg8::EpiPartial E; E.part = (float*)(ws + OFF_PART); E.gate = modv + 5 * DM; E.kp2 = (DFF / 4) * 2;
    run_gemm_split(shm, (const bf16_t*)(ws + OFF_HID), DFF, (const bf16_t*)(ws + OFF_W2), DFF, DFF, ML / 256, MC / 256, DM / 256, 4, E); }
  xcd_barrier(xbar);
  const float* modv1 = modv + (size_t)9 * NMOD6;
  norm_rows<0, true, false, false>(X, X, MT, p.in[6] + DM, modv1 + 0 * DM, modv1 + 1 * DM, H, X, (const float*)(ws + OFF_PART));
  xcd_barrier(xbar);
  { pg8::EpiBf16<0> E; E.O = (bf16_t*)(ws + OFF_QA); E.ldc = 1280;
    run_gemm(shm, H, DM, (const bf16_t*)(ws + OFF_WD), DM, DM, MT / 256, 1280 / 256, E); }
  if (gridDim.x == 256) xpose_deferred(p, shm, N_SLOTB_END, N_XT, 104);
  xcd_barrier(xbar);
  mla_norm_rows(p);
  xcd_barrier(xbar);
  { pg8::EpiBf16<0> E; E.O = (bf16_t*)(ws + OFF_Q); E.ldc = 3072;
    run_gemm(shm, (const bf16_t*)(ws + OFF_QN), 512, (const bf16_t*)(ws + OFF_WUQ), 512, 512, ML / 256, 3072 / 256, E); }
  { pg8::EpiBf16<0> E; E.O = (bf16_t*)(ws + OFF_KV); E.ldc = 4096;
    run_gemm(shm, (const bf16_t*)(ws + OFF_CKVN), 512, (const bf16_t*)(ws + OFF_WUKV), 512, 512, MT / 256, 4096 / 256, E); }
  xcd_barrier(xbar);
  for (int t = blockIdx.x; t < 1024; t += gridDim.x) mla_task(p, t, shm);
  xcd_barrier(xbar);
  { pg8::EpiResid<false> E; E.xin = X; E.xout = X; E.gate = modv1 + 2 * DM;
    run_gemm(shm, H, DM, (const bf16_t*)(ws + OFF_WO), DM, DM, ML / 256, DM / 256, E); }
  xcd_barrier(xbar);
  norm_rows<0, false, false, false>(X, X, ML, p.in[7] + DM, modv1 + 3 * DM, modv1 + 4 * DM, H);
  xcd_barrier(xbar);
  { pg8::EpiBf16<1> E; E.O = (bf16_t*)(ws + OFF_HID); E.ldc = DFF;
    run_gemm(shm, H, DM, (const bf16_t*)(ws + OFF_W1 + (size_t)8192 * 2048 * 2), DM, DM, ML / 256, DFF / 256, E); }
  xcd_barrier(xbar);
  { pg8::EpiResid<false> E; E.xin = X; E.xout = X; E.gate = modv1 + 5 * DM;
    run_gemm(shm, (const bf16_t*)(ws + OFF_HID), DFF, (const bf16_t*)(ws + OFF_W2 + (size_t)2048 * 8192 * 2), DFF, DFF, ML / 256, DM / 256, E); }
  xcd_barrier(xbar);
  norm_rows<1, false, false, false>(X, X, ML, p.in[27], nullptr, nullptr, p.out);
}

extern "C" void kernel_launch(void* const* d_in, const int* in_sizes, int n_in, void* d_out, int out_size, void* d_ws, size_t ws_size, hipStream_t stream) {
  static int grid_blocks = 0;
  if (!grid_blocks) {
    if (n_in != 28 || ws_size < WS_NEED || out_size != ML * DM) { fprintf(stderr, "kernel_launch: unexpected shapes (n_in %d, ws %zu need %zu, out %d)\n", n_in, ws_size, (size_t)WS_NEED, out_size); return; }
    if (hipFuncSetAttribute((const void*)fwd_megakernel, hipFuncAttributeMaxDynamicSharedMemorySize, LDS_BYTES) != hipSuccess) { fprintf(stderr, "kernel_launch: LDS attribute failed\n"); return; }
    int dev = 0, cus = 0, per_cu = 0;
    hipGetDevice(&dev);
    hipDeviceGetAttribute(&cus, hipDeviceAttributeMultiprocessorCount, dev);
    hipOccupancyMaxActiveBlocksPerMultiprocessor(&per_cu, fwd_megakernel, 512, LDS_BYTES);
    if (per_cu < 1) { fprintf(stderr, "kernel_launch: occupancy query gave %d\n", per_cu); return; }
    grid_blocks = cus;
  }
  Params p{};
  for (int i = 0; i < 28; ++i) p.in[i] = (const float*)d_in[i];
  p.out = (float*)d_out; p.ws = (char*)d_ws;
  for (int i = 0; i < 16; ++i) p.inv[i] = (float)pow(10000.0, -(double)i / 16.0);
  hipMemsetAsync((char*)d_ws + OFF_BAR, 0, 16384, stream);
  void* args[] = {&p};
  hipError_t e = hipLaunchCooperativeKernel((void*)fwd_megakernel, dim3(grid_blocks), dim3(512), args, LDS_BYTES, stream);
  if (e != hipSuccess) fprintf(stderr, "cooperative launch failed: %s (grid %d)\n", hipGetErrorString(e), grid_blocks);
}
#endif
```

```cpp
#include <hip/hip_runtime.h>
#include <hip/hip_cooperative_groups.h>
#include <cstdio>
#include <cmath>
#include <cstdint>
namespace cg = cooperative_groups;

#define LAS __attribute__((address_space(3)))
typedef unsigned short bf16_t;
typedef short bf16x8 __attribute__((ext_vector_type(8)));
typedef short s16x4 __attribute__((ext_vector_type(4)));
typedef float f32x4 __attribute__((ext_vector_type(4)));
typedef float f32x2 __attribute__((ext_vector_type(2)));
typedef float f32x16 __attribute__((ext_vector_type(16)));
typedef unsigned u32x4 __attribute__((ext_vector_type(4)));
typedef unsigned u32x2 __attribute__((ext_vector_type(2)));

constexpr int DM = 2048, NBATCH = 8, SEQ = 2048, CTXL = 256, ML = NBATCH * SEQ, MC = NBATCH * CTXL, MT = ML + MC;
constexpr int DFF = 8192, ABIN = 5120, NMOD6 = 6 * DM;
constexpr int LDS_BYTES = 155648;

constexpr size_t OFF_WIN  = 0;
constexpr size_t OFF_WOUT = OFF_WIN  + (size_t)5120 * 2048 * 2;
constexpr size_t OFF_W1   = OFF_WOUT + (size_t)2048 * 2048 * 2;
constexpr size_t OFF_W2   = OFF_W1   + (size_t)2 * 8192 * 2048 * 2;
constexpr size_t OFF_WD   = OFF_W2   + (size_t)2 * 2048 * 8192 * 2;
constexpr size_t OFF_WUQ  = OFF_WD   + (size_t)1280 * 2048 * 2;
constexpr size_t OFF_WUKV = OFF_WUQ  + (size_t)3072 * 512 * 2;
constexpr size_t OFF_WO   = OFF_WUKV + (size_t)4096 * 512 * 2;
constexpr size_t OFF_WL   = OFF_WO   + (size_t)2048 * 2048 * 2;
constexpr size_t OFF_MODV = OFF_WL   + (size_t)8 * 512 * 128 * 2;
constexpr size_t OFF_ROPE = OFF_MODV + (size_t)2 * 9 * NMOD6 * 4;
constexpr size_t OFF_LSUM = OFF_ROPE + (size_t)64 * 16 * 2 * 4;
constexpr size_t OFF_X    = OFF_LSUM + (size_t)8 * 8 * 18 * 2 * 128 * 2 * 4;
constexpr size_t OFF_H    = OFF_X    + (size_t)MT * DM * 4;
constexpr size_t OFF_R    = OFF_H    + (size_t)MT * DM * 2;
constexpr size_t OFF_P    = OFF_R;
constexpr size_t OFF_MIX  = OFF_R + (size_t)MT * ABIN * 2;
constexpr size_t OFF_QA   = OFF_R;
constexpr size_t OFF_QN   = OFF_QA   + (size_t)MT * 1280 * 2;
constexpr size_t OFF_CKVN = OFF_QN   + (size_t)ML * 512 * 2;
constexpr size_t OFF_KPE  = OFF_CKVN + (size_t)MT * 512 * 2;
constexpr size_t OFF_Q    = OFF_KPE  + (size_t)MT * 64 * 2;
constexpr size_t OFF_KV   = OFF_Q    + (size_t)ML * 3072 * 2;
constexpr size_t WS_END   = OFF_KV   + (size_t)MT * 4096 * 2;
constexpr size_t OFF_HID  = OFF_R;
constexpr size_t OFF_PART = OFF_R + (size_t)MT * DFF * 2;
constexpr size_t OFF_BAR  = OFF_PART + (size_t)4 * MC * DM * 4;
constexpr size_t WS_NEED  = OFF_BAR + 16384;

struct Params {
  const float* in[28];
  float* out;
  char* ws;
  float inv[16];
};

__device__ __forceinline__ unsigned cvt_pk_bf16(float lo, float hi) { unsigned r; asm volatile("v_cvt_pk_bf16_f32 %0, %1, %2" : "=v"(r) : "v"(lo), "v"(hi)); return r; }
__device__ __forceinline__ float bf2f(bf16_t b) { return __uint_as_float(((unsigned)b) << 16); }
__device__ __forceinline__ float bflo(unsigned w) { return __uint_as_float(w << 16); }
__device__ __forceinline__ float bfhi(unsigned w) { return __uint_as_float(w & 0xffff0000u); }
__device__ __forceinline__ float wave_sum(float v) {
#pragma unroll
  for (int o = 32; o >= 1; o >>= 1) v += __shfl_xor(v, o, 64);
  return v;
}
__device__ __forceinline__ int otid() { int t = threadIdx.x; asm volatile("" : "+v"(t)); return t; }
__device__ __forceinline__ float sigmoidf_(float x) { return 1.f / (1.f + __expf(-x)); }

namespace pg8 {
constexpr int BM = 256, BK = 64, HALF = 128, HTB = HALF * BK * 2, NXCD = 8, WGM = 8;
__device__ __forceinline__ int lds_byte(int r, int c) { const int st = (r >> 4) * 2 + (c >> 5), rr = r & 15, cc = c & 31, ob = rr * 64 + cc * 2; return st * 1024 + (ob ^ (((ob >> 9) & 1) << 5)); }
__device__ __forceinline__ void stage_rc(int b, int& R, int& C) { const int st = b / 1024, sb = b % 1024, swz = sb ^ (((sb >> 9) & 1) << 5); R = (st >> 1) * 16 + swz / 64; C = (st & 1) * 32 + (swz % 64) / 2; }
__device__ __forceinline__ int perm32(int rho) { const int n = rho >> 4, i = rho & 15; return 8 * (i >> 2) + 4 * n + (i & 3); }
struct Unit { int pm, pn, kb; };
struct Gemm { const bf16_t* A; const bf16_t* Bt; int lda, ldb, K, nM, nN; };
struct StaticOrder {
  int nM, nN, nwg, G, c;
  __device__ void init(int nM_, int nN_, int G_, int c_) { nM = nM_; nN = nN_; nwg = nM * nN; G = G_; c = c_; }
  __device__ bool next(int i, Unit& u) const {
    const long L = (long)i * G + c; if (L >= nwg) return false;
    int wgid = (int)L; { const int q = nwg / NXCD, r = nwg % NXCD, xcd = wgid % NXCD, off = wgid / NXCD; wgid = (xcd < r ? xcd * (q + 1) : r * (q + 1) + (xcd - r) * q) + off; }
    const int nig = WGM * nN, gid = wgid / nig, fm = gid * WGM, gsz = (nM - fm) < WGM ? (nM - fm) : WGM;
    u.pm = fm + ((wgid % nig) % gsz); u.pn = (wgid % nig) / gsz; u.kb = 0; return true;
  }
};
struct SplitOrder {
  int pm0, nMs, nN, NS, Kp, nwg, G, c;
  __device__ void init(int pm0_, int nMs_, int nN_, int NS_, int Kp_, int G_, int c_) { pm0 = pm0_; nMs = nMs_; nN = nN_; NS = NS_; Kp = Kp_; nwg = nMs * nN * NS; G = G_; c = c_; }
  __device__ bool next(int i, Unit& u) const {
    const long L = (long)i * G + c; if (L >= nwg) return false;
    const int l = (int)L; const int part = l % NS, tile = l / NS;
    u.pm = pm0 + tile % nMs; u.pn = tile / nMs; u.kb = part * Kp * 2; return true;
  }
};

template <class Epi, class Sched, bool ALIGN_EPI = true>
__device__ __forceinline__ void gemm_phase(LAS unsigned char* lds, const Gemm g, const Sched& S, const Epi& E) {
  const int tid = otid(), wid = __builtin_amdgcn_readfirstlane(tid >> 6), lane = tid & 63, wr = wid >> 2, wc = wid & 3, fr = lane & 15, fq = lane >> 4;
  const int K = g.K, nt = K / BK;
  unsigned voffA[2], voffB[2];
#pragma unroll
  for (int i = 0; i < 2; ++i) { int R, C; stage_rc(tid * 16 + i * 8192, R, C); const int Rb = Epi::PERM ? ((R & ~31) + perm32(R & 31)) : R;
    voffA[i] = (unsigned)(R * g.lda + C) * 2u; voffB[i] = (unsigned)(Rb * g.ldb + C) * 2u; }
  const size_t kstep = (size_t)(BK * 2);
  const size_t hstepA = (size_t)HALF * g.lda * 2, hstepB = (size_t)HALF * g.ldb * 2;
  const size_t tstepA = 2 * hstepA, tstepB = 2 * hstepB;
  const unsigned ldsw = (unsigned)wid * 1024u;
  const int aoff = lds_byte(wr * 64 + fr, fq * 8), boff = lds_byte(wc * 32 + fr, fq * 8);
#define PG8_SA(b, h) (((b) * 2 + (h)) * HTB)
#define PG8_SB(b, h) ((4 + (b) * 2 + (h)) * HTB)
#define PG8_STAGE(bufoff, gbase, voff) do { _Pragma("unroll") for (int _i = 0; _i < 2; ++_i) \
    __builtin_amdgcn_global_load_lds((const unsigned*)((const char*)(gbase) + (voff)[_i]), (LAS unsigned*)(lds + (bufoff) + ldsw + _i * 8192), 16, 0, 0); } while (0)
#define PG8_LDA(dst, b, h) do { _Pragma("unroll") for (int m = 0; m < 4; ++m) _Pragma("unroll") for (int k = 0; k < 2; ++k) dst[m][k] = *(const LAS bf16x8*)(lds + PG8_SA(b, h) + aoff + m * 2048 + k * 1024); } while (0)
#define PG8_LDB(dst, b, h) do { _Pragma("unroll") for (int n = 0; n < 2; ++n) _Pragma("unroll") for (int k = 0; k < 2; ++k) dst[n][k] = *(const LAS bf16x8*)(lds + PG8_SB(b, h) + boff + n * 2048 + k * 1024); } while (0)
#define PG8_MMA(ai, bj, At, Bt) do { __builtin_amdgcn_s_setprio(1); _Pragma("unroll") for (int m = 0; m < 4; ++m) _Pragma("unroll") for (int n = 0; n < 2; ++n) _Pragma("unroll") for (int k = 0; k < 2; ++k) \
    acc[ai][bj][m][n] = __builtin_amdgcn_mfma_f32_16x16x32_bf16(Bt[n][k], At[m][k], acc[ai][bj][m][n], 0, 0, 0); __builtin_amdgcn_s_setprio(0); } while (0)
#define PG8_WAIT_V(n) asm volatile("s_waitcnt vmcnt(" #n ")" ::: "memory")
#define PG8_WAIT_L(n) asm volatile("s_waitcnt lgkmcnt(" #n ")" ::: "memory")
#define PG8_BAR __builtin_amdgcn_s_barrier()
#define PG8_SCHED __builtin_amdgcn_sched_barrier(0)
  Unit cur, nxt; int ui = 0;
  if (!S.next(0, cur)) return;
  f32x4 acc[2][2][4][2];
#pragma unroll
  for (int a = 0; a < 2; ++a)
#pragma unroll
    for (int b = 0; b < 2; ++b)
#pragma unroll
      for (int m = 0; m < 4; ++m)
#pragma unroll
        for (int n = 0; n < 2; ++n) acc[a][b][m][n] = (f32x4){0.f, 0.f, 0.f, 0.f};
  bf16x8 At[4][2], B0[2][2], B1[2][2];
  const char* cA = (const char*)g.A + (size_t)cur.pm * tstepA + cur.kb; const char* cB = (const char*)g.Bt + (size_t)cur.pn * tstepB + cur.kb;
  PG8_STAGE(PG8_SB(0, 0), cB, voffB); PG8_STAGE(PG8_SB(0, 1), cB + hstepB, voffB); PG8_STAGE(PG8_SA(0, 0), cA, voffA); PG8_STAGE(PG8_SA(0, 1), cA + hstepA, voffA);
  if (wr == 1) PG8_BAR;
  PG8_WAIT_V(2); PG8_BAR;
  PG8_STAGE(PG8_SB(1, 0), cB + kstep, voffB); PG8_STAGE(PG8_SA(1, 0), cA + kstep, voffA); PG8_STAGE(PG8_SB(1, 1), cB + hstepB + kstep, voffB);
  PG8_WAIT_V(6); PG8_BAR;
  for (;;) {
    const bool has_next = S.next(ui + 1, nxt);
    const char* nA = has_next ? (const char*)g.A + (size_t)nxt.pm * tstepA + nxt.kb : cA; const char* nB = has_next ? (const char*)g.Bt + (size_t)nxt.pn * tstepB + nxt.kb : cB;
    for (int t = 0; t < nt; t += 2) {
      const bool last = (t == nt - 2);
      const char* a1 = cA + (size_t)(t + 1) * kstep;
      const char* a2 = last ? nA : cA + (size_t)(t + 2) * kstep; const char* b2 = last ? nB : cB + (size_t)(t + 2) * kstep;
      const char* a3 = a2 + kstep; const char* b3 = b2 + kstep;
      PG8_LDB(B0, 0, 0); PG8_LDB(B1, 0, 1); PG8_SCHED; PG8_LDA(At, 0, 0); PG8_STAGE(PG8_SA(1, 1), a1 + hstepA, voffA);
      PG8_WAIT_V(8); PG8_WAIT_L(0); PG8_BAR; PG8_MMA(0, 0, At, B0); PG8_MMA(0, 1, At, B1); PG8_BAR; PG8_SCHED;
      PG8_LDA(At, 0, 1); PG8_STAGE(PG8_SB(0, 0), b2, voffB); PG8_STAGE(PG8_SB(0, 1), b2 + hstepB, voffB); PG8_STAGE(PG8_SA(0, 0), a2, voffA);
      PG8_WAIT_V(8); PG8_WAIT_L(0); PG8_BAR; PG8_MMA(1, 0, At, B0); PG8_MMA(1, 1, At, B1); PG8_BAR; PG8_SCHED;
      PG8_LDB(B0, 1, 0); PG8_LDB(B1, 1, 1); PG8_SCHED; PG8_LDA(At, 1, 0); PG8_STAGE(PG8_SA(0, 1), a2 + hstepA, voffA);
      PG8_WAIT_V(8); PG8_WAIT_L(0); PG8_BAR; PG8_MMA(0, 0, At, B0); PG8_MMA(0, 1, At, B1); PG8_BAR; PG8_SCHED;
      PG8_LDA(At, 1, 1); PG8_STAGE(PG8_SB(1, 0), b3, voffB); PG8_STAGE(PG8_SB(1, 1), b3 + hstepB, voffB); PG8_STAGE(PG8_SA(1, 0), a3, voffA);
      PG8_WAIT_V(8); PG8_WAIT_L(0); PG8_BAR; PG8_MMA(1, 0, At, B0); PG8_MMA(1, 1, At, B1); PG8_BAR; PG8_SCHED;
    }
    if constexpr (ALIGN_EPI) { if (wr == 0) PG8_BAR; }
    E(acc, cur, wr, wc, fr, fq);
    if (!has_next) break;
#pragma unroll
    for (int a = 0; a < 2; ++a)
#pragma unroll
      for (int b = 0; b < 2; ++b)
#pragma unroll
        for (int m = 0; m < 4; ++m)
#pragma unroll
          for (int n = 0; n < 2; ++n) acc[a][b][m][n] = (f32x4){0.f, 0.f, 0.f, 0.f};
    cur = nxt; cA = nA; cB = nB; ++ui;
    if constexpr (ALIGN_EPI) { if (wr == 1) PG8_BAR; }
  }
  PG8_WAIT_V(0);
  if constexpr (!ALIGN_EPI) { if (wr == 0) PG8_BAR; }
  PG8_BAR;
#undef PG8_SA
#undef PG8_SB
#undef PG8_STAGE
#undef PG8_LDA
#undef PG8_LDB
#undef PG8_MMA
#undef PG8_WAIT_V
#undef PG8_WAIT_L
#undef PG8_BAR
#undef PG8_SCHED
}

template <int ACT  > struct EpiBf16 {
  static constexpr bool PERM = true;
  bf16_t* O; int ldc;
  __device__ __forceinline__ void operator()(const f32x4 (&acc)[2][2][4][2], const Unit& u, int wr, int wc, int fr, int fq) const {
    const int row0 = u.pm * BM + wr * 64 + fr, col0 = u.pn * BM + wc * 32 + 8 * fq;
#pragma unroll
    for (int ai = 0; ai < 2; ++ai)
#pragma unroll
      for (int m = 0; m < 4; ++m) { bf16_t* rowp = O + (size_t)(row0 + ai * HALF + m * 16) * ldc + col0;
#pragma unroll
        for (int bj = 0; bj < 2; ++bj) { f32x4 v0 = acc[ai][bj][m][0], v1 = acc[ai][bj][m][1];
          if (ACT == 1) {
#pragma unroll
            for (int j = 0; j < 4; ++j) { float a = fmaxf(v0[j], 0.f), b = fmaxf(v1[j], 0.f); v0[j] = a * a; v1[j] = b * b; } }
          u32x4 w; w.x = cvt_pk_bf16(v0[0], v0[1]); w.y = cvt_pk_bf16(v0[2], v0[3]); w.z = cvt_pk_bf16(v1[0], v1[1]); w.w = cvt_pk_bf16(v1[2], v1[3]);
          *(u32x4*)(rowp + bj * HALF) = w; } }
  }
};
template <bool XIN_F32> struct EpiResid {
  static constexpr bool PERM = true;
  const void* xin; bf16_t* xout; const float* gate;
  __device__ __forceinline__ void operator()(const f32x4 (&acc)[2][2][4][2], const Unit& u, int wr, int wc, int fr, int fq) const {
    const int rowt = u.pm * BM; const int b = rowt >> 11;
    const int row0 = rowt + wr * 64 + fr, col0 = u.pn * BM + wc * 32 + 8 * fq;
    f32x4 gv[2][2];
#pragma unroll
    for (int bj = 0; bj < 2; ++bj)
#pragma unroll
      for (int n = 0; n < 2; ++n) gv[bj][n] = *(const f32x4*)(gate + (size_t)b * NMOD6 + col0 + bj * HALF + 4 * n);
#pragma unroll
    for (int ai = 0; ai < 2; ++ai)
#pragma unroll
      for (int m = 0; m < 4; ++m) { const size_t ro = (size_t)(row0 + ai * HALF + m * 16) * DM + col0;
#pragma unroll
        for (int bj = 0; bj < 2; ++bj) { f32x4 x0, x1;
          if constexpr (XIN_F32) { x0 = *(const f32x4*)((const float*)xin + ro + bj * HALF); x1 = *(const f32x4*)((const float*)xin + ro + bj * HALF + 4); }
          else { const u32x4 w = *(const u32x4*)((const bf16_t*)xin + ro + bj * HALF);
            x0 = (f32x4){bflo(w.x), bfhi(w.x), bflo(w.y), bfhi(w.y)}; x1 = (f32x4){bflo(w.z), bfhi(w.z), bflo(w.w), bfhi(w.w)}; }
          const f32x4 v0 = x0 + gv[bj][0] * acc[ai][bj][m][0], v1 = x1 + gv[bj][1] * acc[ai][bj][m][1];
          u32x4 o; o.x = cvt_pk_bf16(v0[0], v0[1]); o.y = cvt_pk_bf16(v0[2], v0[3]); o.z = cvt_pk_bf16(v1[0], v1[1]); o.w = cvt_pk_bf16(v1[2], v1[3]);
          *(u32x4*)(xout + ro + bj * HALF) = o; } }
  }
};
struct EpiPartial {
  static constexpr bool PERM = false;
  float* part; const float* gate; int kp2;
  __device__ __forceinline__ void operator()(const f32x4 (&acc)[2][2][4][2], const Unit& u, int wr, int wc, int fr, int fq) const {
    const int row0 = u.pm * BM - ML + wr * 64 + fr, col0 = u.pn * BM + wc * 32 + 4 * fq;
    float* base = part + (size_t)(u.kb / kp2) * MC * DM;
    f32x4 gv[2][2];
#pragma unroll
    for (int bj = 0; bj < 2; ++bj)
#pragma unroll
      for (int n = 0; n < 2; ++n) gv[bj][n] = *(const f32x4*)(gate + (size_t)8 * NMOD6 + col0 + bj * HALF + n * 16);
#pragma unroll
    for (int ai = 0; ai < 2; ++ai)
#pragma unroll
      for (int m = 0; m < 4; ++m) { const size_t ro = (size_t)(row0 + ai * HALF + m * 16) * DM + col0;
#pragma unroll
        for (int bj = 0; bj < 2; ++bj)
#pragma unroll
          for (int n = 0; n < 2; ++n) *(f32x4*)(base + ro + bj * HALF + n * 16) = gv[bj][n] * acc[ai][bj][m][n]; }
  }
};
}

namespace att {
constexpr int NW = 8, QBLK = 32, KVBLK = 64;
constexpr size_t SHM_V = KVBLK * 128 * 2;
#define SBAR() __builtin_amdgcn_sched_barrier(0)
__device__ __forceinline__ int crow(int r, int hi) { return (r & 3) + 8 * (r >> 2) + 4 * hi; }

__device__ __forceinline__ void partialSM(f32x16& p0, f32x16& p1, float& m_reg, float& mn, float& alpha, const float C, const float THRS) {
  float pmax = p0[0];
#pragma unroll
  for (int r = 1; r < 16; ++r) pmax = fmaxf(pmax, p0[r]);
#pragma unroll
  for (int r = 0; r < 16; ++r) pmax = fmaxf(pmax, p1[r]);
  { auto rr = __builtin_amdgcn_permlane32_swap(__float_as_uint(pmax), __float_as_uint(pmax), false, false);
    pmax = fmaxf(__uint_as_float(rr[0]), __uint_as_float(rr[1])); }
  if (__builtin_expect(__all(pmax - m_reg <= THRS), 1)) { mn = m_reg; alpha = 1.f; }
  else { mn = fmaxf(m_reg, pmax); alpha = __builtin_amdgcn_exp2f((m_reg - mn) * C); m_reg = mn; }
  float mnC = -mn * C;
#pragma unroll
  for (int r = 0; r < 16; ++r) p0[r] = fmaf(p0[r], C, mnC);
#pragma unroll
  for (int r = 0; r < 16; ++r) p1[r] = fmaf(p1[r], C, mnC);
#pragma unroll
  for (int r = 0; r < 16; ++r) p0[r] = __builtin_amdgcn_exp2f(p0[r]);
}
__device__ __forceinline__ void finishSM(f32x16& p0, f32x16& p1, float alpha, float& l_reg, bf16x8& pa0, bf16x8& pa1, bf16x8& pa2, bf16x8& pa3) {
#pragma unroll
  for (int r = 0; r < 16; ++r) p1[r] = __builtin_amdgcn_exp2f(p1[r]);
  float ps = 0;
#pragma unroll
  for (int r = 0; r < 16; ++r) ps += p0[r];
#pragma unroll
  for (int r = 0; r < 16; ++r) ps += p1[r];
  { auto rr = __builtin_amdgcn_permlane32_swap(__float_as_uint(ps), __float_as_uint(ps), false, false);
    ps = __uint_as_float(rr[0]) + __uint_as_float(rr[1]); }
  l_reg = l_reg * alpha + ps;
#define PK4(P, BASE, OUT) do { unsigned a0 = cvt_pk_bf16(P[BASE + 0], P[BASE + 1]), a1 = cvt_pk_bf16(P[BASE + 2], P[BASE + 3]);   \
    unsigned b0 = cvt_pk_bf16(P[BASE + 4], P[BASE + 5]), b1 = cvt_pk_bf16(P[BASE + 6], P[BASE + 7]);                              \
    auto r0 = __builtin_amdgcn_permlane32_swap(a0, b0, false, false); auto r1 = __builtin_amdgcn_permlane32_swap(a1, b1, false, false); \
    u32x4 w = {r0[0], r1[0], r0[1], r1[1]}; OUT = *reinterpret_cast<bf16x8*>(&w); } while (0)
  PK4(p0, 0, pa0); PK4(p0, 8, pa1); PK4(p1, 0, pa2); PK4(p1, 8, pa3);
#undef PK4
}
template <int DQK>
__device__ __forceinline__ void qkt(f32x16& p0, f32x16& p1, const char* Ks, const bf16x8* qr, const char* ql, int r32, int hi) {
  p0 = f32x16{}; p1 = f32x16{};
#pragma unroll
  for (int d0 = 0; d0 < DQK / 16; ++d0) { const int cb = (d0 * 16 + hi * 8) * 2;
    bf16x8 b0 = *reinterpret_cast<const bf16x8*>(Ks + r32 * (DQK * 2) + (cb ^ ((r32 & 7) << 4)));
    bf16x8 b1 = *reinterpret_cast<const bf16x8*>(Ks + (32 + r32) * (DQK * 2) + (cb ^ ((r32 & 7) << 4)));
    constexpr int NQR = DQK == 192 ? 4 : 8;
    bf16x8 qv; if (d0 < NQR) qv = qr[d0 < NQR ? d0 : 0]; else qv = *reinterpret_cast<const bf16x8*>(ql + (d0 - NQR) * 1024);
    p0 = __builtin_amdgcn_mfma_f32_32x32x16_bf16(b0, qv, p0, 0, 0, 0);
    p1 = __builtin_amdgcn_mfma_f32_32x32x16_bf16(b1, qv, p1, 0, 0, 0); }
}
__device__ __forceinline__ int v_st(int k, int c) { const int kk = (k & ~0xC) | ((k & 4) << 1) | ((k & 8) >> 1); return ((kk >> 3) * 4 + (c >> 5)) * 512 + ((kk & 7) * 32 + (c & 31)) * 2; }
__device__ __forceinline__ int v_rd_base(int lane) { return ((lane & 3) << 3) | (((lane >> 2) & 3) << 6) | (((lane >> 4) & 1) << 5) | (((lane >> 5) & 1) << 8); }
constexpr int v_rd_off(int d0, int ks, int half) { return d0 * 512 + ks * 4096 + half * 2048; }
template <int OFF> __device__ __forceinline__ s16x4 tr_read(int vb) {
  s16x4 r; asm volatile("ds_read_b64_tr_b16 %0, %1 offset:%2" : "=&v"(r) : "v"(vb), "i"(OFF) : "memory"); return r;
}
template <int D0> __device__ __forceinline__ void pv_one(f32x16& od, int vb, bf16x8 pa0, bf16x8 pa1, bf16x8 pa2, bf16x8 pa3) {
  const s16x4 l0 = tr_read<v_rd_off(D0, 0, 0)>(vb), h0 = tr_read<v_rd_off(D0, 0, 1)>(vb), l1 = tr_read<v_rd_off(D0, 1, 0)>(vb), h1 = tr_read<v_rd_off(D0, 1, 1)>(vb);
  const s16x4 l2 = tr_read<v_rd_off(D0, 2, 0)>(vb), h2 = tr_read<v_rd_off(D0, 2, 1)>(vb), l3 = tr_read<v_rd_off(D0, 3, 0)>(vb), h3 = tr_read<v_rd_off(D0, 3, 1)>(vb);
  asm volatile("s_waitcnt lgkmcnt(0)" ::: "memory"); SBAR();
#define PK(L, H) (bf16x8){L[0], L[1], L[2], L[3], H[0], H[1], H[2], H[3]}
  od = __builtin_amdgcn_mfma_f32_32x32x16_bf16(pa0, PK(l0, h0), od, 0, 0, 0);
  od = __builtin_amdgcn_mfma_f32_32x32x16_bf16(pa1, PK(l1, h1), od, 0, 0, 0);
  od = __builtin_amdgcn_mfma_f32_32x32x16_bf16(pa2, PK(l2, h2), od, 0, 0, 0);
  od = __builtin_amdgcn_mfma_f32_32x32x16_bf16(pa3, PK(l3, h3), od, 0, 0, 0);
#undef PK
}
__device__ __forceinline__ void pv_d0(f32x16* o, int vb, bf16x8 pa0, bf16x8 pa1, bf16x8 pa2, bf16x8 pa3) {
  pv_one<0>(o[0], vb, pa0, pa1, pa2, pa3); pv_one<1>(o[1], vb, pa0, pa1, pa2, pa3); pv_one<2>(o[2], vb, pa0, pa1, pa2, pa3); pv_one<3>(o[3], vb, pa0, pa1, pa2, pa3);
}

struct Job {
  const bf16_t* Qb; int ldq;
  const bf16_t* Kb; const bf16_t* Vb; int ldk;
  const bf16_t* Pe;
  bf16_t* Ob; int ldo;
  int NT;
  int rowA, nA, rowB;
  int qb4;
  int lo, nwin;
  const float* rope; int tok0;
};

template <int MODE>
__device__ __forceinline__ void attn_body(const Job J, char* lds) {
  constexpr int DQK = (MODE == 2) ? 192 : 128;
  constexpr size_t SHM_K = KVBLK * DQK * 2;
  constexpr float SCALE = (MODE == 2) ? 0.07216878364870323f : 0.08838834764831845f;
  constexpr float C = SCALE * 1.4426950408889634f;
  constexpr float THRS = 8.f / SCALE;
  const int tid = otid(), wid = tid >> 6, lane = tid & 63, r32 = lane & 31, hi = lane >> 5;
  char* V_lds = lds; char* K_lds = lds + 2 * SHM_V;
  float* wsf = (float*)(lds + 2 * SHM_V + 2 * SHM_K) + wid * 64; float* li_l = wsf; float* al_l = wsf + 32;
  const float* tab = (const float*)(lds + 2 * SHM_V + 2 * SHM_K + NW * 256) + 64;
  constexpr int NQR = (MODE == 2) ? 4 : 8;
  float m_reg = -1e30f, l_reg = 0; f32x16 o[4] = {}; bf16x8 qr[NQR];
  const bf16_t* Qw = J.Qb + (size_t)(wid * QBLK + r32) * J.ldq + hi * 8;
  char* ql = lds + 2 * SHM_V + 2 * SHM_K + NW * 256 + (wid * 8 * 64 + lane) * 16;
#pragma unroll
  for (int d0 = 0; d0 < NQR; ++d0) qr[d0] = *reinterpret_cast<const bf16x8*>(Qw + d0 * 16);
  if constexpr (MODE == 2) {
#pragma unroll
    for (int d0 = 4; d0 < 8; ++d0) *reinterpret_cast<bf16x8*>(ql + (d0 - 4) * 1024) = *reinterpret_cast<const bf16x8*>(Qw + d0 * 16);
    const int tok = J.tok0 + wid * QBLK + r32; const int prow = tok >> 6, pcol = tok & 63;
#pragma unroll
    for (int ax = 0; ax < 2; ++ax) {
      const float* cs = J.rope + (size_t)((ax == 0 ? prow : pcol) * 16 + hi * 8) * 2;
      bf16x8 x1 = *reinterpret_cast<const bf16x8*>(Qw + (8 + 2 * ax) * 16), x2 = *reinterpret_cast<const bf16x8*>(Qw + (9 + 2 * ax) * 16); u32x4 w1, w2;
#pragma unroll
      for (int i = 0; i < 4; ++i) {
        const f32x4 t = *(const f32x4*)(cs + 4 * i);
        const float a0 = bf2f((bf16_t)x1[2 * i]), a1 = bf2f((bf16_t)x1[2 * i + 1]), b0 = bf2f((bf16_t)x2[2 * i]), b1 = bf2f((bf16_t)x2[2 * i + 1]);
        w1[i] = cvt_pk_bf16(a0 * t[0] - b0 * t[1], a1 * t[2] - b1 * t[3]);
        w2[i] = cvt_pk_bf16(a0 * t[1] + b0 * t[0], a1 * t[3] + b1 * t[2]);
      }
      *reinterpret_cast<u32x4*>(ql + (4 + 2 * ax) * 1024) = w1; *reinterpret_cast<u32x4*>(ql + (5 + 2 * ax) * 1024) = w2;
    }
  }
  const int sr = tid >> 4, sc = (tid & 15) * 8, vst0 = v_st(sr, sc), vst1 = v_st(32 + sr, sc);
  const int pr = tid >> 3, pc = (tid & 7) * 8;
  const int vb0 = (int)(uintptr_t)V_lds + v_rd_base(lane);
  bf16x8 vs0, vs1, ks0, ks1, kp;
  const int rq = J.qb4 + (wid >> 1), qc = (wid & 1) * 32 + r32;
  const int rs = min(max(rq - 4, 0), 24), cs_ = min(max(qc - 8, 0), 48);
#define TROW(t) ((t) < J.nA ? J.rowA + 64 * (t) : J.rowB + 64 * ((t) - J.nA))
#define SLOAD(t) do { const int _r0 = TROW(t); \
    vs0 = *reinterpret_cast<const bf16x8*>(J.Vb + (size_t)(_r0 + sr) * J.ldk + sc); vs1 = *reinterpret_cast<const bf16x8*>(J.Vb + (size_t)(_r0 + 32 + sr) * J.ldk + sc); \
    ks0 = *reinterpret_cast<const bf16x8*>(J.Kb + (size_t)(_r0 + sr) * J.ldk + sc); ks1 = *reinterpret_cast<const bf16x8*>(J.Kb + (size_t)(_r0 + 32 + sr) * J.ldk + sc); \
    if constexpr (MODE == 2) kp = *reinterpret_cast<const bf16x8*>(J.Pe + (size_t)(_r0 + pr) * 64 + pc); } while (0)
#define SWRITE(b) do { *(bf16x8*)(V_lds + (b) * SHM_V + vst0) = vs0; *(bf16x8*)(V_lds + (b) * SHM_V + vst1) = vs1; const int kc = sc * 2; \
    *(bf16x8*)(K_lds + (b) * SHM_K + sr * (DQK * 2) + (kc ^ ((sr & 7) << 4))) = ks0; \
    *(bf16x8*)(K_lds + (b) * SHM_K + (32 + sr) * (DQK * 2) + (kc ^ ((sr & 7) << 4))) = ks1; \
    if constexpr (MODE == 2) *(bf16x8*)(K_lds + (b) * SHM_K + pr * (DQK * 2) + (((128 + pc) * 2) ^ ((pr & 7) << 4))) = kp; } while (0)
#define SWAIT() asm volatile("s_waitcnt vmcnt(0)" ::: "memory")
#define RESC(a) do { if (__any((a) < 1.f)) { if (hi == 0) al_l[r32] = (a); asm volatile("s_waitcnt lgkmcnt(0)" ::: "memory"); \
    _Pragma("unroll") for (int d = 0; d < 4; ++d) _Pragma("unroll") for (int r = 0; r < 16; ++r) o[d][r] *= al_l[crow(r, hi)]; } } while (0)
#define MASK(P0, P1, t) do { if constexpr (MODE == 0) { if ((t) >= J.nA) { const int _w = (t) - J.nA; const int _kr = J.lo + _w; \
      if (_w < J.nwin && _kr >= rs && _kr < rs + 8) { const float* _tr = tab + (_kr - rq + 7) * 31 + 15 - qc; \
        _Pragma("unroll") for (int r = 0; r < 16; ++r) { const int kc0 = crow(r, hi); \
          const float b0 = _tr[kc0], b1 = _tr[kc0 + 32]; \
          P0[r] = ((unsigned)(kc0 - cs_) < 16u) ? P0[r] + b0 : -1e30f; P1[r] = ((unsigned)(kc0 + 32 - cs_) < 16u) ? P1[r] + b1 : -1e30f; } } \
      else { _Pragma("unroll") for (int r = 0; r < 16; ++r) { P0[r] = -1e30f; P1[r] = -1e30f; } } } } } while (0)
  f32x16 pA0, pA1, pB0, pB1; float mnA, mnB, alA, alB; bf16x8 pa0, pa1, pa2, pa3; const int NT = J.NT;
  SLOAD(0); SWAIT(); SWRITE(0); __syncthreads();
  qkt<DQK>(pA0, pA1, K_lds, qr, ql, r32, hi); MASK(pA0, pA1, 0); partialSM(pA0, pA1, m_reg, mnA, alA, C, THRS);
  SLOAD(1);
  SWAIT(); SWRITE(1); __syncthreads();
  for (int j = 1; j + 1 < NT; j += 2) {
    SBAR(); qkt<DQK>(pB0, pB1, K_lds + SHM_K, qr, ql, r32, hi);
    finishSM(pA0, pA1, alA, l_reg, pa0, pa1, pa2, pa3); SBAR();
    SLOAD(j + 1); SBAR();
    pv_d0(o, vb0, pa0, pa1, pa2, pa3); MASK(pB0, pB1, j); partialSM(pB0, pB1, m_reg, mnB, alB, C, THRS);
    __syncthreads(); SWAIT(); SWRITE(0);
    RESC(alB); __syncthreads();
    SBAR(); qkt<DQK>(pA0, pA1, K_lds, qr, ql, r32, hi);
    finishSM(pB0, pB1, alB, l_reg, pa0, pa1, pa2, pa3); SBAR();
    SLOAD(j + 2); SBAR();
    pv_d0(o, vb0 + (int)SHM_V, pa0, pa1, pa2, pa3); MASK(pA0, pA1, j + 1); partialSM(pA0, pA1, m_reg, mnA, alA, C, THRS);
    __syncthreads(); SWAIT(); SWRITE(1);
    RESC(alA); __syncthreads();
  }
  SBAR(); qkt<DQK>(pB0, pB1, K_lds + SHM_K, qr, ql, r32, hi);
  finishSM(pA0, pA1, alA, l_reg, pa0, pa1, pa2, pa3); SBAR();
  pv_d0(o, vb0, pa0, pa1, pa2, pa3); MASK(pB0, pB1, NT - 1); partialSM(pB0, pB1, m_reg, mnB, alB, C, THRS);
  __syncthreads(); RESC(alB);
  finishSM(pB0, pB1, alB, l_reg, pa0, pa1, pa2, pa3); SBAR();
  pv_d0(o, vb0 + (int)SHM_V, pa0, pa1, pa2, pa3);
  if (hi == 0) li_l[r32] = l_reg; asm volatile("s_waitcnt lgkmcnt(0)" ::: "memory");
  float rli[16];
#pragma unroll
  for (int r = 0; r < 16; ++r) rli[r] = __builtin_amdgcn_rcpf(li_l[crow(r, hi)]);
  bf16_t* Ow = J.Ob + (size_t)(wid * QBLK) * J.ldo;
#pragma unroll
  for (int r = 0; r < 16; ++r) { const int orow = crow(r, hi);
#pragma unroll
    for (int d0 = 0; d0 < 4; ++d0) Ow[(size_t)orow * J.ldo + d0 * 32 + r32] = (bf16_t)(cvt_pk_bf16(o[d0][r] * rli[r], 0.f) & 0xffffu); }
#undef TROW
#undef SLOAD
#undef SWRITE
#undef SWAIT
#undef RESC
#undef MASK
}
}

__constant__ int XJOB[11][6] = {
  {10, 0, 2048, 5120, 0, 0},
  {11, 0, 2048, 2048, 0, 640},
  {8, 0, 2048, 8192, 0, 896},
  {20, 0, 2048, 512, 0, 1920},
  {21, 0, 2048, 576, 512, 1984},
  {9, 0, 8192, 2048, 0, 2064},
  {8, 2048 * 8, 2048, 8192, 0, 3088},
  {9, 8192 * 2, 8192, 2048, 0, 4112},
  {23, 0, 512, 3072, 0, 5136},
  {25, 0, 512, 4096, 0, 5232},
  {26, 0, 2048, 2048, 0, 5360},
};
constexpr int N_XT = 5616, N_EARLY = 640, N_SLOTA_END = 2752, N_SLOTB_END = 3088, N_GEMV = 192;

__device__ __forceinline__ size_t xjob_dst(int j) {
  switch (j) {
    case 0: return OFF_WIN; case 1: return OFF_WOUT; case 2: return OFF_W1; case 3: return OFF_WD; case 4: return OFF_WD;
    case 5: return OFF_W2; case 6: return OFF_W1 + (size_t)8192 * 2048 * 2; case 7: return OFF_W2 + (size_t)2048 * 8192 * 2;
    case 8: return OFF_WUQ; case 9: return OFF_WUKV; default: return OFF_WO;
  }
}

__device__ __forceinline__ void xpose_core(const float* src, int N, bf16_t* dst, int K, int k0, int n0, float* fs, int tid);
__device__ __forceinline__ void xpose_tile(const Params& p, int tt, float* fs, int tid) {
  int j = 0;
#pragma unroll
  for (int q = 1; q < 11; ++q) if (tt >= XJOB[q][5]) j = q;
  const int K = XJOB[j][2], N = XJOB[j][3], tl = tt - XJOB[j][5];
  const int tilesN = (N + 127) / 128; const int tk = tl / tilesN, tn = tl % tilesN;
  const float* src = p.in[XJOB[j][0]] + (size_t)XJOB[j][1] * 1024;
  bf16_t* dst = (bf16_t*)(p.ws + xjob_dst(j)) + (size_t)XJOB[j][4] * K;
  xpose_core(src, N, dst, K, tk * 128, tn * 128, fs, tid);
}
__device__ __forceinline__ void xpose_core(const float* src, int N, bf16_t* dst, int K, int k0, int n0, float* fs, int tid) {
  { const int nn = (tid & 31) * 4, kr = tid >> 5; f32x4 v[8];
#pragma unroll
    for (int q = 0; q < 8; ++q) v[q] = (n0 + nn < N) ? *(const f32x4*)(src + (size_t)(k0 + kr + 16 * q) * N + n0 + nn) : (f32x4){0.f, 0.f, 0.f, 0.f};
#pragma unroll
    for (int q = 0; q < 8; ++q) { float* d = fs + (kr + 16 * q) * 129 + nn; d[0] = v[q][0]; d[1] = v[q][1]; d[2] = v[q][2]; d[3] = v[q][3]; } }
  __syncthreads();
  { const int nl = tid >> 4, kc = (tid & 15) * 8;
#pragma unroll
    for (int q = 0; q < 4; ++q) { const int n = nl + 32 * q;
      if (n0 + n < N) { float e[8];
#pragma unroll
        for (int i = 0; i < 8; ++i) e[i] = fs[(kc + i) * 129 + n];
        u32x4 w; w.x = cvt_pk_bf16(e[0], e[1]); w.y = cvt_pk_bf16(e[2], e[3]); w.z = cvt_pk_bf16(e[4], e[5]); w.w = cvt_pk_bf16(e[6], e[7]);
        *(u32x4*)(dst + (size_t)(n0 + n) * K + k0 + kc) = w; } } }
}
__device__ __forceinline__ void xpose_deferred(const Params& p, char* shm, int lo, int hi, int c0) {
  if ((int)blockIdx.x < c0) return;
  const int tid = otid();
  for (int t = lo + (int)blockIdx.x - c0; t < hi; t += (int)gridDim.x - c0) { __syncthreads(); xpose_tile(p, t, (float*)shm, tid); }
}

__device__ __forceinline__ void phase0(const Params& p, char* shm) {
  const int tid = otid();
  float* fs = (float*)shm;
  bool cond_ready = false;
  const int n_xt0 = (gridDim.x == 256) ? N_EARLY : N_XT;
  const int T0_TOTAL = N_GEMV + n_xt0 + 32 + 1 + 1;
  for (int it = 0; ; ++it) {
    int task;
    if (gridDim.x == 256) {
      const int c = blockIdx.x;
      if (c < 192) { if (it == 0) task = c; else if (it == 1 && c < 34) task = N_GEMV + n_xt0 + c; else break; }
      else { if (it < 10) task = N_GEMV + (c - 192) * 10 + it; else break; }
    } else { task = blockIdx.x + it * gridDim.x; if (task >= T0_TOTAL) break; }
    __syncthreads();
    if (task < N_GEMV) {
      float* condS = fs;
      float* red = fs + 9 * 2048;
      if (!cond_ready) {
        for (int i = tid; i < 9 * 2048; i += 512) { const int r = i >> 11, k = i & 2047; const float v = r < 8 ? p.in[1][r * 2048 + k] : p.in[3][k]; condS[i] = v / (1.f + __expf(-v)); }
        cond_ready = true;
        __syncthreads();
      }
      const int l = task / 96, col0 = (task % 96) * 128;
      const int cp = (tid & 63) * 2, ks = tid >> 6;
      const float* W = p.in[4] + ((size_t)l * 2048 + ks * 256) * NMOD6 + col0 + cp;
      float a0[9], a1[9];
#pragma unroll
      for (int r = 0; r < 9; ++r) { a0[r] = 0.f; a1[r] = 0.f; }
      const LAS float* condL = (const LAS float*)(LAS char*)shm;
      for (int k = 0; k < 256; k += 32) {
        f32x2 w[32];
#pragma unroll
        for (int u = 0; u < 32; ++u) w[u] = *(const f32x2*)(W + (size_t)(k + u) * NMOD6);
#pragma unroll
        for (int u4 = 0; u4 < 8; ++u4) {
#pragma unroll
          for (int r = 0; r < 9; ++r) { const f32x4 cv = *(const LAS f32x4*)(condL + r * 2048 + ks * 256 + k + 4 * u4);
#pragma unroll
            for (int e = 0; e < 4; ++e) { a0[r] = fmaf(cv[e], w[4 * u4 + e].x, a0[r]); a1[r] = fmaf(cv[e], w[4 * u4 + e].y, a1[r]); } }
        }
      }
#pragma unroll
      for (int r = 0; r < 9; ++r) { red[(ks * 9 + r) * 128 + cp] = a0[r]; red[(ks * 9 + r) * 128 + cp + 1] = a1[r]; }
      __syncthreads();
      float* modv = (float*)(p.ws + OFF_MODV);
      for (int i = tid; i < 9 * 128; i += 512) { const int r = i >> 7, c = i & 127; float s = 0.f;
#pragma unroll
        for (int q = 0; q < 8; ++q) s += red[(q * 9 + r) * 128 + c];
        modv[((size_t)l * 9 + r) * NMOD6 + col0 + c] = s + p.in[5][(size_t)l * NMOD6 + col0 + c]; }
    } else if (task < N_GEMV + n_xt0) {
      xpose_tile(p, task - N_GEMV, fs, tid);
    } else if (task < N_GEMV + n_xt0 + 32) {
      const int mi = task - (N_GEMV + n_xt0); const int blk = mi >> 2, d = (mi >> 1) & 1, g = mi & 1;
      xpose_core((g ? p.in[17] : p.in[15]) + ((size_t)d * 8 + blk) * 128 * 128, 128, (bf16_t*)(p.ws + OFF_WL) + ((size_t)blk * 512 + d * 256 + g * 128) * 128, 128, 0, 0, fs, tid);
    } else if (task == N_GEMV + n_xt0 + 32) {
      u32x4* z = (u32x4*)(p.ws + OFF_WD + (size_t)1088 * 2048 * 2);
      for (int i = tid; i < 192 * 2048 * 2 / 16; i += 512) z[i] = (u32x4){0u, 0u, 0u, 0u};
    } else {
      float* rt = (float*)(p.ws + OFF_ROPE);
      for (int i = tid; i < 1024; i += 512) { const int pos = i >> 4, f = i & 15; const float ang = (float)pos * p.inv[f]; rt[2 * i] = cosf(ang); rt[2 * i + 1] = sinf(ang); }
    }
  }
}

template <int MODE, bool FIX, bool LAT_F32, bool CTX_F32>
__device__ __forceinline__ void norm_rows(const void* src_lat, const void* src_ctx, int nrows, const float* gain, const float* shift, const float* scale, void* dst,
                                          bf16_t* xfix = nullptr, const float* part = nullptr) {
  const int tid_ = otid(); const int lane = tid_ & 63, wv = tid_ >> 6;
  f32x4 g[4][2];
#pragma unroll
  for (int i = 0; i < 4; ++i) { g[i][0] = *(const f32x4*)(gain + i * 512 + lane * 8); g[i][1] = *(const f32x4*)(gain + i * 512 + lane * 8 + 4); }
  for (int row = blockIdx.x * 8 + wv; row < nrows; row += gridDim.x * 8) {
    f32x4 v[4][2];
    const bool islat = row < ML;
    const bool f32src = islat ? LAT_F32 : CTX_F32;
    const void* sp = islat ? src_lat : src_ctx;
    if (f32src) { const float* s = (const float*)sp + (size_t)row * DM + lane * 8;
#pragma unroll
      for (int i = 0; i < 4; ++i) { v[i][0] = *(const f32x4*)(s + i * 512); v[i][1] = *(const f32x4*)(s + i * 512 + 4); } }
    else { const bf16_t* s = (const bf16_t*)sp + (size_t)row * DM + lane * 8;
#pragma unroll
      for (int i = 0; i < 4; ++i) { const u32x4 w = *(const u32x4*)(s + i * 512);
        v[i][0] = (f32x4){bflo(w.x), bfhi(w.x), bflo(w.y), bfhi(w.y)}; v[i][1] = (f32x4){bflo(w.z), bfhi(w.z), bflo(w.w), bfhi(w.w)}; } }
    if constexpr (FIX) { if (!islat) {
      const float* pp = part + (size_t)(row - ML) * DM + lane * 8;
#pragma unroll
      for (int q = 0; q < 4; ++q)
#pragma unroll
        for (int i = 0; i < 4; ++i) { v[i][0] += *(const f32x4*)(pp + (size_t)q * MC * DM + i * 512); v[i][1] += *(const f32x4*)(pp + (size_t)q * MC * DM + i * 512 + 4); }
#pragma unroll
      for (int i = 0; i < 4; ++i) { u32x4 o; o.x = cvt_pk_bf16(v[i][0][0], v[i][0][1]); o.y = cvt_pk_bf16(v[i][0][2], v[i][0][3]); o.z = cvt_pk_bf16(v[i][1][0], v[i][1][1]); o.w = cvt_pk_bf16(v[i][1][2], v[i][1][3]);
        *(u32x4*)(xfix + (size_t)row * DM + i * 512 + lane * 8) = o;
        v[i][0] = (f32x4){bflo(o.x), bfhi(o.x), bflo(o.y), bfhi(o.y)}; v[i][1] = (f32x4){bflo(o.z), bfhi(o.z), bflo(o.w), bfhi(o.w)}; } } }
    float ss = 0.f;
#pragma unroll
    for (int i = 0; i < 4; ++i)
#pragma unroll
      for (int h = 0; h < 2; ++h) ss += v[i][h][0] * v[i][h][0] + v[i][h][1] * v[i][h][1] + v[i][h][2] * v[i][h][2] + v[i][h][3] * v[i][h][3];
    ss = wave_sum(ss);
    const float rstd = rsqrtf(ss * (1.f / DM) + 1e-6f);
    if constexpr (MODE == 0) {
      const int b = islat ? (row >> 11) : 8;
      const float* sh = shift + (size_t)b * NMOD6 + lane * 8; const float* sc = scale + (size_t)b * NMOD6 + lane * 8;
      bf16_t* d = (bf16_t*)dst + (size_t)row * DM + lane * 8;
#pragma unroll
      for (int i = 0; i < 4; ++i) { f32x4 y[2];
#pragma unroll
        for (int h = 0; h < 2; ++h) { const f32x4 a = *(const f32x4*)(sh + i * 512 + 4 * h), c = *(const f32x4*)(sc + i * 512 + 4 * h);
          y[h] = v[i][h] * rstd * g[i][h]; y[h] = y[h] * (c + 1.f) + a; }
        u32x4 o; o.x = cvt_pk_bf16(y[0][0], y[0][1]); o.y = cvt_pk_bf16(y[0][2], y[0][3]); o.z = cvt_pk_bf16(y[1][0], y[1][1]); o.w = cvt_pk_bf16(y[1][2], y[1][3]);
        *(u32x4*)(d + i * 512) = o; }
    } else {
      float* d = (float*)dst + (size_t)row * DM + lane * 8;
#pragma unroll
      for (int i = 0; i < 4; ++i) { *(f32x4*)(d + i * 512) = v[i][0] * rstd * g[i][0]; *(f32x4*)(d + i * 512 + 4) = v[i][1] * rstd * g[i][1]; }
    }
  }
}

__device__ __forceinline__ void mla_norm_rows(const Params& p) {
  const int tid_ = otid(); const int lane = tid_ & 63, wv = tid_ >> 6;
  const bf16_t* QA = (const bf16_t*)(p.ws + OFF_QA); bf16_t* QN = (bf16_t*)(p.ws + OFF_QN); bf16_t* CK = (bf16_t*)(p.ws + OFF_CKVN); bf16_t* KPE = (bf16_t*)(p.ws + OFF_KPE);
  const float* rope = (const float*)(p.ws + OFF_ROPE);
  float gq[8], gk[8];
#pragma unroll
  for (int i = 0; i < 8; ++i) { gq[i] = p.in[22][lane * 8 + i]; gk[i] = p.in[24][lane * 8 + i]; }
  for (int row = blockIdx.x * 8 + wv; row < MT; row += gridDim.x * 8) {
    const bf16_t* s = QA + (size_t)row * 1280;
    const u32x4 cw = *(const u32x4*)(s + 512 + lane * 8);
    float c[8] = {bflo(cw.x), bfhi(cw.x), bflo(cw.y), bfhi(cw.y), bflo(cw.z), bfhi(cw.z), bflo(cw.w), bfhi(cw.w)};
    float ssc = 0.f;
#pragma unroll
    for (int i = 0; i < 8; ++i) ssc += c[i] * c[i];
    ssc = wave_sum(ssc);
    { const float rstd = rsqrtf(ssc * (1.f / 512.f) + 1e-6f); u32x4 w;
      w.x = cvt_pk_bf16(c[0] * rstd * gk[0], c[1] * rstd * gk[1]); w.y = cvt_pk_bf16(c[2] * rstd * gk[2], c[3] * rstd * gk[3]);
      w.z = cvt_pk_bf16(c[4] * rstd * gk[4], c[5] * rstd * gk[5]); w.w = cvt_pk_bf16(c[6] * rstd * gk[6], c[7] * rstd * gk[7]);
      *(u32x4*)(CK + (size_t)row * 512 + lane * 8) = w; }
    if (row < ML) {
      const u32x4 qw = *(const u32x4*)(s + lane * 8);
      float q[8] = {bflo(qw.x), bfhi(qw.x), bflo(qw.y), bfhi(qw.y), bflo(qw.z), bfhi(qw.z), bflo(qw.w), bfhi(qw.w)};
      float ssq = 0.f;
#pragma unroll
      for (int i = 0; i < 8; ++i) ssq += q[i] * q[i];
      ssq = wave_sum(ssq);
      const float rstd = rsqrtf(ssq * (1.f / 512.f) + 1e-6f); u32x4 w;
      w.x = cvt_pk_bf16(q[0] * rstd * gq[0], q[1] * rstd * gq[1]); w.y = cvt_pk_bf16(q[2] * rstd * gq[2], q[3] * rstd * gq[3]);
      w.z = cvt_pk_bf16(q[4] * rstd * gq[4], q[5] * rstd * gq[5]); w.w = cvt_pk_bf16(q[6] * rstd * gq[6], q[7] * rstd * gq[7]);
      *(u32x4*)(QN + (size_t)row * 512 + lane * 8) = w;
    }
    {
      const int l8 = lane & 7;
      const u32x4 kw = *(const u32x4*)(s + 1024 + l8 * 8);
      float k[8] = {bflo(kw.x), bfhi(kw.x), bflo(kw.y), bfhi(kw.y), bflo(kw.z), bfhi(kw.z), bflo(kw.w), bfhi(kw.w)};
      float o[8];
      if (row < ML) {
        const int tok = row & 2047; const int ax = l8 >> 2, half = (l8 >> 1) & 1; const int pos = ax == 0 ? (tok >> 6) : (tok & 63);
        const float* cs = rope + (size_t)(pos * 16 + (l8 & 1) * 8) * 2;
#pragma unroll
        for (int i = 0; i < 8; ++i) { const float other = __shfl_xor(k[i], 2, 64); const float co = cs[2 * i], si = cs[2 * i + 1];
          o[i] = half == 0 ? (k[i] * co - other * si) : (other * si + k[i] * co); }
      } else {
#pragma unroll
        for (int i = 0; i < 8; ++i) o[i] = k[i];
      }
      if (lane < 8) { u32x4 w; w.x = cvt_pk_bf16(o[0], o[1]); w.y = cvt_pk_bf16(o[2], o[3]); w.z = cvt_pk_bf16(o[4], o[5]); w.w = cvt_pk_bf16(o[6], o[7]);
        *(u32x4*)(KPE + (size_t)row * 64 + lane * 8) = w; }
    }
  }
}

constexpr int XCP = 136;
template <int REV, int EMIT>
__device__ __forceinline__ void lru_dir(const LAS bf16_t* XC, LAS float* HF, const bf16x8 (&Wr)[4], const bf16x8 (&Wi)[4], float ba, float bx, float sp8,
                                        float& carry, float& Atot, int tid, int wv, int fr, int fq, const LAS bf16_t* GE, bf16_t* Op,
                                        unsigned* SDp, const unsigned (&sd)[8][4]) {
  const int lane = fq * 16 + fr;
#pragma unroll
  for (int mm = 0; mm < 8; ++mm) {
    const int m = REV ? 7 - mm : mm;
    float av[4], uv[4];
    if constexpr (EMIT == 0) {
      f32x4 gr = {0.f, 0.f, 0.f, 0.f}, gi = {0.f, 0.f, 0.f, 0.f};
#pragma unroll
      for (int ks = 0; ks < 4; ++ks) {
        const bf16x8 a = *(const LAS bf16x8*)(XC + (16 * m + fr) * XCP + ks * 32 + fq * 8);
        gr = __builtin_amdgcn_mfma_f32_16x16x32_bf16(a, Wr[ks], gr, 0, 0, 0);
        gi = __builtin_amdgcn_mfma_f32_16x16x32_bf16(a, Wi[ks], gi, 0, 0, 0);
      }
#pragma unroll
      for (int j = 0; j < 4; ++j) {
        const float xc = bf2f(XC[(16 * m + 4 * fq + j) * XCP + 16 * wv + fr]);
        const float r = __builtin_amdgcn_rcpf(1.f + __expf(-(gr[j] + ba))), ig = __builtin_amdgcn_rcpf(1.f + __expf(-(gi[j] + bx)));
        const float la = -sp8 * r;
        const float a = __expf(la);
        av[j] = a;
        uv[j] = __builtin_amdgcn_sqrtf(fmaxf(fmaf(-a, a, 1.f), 0.f)) * (ig * xc);
        SDp[(size_t)(16 * m + 4 * fq + j) * 1024] = cvt_pk_bf16(la, uv[j]);
      }
    } else {
#pragma unroll
      for (int j = 0; j < 4; ++j) { av[j] = __expf(bflo(sd[m][j])); uv[j] = bfhi(sd[m][j]); }
    }
    float s[4], P[4];
    if (!REV) { s[0] = uv[0]; P[0] = av[0];
#pragma unroll
      for (int j = 1; j < 4; ++j) { s[j] = fmaf(av[j], s[j - 1], uv[j]); P[j] = av[j] * P[j - 1]; } }
    else { s[3] = uv[3]; P[3] = av[3];
#pragma unroll
      for (int j = 2; j >= 0; --j) { s[j] = fmaf(av[j], s[j + 1], uv[j]); P[j] = av[j] * P[j + 1]; } }
    float A = REV ? P[0] : P[3], U = REV ? s[0] : s[3];
    { const int src = REV ? lane + 16 : lane - 16; const float Ap = __shfl(A, src & 63, 64), Up = __shfl(U, src & 63, 64);
      const bool on = REV ? (fq <= 2) : (fq >= 1); if (on) { U = fmaf(A, Up, U); A = A * Ap; } }
    { const int src = REV ? lane + 32 : lane - 32; const float Ap = __shfl(A, src & 63, 64), Up = __shfl(U, src & 63, 64);
      const bool on = REV ? (fq <= 1) : (fq >= 2); if (on) { U = fmaf(A, Up, U); A = A * Ap; } }
    float Ae, Ue;
    { const int src = REV ? lane + 16 : lane - 16; Ae = __shfl(A, src & 63, 64); Ue = __shfl(U, src & 63, 64);
      const bool first = REV ? (fq == 3) : (fq == 0); if (first) { Ae = 1.f; Ue = 0.f; } }
    const float cr = fmaf(Ae, carry, Ue);
    if (EMIT == 1) {
#pragma unroll
      for (int j = 0; j < 4; ++j) HF[(m * 4 + j) * 512 + tid] = fmaf(P[j], cr, s[j]);
    }
    if (EMIT == 2) {
#pragma unroll
      for (int j = 0; j < 4; ++j) { const float hsum = HF[(m * 4 + j) * 512 + tid] + fmaf(P[j], cr, s[j]);
        const int tl = 16 * m + 4 * fq + j;
        const float ge = bf2f(GE[tl * XCP + 16 * wv + fr]);
        Op[(size_t)tl * DM] = (bf16_t)(cvt_pk_bf16(hsum * ge, 0.f) & 0xffffu); }
    }
    const int lastl = REV ? fr : 48 + fr;
    const float At = __shfl(A, lastl, 64), Ut = __shfl(U, lastl, 64);
    carry = fmaf(At, carry, Ut); Atot *= At;
  }
}

template <int PASS>
__device__ __forceinline__ void lru_task(const Params& p, int task, char* shm) {
  const int tid = otid(), lane = tid & 63, wv = tid >> 6, fr = lane & 15, fq = lane >> 4;
  const int ci = task % 18, blk = (task / 18) & 7, b = task / 144;
  const bf16_t* P = (const bf16_t*)(p.ws + OFF_P);
  LAS bf16_t* XC = (LAS bf16_t*)shm;
  LAS float* HF = (LAS float*)(shm + 128 * XCP * 2);
  LAS bf16_t* GE = (LAS bf16_t*)(shm + 128 * XCP * 2 + 32 * 512 * 4);
  const int L = ci < 2 ? 256 : 2048, tl0 = ci < 2 ? ci * 128 : (ci - 2) * 128;
  const size_t rowbase = ci < 2 ? (size_t)ML + b * 256 : (size_t)b * 2048;
  const int ch = blk * 128 + 16 * wv + fr;
  unsigned* SD0 = (unsigned*)(p.ws + OFF_X) + (rowbase + tl0) * 1024 + ch;
  unsigned* SD1 = SD0 + (size_t)MT * 1024;
  float* LS = (float*)(p.ws + OFF_LSUM) + (size_t)((b * 8 + blk) * 18) * 2 * 128 * 2;
  bf16_t* Op = (bf16_t*)(p.ws + OFF_MIX) + (rowbase + tl0) * DM + 1024 + ch;
  __syncthreads();
  if constexpr (PASS == 1) {
    {
      const int cg = tid & 15; const int ch0 = blk * 128 + cg * 8;
      float cw[4][8], cb[8];
#pragma unroll
      for (int e = 0; e < 8; ++e) { cb[e] = p.in[14][ch0 + e];
#pragma unroll
        for (int tp = 0; tp < 4; ++tp) cw[tp][e] = p.in[13][tp * 1024 + ch0 + e]; }
      u32x4 wld[4][4];
#pragma unroll
      for (int it = 0; it < 4; ++it)
#pragma unroll
        for (int tp = 0; tp < 4; ++tp) { const int tl = tl0 + (tid >> 4) + 32 * it + tp - 2; const int tlc = min(max(tl, 0), L - 1);
          wld[it][tp] = *(const u32x4*)(P + (rowbase + tlc) * ABIN + 3072 + ch0); }
#pragma unroll
      for (int it = 0; it < 4; ++it) { const int t = (tid >> 4) + 32 * it; float acc[8];
#pragma unroll
        for (int e = 0; e < 8; ++e) acc[e] = cb[e];
#pragma unroll
        for (int tp = 0; tp < 4; ++tp) { const int tl = tl0 + t + tp - 2; const bool ok = (tl >= 0 && tl < L);
          const u32x4 w = wld[it][tp];
          const float x[8] = {bflo(w.x), bfhi(w.x), bflo(w.y), bfhi(w.y), bflo(w.z), bfhi(w.z), bflo(w.w), bfhi(w.w)};
#pragma unroll
          for (int e = 0; e < 8; ++e) acc[e] = fmaf(cw[tp][e], ok ? x[e] : 0.f, acc[e]); }
        u32x4 o; o.x = cvt_pk_bf16(acc[0], acc[1]); o.y = cvt_pk_bf16(acc[2], acc[3]); o.z = cvt_pk_bf16(acc[4], acc[5]); o.w = cvt_pk_bf16(acc[6], acc[7]);
        *(LAS u32x4*)(XC + t * XCP + cg * 8) = o; }
    }
    __syncthreads();
    const bf16_t* WL = (const bf16_t*)(p.ws + OFF_WL) + (size_t)blk * 512 * 128;
    const unsigned nosd[8][4] = {};
#pragma unroll
    for (int d = 0; d < 2; ++d) {
      bf16x8 Wr[4], Wi[4];
#pragma unroll
      for (int ks = 0; ks < 4; ++ks) { Wr[ks] = *(const bf16x8*)(WL + (size_t)(256 * d + 16 * wv + fr) * 128 + ks * 32 + fq * 8); Wi[ks] = *(const bf16x8*)(WL + (size_t)(256 * d + 128 + 16 * wv + fr) * 128 + ks * 32 + fq * 8); }
      const float ba = p.in[16][1024 * d + ch], bx = p.in[18][1024 * d + ch]; const float lam = p.in[19][1024 * d + ch];
      const float sp8 = 8.f * (fmaxf(-lam, 0.f) + log1pf(__expf(-fabsf(lam))));
      float carry = 0.f, Atot = 1.f;
      if (d == 0) lru_dir<0, 0>(XC, HF, Wr, Wi, ba, bx, sp8, carry, Atot, tid, wv, fr, fq, GE, Op, SD0, nosd);
      else        lru_dir<1, 0>(XC, HF, Wr, Wi, ba, bx, sp8, carry, Atot, tid, wv, fr, fq, GE, Op, SD1, nosd);
      if (fq == 0) *(f32x2*)(LS + ((size_t)(ci * 2 + d) * 128 + 16 * wv + fr) * 2) = (f32x2){Atot, carry};
    }
  } else {
    unsigned sdf[8][4], sdr[8][4];
#pragma unroll
    for (int m = 0; m < 8; ++m)
#pragma unroll
      for (int j = 0; j < 4; ++j) { sdf[m][j] = SD0[(size_t)(16 * m + 4 * fq + j) * 1024]; sdr[m][j] = SD1[(size_t)(16 * m + 4 * fq + j) * 1024]; }
    {
      const int cg = tid & 15; const int ch0 = blk * 128 + cg * 8;
      u32x4 gl[4];
#pragma unroll
      for (int it = 0; it < 4; ++it) gl[it] = *(const u32x4*)(P + (rowbase + tl0 + (tid >> 4) + 32 * it) * ABIN + 4096 + ch0);
#pragma unroll
      for (int it = 0; it < 4; ++it) { const u32x4 w = gl[it];
        float x[8] = {bflo(w.x), bfhi(w.x), bflo(w.y), bfhi(w.y), bflo(w.z), bfhi(w.z), bflo(w.w), bfhi(w.w)};
#pragma unroll
        for (int e = 0; e < 8; ++e) { const float g = x[e]; const float z = 0.7978845608028654f * (g + 0.044715f * g * g * g); x[e] = g * __builtin_amdgcn_rcpf(1.f + __expf(-2.f * z)); }
        u32x4 o; o.x = cvt_pk_bf16(x[0], x[1]); o.y = cvt_pk_bf16(x[2], x[3]); o.z = cvt_pk_bf16(x[4], x[5]); o.w = cvt_pk_bf16(x[6], x[7]);
        *(LAS u32x4*)(GE + ((tid >> 4) + 32 * it) * XCP + cg * 8) = o; }
    }
    float carryF = 0.f, carryR = 0.f;
    { f32x2 su[17];
#pragma unroll
      for (int c2 = 0; c2 < 17; ++c2) su[c2] = (c2 < ci) ? *(const f32x2*)(LS + ((size_t)(c2 * 2 + 0) * 128 + 16 * wv + fr) * 2) : (f32x2){1.f, 0.f};
#pragma unroll
      for (int c2 = 0; c2 < 17; ++c2) carryF = fmaf(su[c2].x, carryF, su[c2].y); }
    { const int pos = ci < 2 ? (1 - ci) : (19 - ci);
      f32x2 su[17];
#pragma unroll
      for (int q = 0; q < 17; ++q) { const int c2 = q < 2 ? 1 - q : 19 - q; su[q] = (q < pos) ? *(const f32x2*)(LS + ((size_t)(c2 * 2 + 1) * 128 + 16 * wv + fr) * 2) : (f32x2){1.f, 0.f}; }
#pragma unroll
      for (int q = 0; q < 17; ++q) carryR = fmaf(su[q].x, carryR, su[q].y); }
    __syncthreads();
    const bf16x8 nw[4] = {};
    float At0 = 1.f, At1 = 1.f;
    lru_dir<0, 1>(XC, HF, nw, nw, 0.f, 0.f, 0.f, carryF, At0, tid, wv, fr, fq, GE, Op, SD0, sdf);
    lru_dir<1, 2>(XC, HF, nw, nw, 0.f, 0.f, 0.f, carryR, At1, tid, wv, fr, fq, GE, Op, SD1, sdr);
  }
}

__device__ __forceinline__ void na_task(const Params& p, int task, char* shm) {
  const int qb = task & 7, h = (task >> 3) & 7, b = task >> 6;
  const bf16_t* P = (const bf16_t*)(p.ws + OFF_P); bf16_t* MIX = (bf16_t*)(p.ws + OFF_MIX);
  __syncthreads();
  { float* tb = (float*)(shm + 2 * att::SHM_V + 2 * (64 * 128 * 2) + att::NW * 256) + 64;
    for (int i = otid(); i < 15 * 31; i += 512) tb[i] = p.in[12][h * 465 + i] * 11.313708498984761f; }
  att::Job J;
  J.Qb = P + (size_t)(b * 2048 + qb * 256) * ABIN + h * 128; J.ldq = ABIN;
  J.Kb = P + 1024 + h * 128; J.Vb = P + 2048 + h * 128; J.ldk = ABIN; J.Pe = nullptr;
  J.Ob = MIX + (size_t)(b * 2048 + qb * 256) * DM + h * 128; J.ldo = DM;
  const int r0 = qb * 4; const int lo = min(max(r0 - 4, 0), 24), hiw = min(max(r0 - 1, 0), 24) + 7;
  J.lo = lo; J.nwin = hiw - lo + 1; J.qb4 = r0;
  J.nA = 4; J.rowA = ML + b * 256; J.rowB = b * 2048 + lo * 64;
  J.NT = (4 + J.nwin + 1) & ~1;
  J.rope = nullptr; J.tok0 = 0;
  __syncthreads();
  att::attn_body<0>(J, shm);
}
__device__ __forceinline__ void ctxattn_task(const Params& p, int task, char* shm) {
  const int h = task & 7, b = task >> 3;
  const bf16_t* P = (const bf16_t*)(p.ws + OFF_P); bf16_t* MIX = (bf16_t*)(p.ws + OFF_MIX);
  __syncthreads();
  att::Job J;
  J.Qb = P + (size_t)(ML + b * 256) * ABIN + h * 128; J.ldq = ABIN;
  J.Kb = P + 1024 + h * 128; J.Vb = P + 2048 + h * 128; J.ldk = ABIN; J.Pe = nullptr;
  J.Ob = MIX + (size_t)(ML + b * 256) * DM + h * 128; J.ldo = DM;
  J.NT = 4; J.nA = 4; J.rowA = ML + b * 256; J.rowB = 0; J.qb4 = 0; J.lo = 0; J.nwin = 0; J.rope = nullptr; J.tok0 = 0;
  att::attn_body<1>(J, shm);
}
__device__ __forceinline__ void mla_task(const Params& p, int task, char* shm) {
  const int qb = task & 7, h = (task >> 3) & 15, b = task >> 7;
  const bf16_t* Q = (const bf16_t*)(p.ws + OFF_Q); const bf16_t* KV = (const bf16_t*)(p.ws + OFF_KV); bf16_t* ATT = (bf16_t*)(p.ws + OFF_H);
  __syncthreads();
  att::Job J;
  J.Qb = Q + (size_t)(b * 2048 + qb * 256) * 3072 + h * 192; J.ldq = 3072;
  J.Kb = KV + h * 256; J.Vb = KV + h * 256 + 128; J.ldk = 4096; J.Pe = (const bf16_t*)(p.ws + OFF_KPE);
  J.Ob = ATT + (size_t)(b * 2048 + qb * 256) * DM + h * 128; J.ldo = DM;
  J.NT = 36; J.nA = 32; J.rowA = b * 2048; J.rowB = ML + b * 256; J.qb4 = 0; J.lo = 0; J.nwin = 0;
  J.rope = (const float*)(p.ws + OFF_ROPE); J.tok0 = qb * 256;
  att::attn_body<2>(J, shm);
}

#define XB_TMO      128
#define XB_XCNT(j)  (256  + 64 * (j))
#define XB_XSUB(j)  (1280 + 64 * (j))
#define XB_XGEN(j)  (2304 + 64 * (j))
#define XB_TOP      3328
#define XB_TOPGEN   3392
#define XCD_BAR_WORDS 3456
#define XB_SPIN_CAP (1u << 18)
__device__ __forceinline__ unsigned xb_ld(unsigned* p)              { return __hip_atomic_load(p, __ATOMIC_RELAXED, __HIP_MEMORY_SCOPE_AGENT); }
__device__ __forceinline__ unsigned xb_add(unsigned* p, unsigned v) { return __hip_atomic_fetch_add(p, v, __ATOMIC_RELAXED, __HIP_MEMORY_SCOPE_AGENT); }
__device__ __forceinline__ unsigned xb_xcc_id() { return (unsigned)__builtin_amdgcn_s_getreg((3 << 11) | 20) & 0xFu; }
#define XB_SPIN(cond, bar) do { unsigned _sp = 0; while (cond) { __builtin_amdgcn_s_sleep(1); \
    if ((++_sp & 255u) == 0u) { if (xb_ld(&(bar)[XB_TMO])) break; if (_sp > XB_SPIN_CAP) { atomicAdd(&(bar)[XB_TMO], 1u); break; } } } } while (0)
struct XcdBarrier { unsigned* bar; unsigned x; volatile LAS unsigned* st; };
__device__ __forceinline__ XcdBarrier xcd_barrier_post(unsigned* bar, volatile LAS unsigned* st) {
  XcdBarrier b; b.bar = bar; b.x = xb_xcc_id(); b.st = st;
  if (threadIdx.x == 0) (void)xb_add(&bar[XB_XCNT(b.x)], 1u);
  return b;
}
__device__ __forceinline__ void xcd_barrier_complete(unsigned* bar, unsigned x, unsigned& nloc, unsigned& nx) {
  const unsigned G = gridDim.x * gridDim.y * gridDim.z;
  unsigned sum, cnt, mine, sp = 0u;
  for (;;) {
    sum = 0u; cnt = 0u; mine = 0u;
#pragma unroll
    for (unsigned j = 0; j < 16; ++j) { const unsigned c = xb_ld(&bar[XB_XCNT(j)]); sum += c; cnt += (c > 0u) ? 1u : 0u; mine = (j == x) ? c : mine; }
    if (sum == G) break;
    __builtin_amdgcn_s_sleep(1);
    if ((++sp & 255u) == 0u) { if (xb_ld(&bar[XB_TMO])) break; if (sp > XB_SPIN_CAP) { atomicAdd(&bar[XB_TMO], 1u); break; } }
  }
  nloc = mine > 0u ? mine : 1u; nx = cnt > 0u ? cnt : 1u;
}
__device__ __forceinline__ void xcd_barrier(const XcdBarrier& b) {
  asm volatile("s_waitcnt vmcnt(0)" ::: "memory");
  __syncthreads();
  if (threadIdx.x == 0) {
    unsigned* bar = b.bar;
    __builtin_amdgcn_s_waitcnt(0);
    unsigned nloc = b.st[0], nx = b.st[1];
    if (nloc == 0u) { xcd_barrier_complete(bar, b.x, nloc, nx); b.st[0] = nloc; b.st[1] = nx; }
    const unsigned old = xb_add(&bar[XB_XSUB(b.x)], 1u);
    const unsigned gen = old / nloc;
    if (old + 1u == (gen + 1u) * nloc) {
      __builtin_amdgcn_fence(__ATOMIC_RELEASE, "agent");
      asm volatile("s_waitcnt vmcnt(0)" ::: "memory");
      const unsigned og = xb_add(&bar[XB_TOP], 1u);
      const unsigned tg = og / nx;
      if (og + 1u == (tg + 1u) * nx) xb_add(&bar[XB_TOPGEN], 1u);
      else XB_SPIN(xb_ld(&bar[XB_TOPGEN]) == tg, bar);
      __builtin_amdgcn_fence(__ATOMIC_ACQUIRE, "agent");
      xb_add(&bar[XB_XGEN(b.x)], 1u);
      asm volatile("s_waitcnt vmcnt(0)" ::: "memory");
    } else {
      XB_SPIN(xb_ld(&bar[XB_XGEN(b.x)]) == gen, bar);
      __builtin_amdgcn_fence(__ATOMIC_ACQUIRE, "agent");
      asm volatile("s_waitcnt vmcnt(0)" ::: "memory");
    }
  }
  __syncthreads();
}

template <class Epi>
__device__ __forceinline__ void run_gemm(char* shm, const bf16_t* A, int lda, const bf16_t* Bt, int ldb, int K, int nM, int nN, const Epi& E) {
  pg8::Gemm g; g.A = A; g.Bt = Bt; g.lda = lda; g.ldb = ldb; g.K = K; g.nM = nM; g.nN = nN;
  pg8::StaticOrder S; S.init(nM, nN, gridDim.x, blockIdx.x);
  __syncthreads();
  pg8::gemm_phase<Epi, pg8::StaticOrder>((LAS unsigned char*)shm, g, S, E);
}
template <class Epi>
__device__ __forceinline__ void run_gemm_split(char* shm, const bf16_t* A, int lda, const bf16_t* Bt, int ldb, int K, int pm0, int nMs, int nN, int NS, const Epi& E) {
  pg8::Gemm g; g.A = A; g.Bt = Bt; g.lda = lda; g.ldb = ldb; g.K = K / NS; g.nM = nMs; g.nN = nN;
  pg8::SplitOrder S; S.init(pm0, nMs, nN, NS, K / NS, gridDim.x, blockIdx.x);
  __syncthreads();
  pg8::gemm_phase<Epi, pg8::SplitOrder>((LAS unsigned char*)shm, g, S, E);
}

#ifndef NO_MEGA
__global__ void __launch_bounds__(512, 2) fwd_megakernel(Params p) {
  extern __shared__ __attribute__((aligned(16))) char shm[];
  cg::grid_group grid = cg::this_grid();
  char* ws = p.ws;
  const float* modv = (const float*)(ws + OFF_MODV);
  bf16_t* X = (bf16_t*)(ws + OFF_X);
  bf16_t* H = (bf16_t*)(ws + OFF_H);

  volatile LAS unsigned* xst = (volatile LAS unsigned*)((LAS char*)shm + (LDS_BYTES - 16));
  if (threadIdx.x == 0) { xst[0] = 0u; xst[1] = 0u; }
  __syncthreads();
  const XcdBarrier xbar = xcd_barrier_post((unsigned*)(ws + OFF_BAR), xst);
  phase0(p, shm);
  grid.sync();
  norm_rows<0, false, true, true>(p.in[0], p.in[2] - (size_t)ML * DM, MT, p.in[6], modv + 0 * DM, modv + 1 * DM, H);
  xcd_barrier(xbar);
  { pg8::EpiBf16<0> E; E.O = (bf16_t*)(ws + OFF_P); E.ldc = ABIN;
    run_gemm(shm, H, DM, (const bf16_t*)(ws + OFF_WIN), DM, DM, MT / 256, ABIN / 256, E); }
  if (gridDim.x == 256) xpose_deferred(p, shm, N_EARLY, N_SLOTA_END, 160);
  xcd_barrier(xbar);
  { const int nxb = (gridDim.x == 256) ? (N_SLOTB_END - N_SLOTA_END) : 0;
    const int tid0 = otid();
    for (int t = blockIdx.x; t < 512 + 64 + 1152 + nxb; t += gridDim.x) {
      if (t < 512) na_task(p, t, shm);
      else if (t < 576) ctxattn_task(p, t - 512, shm);
      else if (t < 1728) lru_task<1>(p, t - 576, shm);
      else { __syncthreads(); xpose_tile(p, N_SLOTA_END + (t - 1728), (float*)shm, tid0); }
    } }
  xcd_barrier(xbar);
  for (int t = blockIdx.x; t < 1152; t += gridDim.x) lru_task<2>(p, t, shm);
  xcd_barrier(xbar);
  { pg8::EpiResid<true> E; E.xin = p.in[0]; E.xout = X; E.gate = modv + 2 * DM;
    run_gemm(shm, (const bf16_t*)(ws + OFF_MIX), DM, (const bf16_t*)(ws + OFF_WOUT), DM, DM, ML / 256, DM / 256, E); }
  { pg8::EpiPartial E; E.part = (float*)(ws + OFF_PART); E.gate = modv + 2 * DM; E.kp2 = (DM / 4) * 2;
    run_gemm_split(shm, (const bf16_t*)(ws + OFF_MIX), DM, (const bf16_t*)(ws + OFF_WOUT), DM, DM, ML / 256, MC / 256, DM / 256, 4, E); }
  xcd_barrier(xbar);
  norm_rows<0, true, false, true>(X, p.in[2] - (size_t)ML * DM, MT, p.in[7], modv + 3 * DM, modv + 4 * DM, H, X, (const float*)(ws + OFF_PART));
  xcd_barrier(xbar);
  { pg8::EpiBf16<1> E; E.O = (bf16_t*)(ws + OFF_HID); E.ldc = DFF;
    run_gemm(shm, H, DM, (const bf16_t*)(ws + OFF_W1), DM, DM, MT / 256, DFF / 256, E); }
  xcd_barrier(xbar);
  { pg8::EpiResid<false> E; E.xin = X; E.xout = X; E.gate = modv + 5 * DM;
    run_gemm(shm, (const bf16_t*)(ws + OFF_HID), DFF, (const bf16_t*)(ws + OFF_W2), DFF, DFF, ML / 256, DM / 256, E); }
  { pg8::EpiPartial E; E.part = (float*)(ws + OFF_PART); E.gate = modv + 5 * DM; E.kp2 = (DFF / 4) * 2;
    run_gemm_split(shm, (const bf16_t*)(ws + OFF_HID), DFF, (const bf16_t*)(ws + OFF_W2), DFF, DFF, ML / 256, MC / 256, DM / 256, 4, E); }
  xcd_barrier(xbar);
  const float* modv1 = modv + (size_t)9 * NMOD6;
  norm_rows<0, true, false, false>(X, X, MT, p.in[6] + DM, modv1 + 0 * DM, modv1 + 1 * DM, H, X, (const float*)(ws + OFF_PART));
  xcd_barrier(xbar);
  { pg8::EpiBf16<0> E; E.O = (bf16_t*)(ws + OFF_QA); E.ldc = 1280;
    run_gemm(shm, H, DM, (const bf16_t*)(ws + OFF_WD), DM, DM, MT / 256, 1280 / 256, E); }
  if (gridDim.x == 256) xpose_deferred(p, shm, N_SLOTB_END, N_XT, 104);
  xcd_barrier(xbar);
  mla_norm_rows(p);
  xcd_barrier(xbar);
  { pg8::EpiBf16<0> E; E.O = (bf16_t*)(ws + OFF_Q); E.ldc = 3072;
    run_gemm(shm, (const bf16_t*)(ws + OFF_QN), 512, (const bf16_t*)(ws + OFF_WUQ), 512, 512, ML / 256, 3072 / 256, E); }
  { pg8::EpiBf16<0> E; E.O = (bf16_t*)(ws + OFF_KV); E.ldc = 4096;
    run_gemm(shm, (const bf16_t*)(ws + OFF_CKVN), 512, (const bf16_t*)(ws + OFF_WUKV), 512, 512, MT / 256, 4096 / 256, E); }
  xcd_barrier(xbar);
  for (int t = blockIdx.x; t < 1024; t += gridDim.x) mla_task(p, t, shm);
  xcd_barrier(xbar);
  { pg8::EpiResid<false> E; E.xin = X; E.xout = X; E.gate = modv1 + 2 * DM;
    run_gemm(shm, H, DM, (const bf16_t*)(ws + OFF_WO), DM, DM, ML / 256, DM / 256, E); }
  xcd_barrier(xbar);
  norm_rows<0, false, false, false>(X, X, ML, p.in[7] + DM, modv1 + 3 * DM, modv1 + 4 * DM, H);
  xcd_barrier(xbar);
  { pg8::EpiBf16<1> E; E.O = (bf16_t*)(ws + OFF_HID); E.ldc = DFF;
    run_gemm(shm, H, DM, (const bf16_t*)(ws + OFF_W1 + (size_t)8192 * 2048 * 2), DM, DM, ML / 256, DFF / 256, E); }
  xcd_barrier(xbar);
  { pg8::EpiResid<false> E; E.xin = X; E.xout = X; E.gate = modv1 + 5 * DM;
    run_gemm(shm, (const bf16_t*)(ws + OFF_HID), DFF, (const bf16_t*)(ws + OFF_W2 + (size_t)2048 * 8192 * 2), DFF, DFF, ML / 256, DM / 256, E); }
  xcd_barrier(xbar);
  norm_rows<1, false, false, false>(X, X, ML, p.in[27], nullptr, nullptr, p.out);
}

extern "C" void kernel_launch(void* const* d_in, const int* in_sizes, int n_in, void* d_out, int out_size, void* d_ws, size_t ws_size, hipStream_t stream) {
  static int grid_blocks = 0;
  if (!grid_blocks) {
    if (n_in != 28 || ws_size < WS_NEED || out_size != ML * DM) { fprintf(stderr, "kernel_launch: unexpected shapes (n_in %d, ws %zu need %zu, out %d)\n", n_in, ws_size, (size_t)WS_NEED, out_size); return; }
    if (hipFuncSetAttribute((const void*)fwd_megakernel, hipFuncAttributeMaxDynamicSharedMemorySize, LDS_BYTES) != hipSuccess) { fprintf(stderr, "kernel_launch: LDS attribute failed\n"); return; }
    int dev = 0, cus = 0, per_cu = 0;
    hipGetDevice(&dev);
    hipDeviceGetAttribute(&cus, hipDeviceAttributeMultiprocessorCount, dev);
    hipOccupancyMaxActiveBlocksPerMultiprocessor(&per_cu, fwd_megakernel, 512, LDS_BYTES);
    if (per_cu < 1) { fprintf(stderr, "kernel_launch: occupancy query gave %d\n", per_cu); return; }
    grid_blocks = cus;
  }
  Params p{};
  for (int i = 0; i < 28; ++i) p.in[i] = (const float*)d_in[i];
  p.out = (float*)d_out; p.ws = (char*)d_ws;
  for (int i = 0; i < 16; ++i) p.inv[i] = (float)pow(10000.0, -(double)i / 16.0);
  hipMemsetAsync((char*)d_ws + OFF_BAR, 0, 16384, stream);
  void* args[] = {&p};
  hipError_t e = hipLaunchCooperativeKernel((void*)fwd_megakernel, dim3(grid_blocks), dim3(512), args, LDS_BYTES, stream);
  if (e != hipSuccess) fprintf(stderr, "cooperative launch failed: %s (grid %d)\n", hipGetErrorString(e), grid_blocks);
}
#endif
```

```cpp
#include <hip/hip_runtime.h>
#include <hip/hip_cooperative_groups.h>
#include <cstdio>
#include <cmath>
#include <cstdint>
namespace cg = cooperative_groups;

#define LAS __attribute__((address_space(3)))
typedef unsigned short bf16_t;
typedef short bf16x8 __attribute__((ext_vector_type(8)));
typedef short s16x4 __attribute__((ext_vector_type(4)));
typedef float f32x4 __attribute__((ext_vector_type(4)));
typedef float f32x2 __attribute__((ext_vector_type(2)));
typedef float f32x16 __attribute__((ext_vector_type(16)));
typedef unsigned u32x4 __attribute__((ext_vector_type(4)));
typedef unsigned u32x2 __attribute__((ext_vector_type(2)));

constexpr int DM = 2048, NBATCH = 8, SEQ = 2048, CTXL = 256, ML = NBATCH * SEQ, MC = NBATCH * CTXL, MT = ML + MC;
constexpr int DFF = 8192, ABIN = 5120, NMOD6 = 6 * DM;
constexpr int LDS_BYTES = 155648;

constexpr size_t OFF_WIN  = 0;
constexpr size_t OFF_WOUT = OFF_WIN  + (size_t)5120 * 2048 * 2;
constexpr size_t OFF_W1   = OFF_WOUT + (size_t)2048 * 2048 * 2;
constexpr size_t OFF_W2   = OFF_W1   + (size_t)2 * 8192 * 2048 * 2;
constexpr size_t OFF_WD   = OFF_W2   + (size_t)2 * 2048 * 8192 * 2;
constexpr size_t OFF_WUQ  = OFF_WD   + (size_t)1280 * 2048 * 2;
constexpr size_t OFF_WUKV = OFF_WUQ  + (size_t)3072 * 512 * 2;
constexpr size_t OFF_WO   = OFF_WUKV + (size_t)4096 * 512 * 2;
constexpr size_t OFF_WL   = OFF_WO   + (size_t)2048 * 2048 * 2;
constexpr size_t OFF_MODV = OFF_WL   + (size_t)8 * 512 * 128 * 2;
constexpr size_t OFF_ROPE = OFF_MODV + (size_t)2 * 9 * NMOD6 * 4;
constexpr size_t OFF_LSUM = OFF_ROPE + (size_t)64 * 16 * 2 * 4;
constexpr size_t OFF_X    = OFF_LSUM + (size_t)8 * 8 * 18 * 2 * 128 * 2 * 4;
constexpr size_t OFF_H    = OFF_X    + (size_t)MT * DM * 4;
constexpr size_t OFF_R    = OFF_H    + (size_t)MT * DM * 2;
constexpr size_t OFF_P    = OFF_R;
constexpr size_t OFF_MIX  = OFF_R + (size_t)MT * ABIN * 2;
constexpr size_t OFF_QA   = OFF_R;
constexpr size_t OFF_QN   = OFF_QA   + (size_t)MT * 1280 * 2;
constexpr size_t OFF_CKVN = OFF_QN   + (size_t)ML * 512 * 2;
constexpr size_t OFF_KPE  = OFF_CKVN + (size_t)MT * 512 * 2;
constexpr size_t OFF_Q    = OFF_KPE  + (size_t)MT * 64 * 2;
constexpr size_t OFF_KV   = OFF_Q    + (size_t)ML * 3072 * 2;
constexpr size_t WS_END   = OFF_KV   + (size_t)MT * 4096 * 2;
constexpr size_t OFF_HID  = OFF_R;
constexpr size_t OFF_PART = OFF_R + (size_t)MT * DFF * 2;
constexpr size_t OFF_BAR  = OFF_PART + (size_t)4 * MC * DM * 4;
constexpr size_t WS_NEED  = OFF_BAR + 16384;

struct Params {
  const float* in[28];
  float* out;
  char* ws;
  float inv[16];
};

__device__ __forceinline__ unsigned cvt_pk_bf16(float lo, float hi) { unsigned r; asm volatile("v_cvt_pk_bf16_f32 %0, %1, %2" : "=v"(r) : "v"(lo), "v"(hi)); return r; }
__device__ __forceinline__ float bf2f(bf16_t b) { return __uint_as_float(((unsigned)b) << 16); }
__device__ __forceinline__ float bflo(unsigned w) { return __uint_as_float(w << 16); }
__device__ __forceinline__ float bfhi(unsigned w) { return __uint_as_float(w & 0xffff0000u); }
__device__ __forceinline__ float wave_sum(float v) {
#pragma unroll
  for (int o = 32; o >= 1; o >>= 1) v += __shfl_xor(v, o, 64);
  return v;
}
__device__ __forceinline__ int otid() { int t = threadIdx.x; asm volatile("" : "+v"(t)); return t; }
__device__ __forceinline__ float sigmoidf_(float x) { return 1.f / (1.f + __expf(-x)); }

namespace pg8 {
constexpr int BM = 256, BK = 64, HALF = 128, HTB = HALF * BK * 2, NXCD = 8, WGM = 8;
__device__ __forceinline__ int lds_byte(int r, int c) { const int st = (r >> 4) * 2 + (c >> 5), rr = r & 15, cc = c & 31, ob = rr * 64 + cc * 2; return st * 1024 + (ob ^ (((ob >> 9) & 1) << 5)); }
__device__ __forceinline__ void stage_rc(int b, int& R, int& C) { const int st = b / 1024, sb = b % 1024, swz = sb ^ (((sb >> 9) & 1) << 5); R = (st >> 1) * 16 + swz / 64; C = (st & 1) * 32 + (swz % 64) / 2; }
__device__ __forceinline__ int perm32(int rho) { const int n = rho >> 4, i = rho & 15; return 8 * (i >> 2) + 4 * n + (i & 3); }
struct Unit { int pm, pn, kb; };
struct Gemm { const bf16_t* A; const bf16_t* Bt; int lda, ldb, K, nM, nN; int krev = 0; };
struct StaticOrder {
  int nM, nN, nwg, G, c;
  __device__ void init(int nM_, int nN_, int G_, int c_) { nM = nM_; nN = nN_; nwg = nM * nN; G = G_; c = c_; }
  __device__ bool next(int i, Unit& u) const {
    const long L = (long)i * G + c; if (L >= nwg) return false;
    int wgid = (int)L; { const int q = nwg / NXCD, r = nwg % NXCD, xcd = wgid % NXCD, off = wgid / NXCD; wgid = (xcd < r ? xcd * (q + 1) : r * (q + 1) + (xcd - r) * q) + off; }
    const int nig = WGM * nN, gid = wgid / nig, fm = gid * WGM, gsz = (nM - fm) < WGM ? (nM - fm) : WGM;
    u.pm = fm + ((wgid % nig) % gsz); u.pn = (wgid % nig) / gsz; u.kb = 0; return true;
  }
};
struct SplitOrder {
  int pm0, nMs, nN, NS, Kp, nwg, G, c;
  __device__ void init(int pm0_, int nMs_, int nN_, int NS_, int Kp_, int G_, int c_) { pm0 = pm0_; nMs = nMs_; nN = nN_; NS = NS_; Kp = Kp_; nwg = nMs * nN * NS; G = G_; c = c_; }
  __device__ bool next(int i, Unit& u) const {
    const long L = (long)i * G + c; if (L >= nwg) return false;
    const int l = (int)L; const int part = l % NS, tile = l / NS;
    u.pm = pm0 + tile % nMs; u.pn = tile / nMs; u.kb = part * Kp * 2; return true;
  }
};

template <class Epi, class Sched, bool ALIGN_EPI = true>
__device__ __forceinline__ void gemm_phase(LAS unsigned char* lds, const Gemm g, const Sched& S, const Epi& E) {
  const int tid = otid(), wid = __builtin_amdgcn_readfirstlane(tid >> 6), lane = tid & 63, wr = wid >> 2, wc = wid & 3, fr = lane & 15, fq = lane >> 4;
  const int K = g.K, nt = K / BK;
  unsigned voffA[2], voffB[2];
#pragma unroll
  for (int i = 0; i < 2; ++i) { int R, C; stage_rc(tid * 16 + i * 8192, R, C); const int Rb = Epi::PERM ? ((R & ~31) + perm32(R & 31)) : R;
    voffA[i] = (unsigned)(R * g.lda + C) * 2u; voffB[i] = (unsigned)(Rb * g.ldb + C) * 2u; }
  const ptrdiff_t kstep = g.krev ? -(ptrdiff_t)(BK * 2) : (ptrdiff_t)(BK * 2);
  const size_t koff0 = g.krev ? (size_t)(nt - 1) * (BK * 2) : 0;
  const size_t hstepA = (size_t)HALF * g.lda * 2, hstepB = (size_t)HALF * g.ldb * 2;
  const size_t tstepA = 2 * hstepA, tstepB = 2 * hstepB;
  const unsigned ldsw = (unsigned)wid * 1024u;
  const int aoff = lds_byte(wr * 64 + fr, fq * 8), boff = lds_byte(wc * 32 + fr, fq * 8);
#define PG8_SA(b, h) (((b) * 2 + (h)) * HTB)
#define PG8_SB(b, h) ((4 + (b) * 2 + (h)) * HTB)
#define PG8_STAGE(bufoff, gbase, voff) do { _Pragma("unroll") for (int _i = 0; _i < 2; ++_i) \
    __builtin_amdgcn_global_load_lds((const unsigned*)((const char*)(gbase) + (voff)[_i]), (LAS unsigned*)(lds + (bufoff) + ldsw + _i * 8192), 16, 0, 0); } while (0)
#define PG8_LDA(dst, b, h) do { _Pragma("unroll") for (int m = 0; m < 4; ++m) _Pragma("unroll") for (int k = 0; k < 2; ++k) dst[m][k] = *(const LAS bf16x8*)(lds + PG8_SA(b, h) + aoff + m * 2048 + k * 1024); } while (0)
#define PG8_LDB(dst, b, h) do { _Pragma("unroll") for (int n = 0; n < 2; ++n) _Pragma("unroll") for (int k = 0; k < 2; ++k) dst[n][k] = *(const LAS bf16x8*)(lds + PG8_SB(b, h) + boff + n * 2048 + k * 1024); } while (0)
#define PG8_MMA(ai, bj, At, Bt) do { __builtin_amdgcn_s_setprio(1); _Pragma("unroll") for (int m = 0; m < 4; ++m) _Pragma("unroll") for (int n = 0; n < 2; ++n) _Pragma("unroll") for (int k = 0; k < 2; ++k) \
    acc[ai][bj][m][n] = __builtin_amdgcn_mfma_f32_16x16x32_bf16(Bt[n][k], At[m][k], acc[ai][bj][m][n], 0, 0, 0); __builtin_amdgcn_s_setprio(0); } while (0)
#define PG8_WAIT_V(n) asm volatile("s_waitcnt vmcnt(" #n ")" ::: "memory")
#define PG8_WAIT_L(n) asm volatile("s_waitcnt lgkmcnt(" #n ")" ::: "memory")
#define PG8_BAR __builtin_amdgcn_s_barrier()
#define PG8_SCHED __builtin_amdgcn_sched_barrier(0)
  Unit cur, nxt; int ui = 0;
  if (!S.next(0, cur)) return;
  f32x4 acc[2][2][4][2];
#pragma unroll
  for (int a = 0; a < 2; ++a)
#pragma unroll
    for (int b = 0; b < 2; ++b)
#pragma unroll
      for (int m = 0; m < 4; ++m)
#pragma unroll
        for (int n = 0; n < 2; ++n) acc[a][b][m][n] = (f32x4){0.f, 0.f, 0.f, 0.f};
  bf16x8 At[4][2], B0[2][2], B1[2][2];
  const char* cA = (const char*)g.A + (size_t)cur.pm * tstepA + cur.kb + koff0; const char* cB = (const char*)g.Bt + (size_t)cur.pn * tstepB + cur.kb + koff0;
  PG8_STAGE(PG8_SB(0, 0), cB, voffB); PG8_STAGE(PG8_SB(0, 1), cB + hstepB, voffB); PG8_STAGE(PG8_SA(0, 0), cA, voffA); PG8_STAGE(PG8_SA(0, 1), cA + hstepA, voffA);
  if (wr == 1) PG8_BAR;
  PG8_WAIT_V(2); PG8_BAR;
  PG8_STAGE(PG8_SB(1, 0), cB + kstep, voffB); PG8_STAGE(PG8_SA(1, 0), cA + kstep, voffA); PG8_STAGE(PG8_SB(1, 1), cB + hstepB + kstep, voffB);
  PG8_WAIT_V(6); PG8_BAR;
  for (;;) {
    const bool has_next = S.next(ui + 1, nxt);
    const char* nA = has_next ? (const char*)g.A + (size_t)nxt.pm * tstepA + nxt.kb + koff0 : cA; const char* nB = has_next ? (const char*)g.Bt + (size_t)nxt.pn * tstepB + nxt.kb + koff0 : cB;
    for (int t = 0; t < nt; t += 2) {
      const bool last = (t == nt - 2);
      const char* a1 = cA + (ptrdiff_t)(t + 1) * kstep;
      const char* a2 = last ? nA : cA + (ptrdiff_t)(t + 2) * kstep; const char* b2 = last ? nB : cB + (ptrdiff_t)(t + 2) * kstep;
      const char* a3 = a2 + kstep; const char* b3 = b2 + kstep;
      PG8_LDB(B0, 0, 0); PG8_LDB(B1, 0, 1); PG8_SCHED; PG8_LDA(At, 0, 0); PG8_STAGE(PG8_SA(1, 1), a1 + hstepA, voffA);
      PG8_WAIT_V(8); PG8_WAIT_L(0); PG8_BAR; PG8_MMA(0, 0, At, B0); PG8_MMA(0, 1, At, B1); PG8_BAR; PG8_SCHED;
      PG8_LDA(At, 0, 1); PG8_STAGE(PG8_SB(0, 0), b2, voffB); PG8_STAGE(PG8_SB(0, 1), b2 + hstepB, voffB); PG8_STAGE(PG8_SA(0, 0), a2, voffA);
      PG8_WAIT_V(8); PG8_WAIT_L(0); PG8_BAR; PG8_MMA(1, 0, At, B0); PG8_MMA(1, 1, At, B1); PG8_BAR; PG8_SCHED;
      PG8_LDB(B0, 1, 0); PG8_LDB(B1, 1, 1); PG8_SCHED; PG8_LDA(At, 1, 0); PG8_STAGE(PG8_SA(0, 1), a2 + hstepA, voffA);
      PG8_WAIT_V(8); PG8_WAIT_L(0); PG8_BAR; PG8_MMA(0, 0, At, B0); PG8_MMA(0, 1, At, B1); PG8_BAR; PG8_SCHED;
      PG8_LDA(At, 1, 1); PG8_STAGE(PG8_SB(1, 0), b3, voffB); PG8_STAGE(PG8_SB(1, 1), b3 + hstepB, voffB); PG8_STAGE(PG8_SA(1, 0), a3, voffA);
      PG8_WAIT_V(8); PG8_WAIT_L(0); PG8_BAR; PG8_MMA(1, 0, At, B0); PG8_MMA(1, 1, At, B1); PG8_BAR; PG8_SCHED;
    }
    if constexpr (ALIGN_EPI) { if (wr == 0) PG8_BAR; }
    E(acc, cur, wr, wc, fr, fq);
    if (!has_next) break;
#pragma unroll
    for (int a = 0; a < 2; ++a)
#pragma unroll
      for (int b = 0; b < 2; ++b)
#pragma unroll
        for (int m = 0; m < 4; ++m)
#pragma unroll
          for (int n = 0; n < 2; ++n) acc[a][b][m][n] = (f32x4){0.f, 0.f, 0.f, 0.f};
    cur = nxt; cA = nA; cB = nB; ++ui;
    if constexpr (ALIGN_EPI) { if (wr == 1) PG8_BAR; }
  }
  PG8_WAIT_V(0);
  if constexpr (!ALIGN_EPI) { if (wr == 0) PG8_BAR; }
  PG8_BAR;
#undef PG8_SA
#undef PG8_SB
#undef PG8_STAGE
#undef PG8_LDA
#undef PG8_LDB
#undef PG8_MMA
#undef PG8_WAIT_V
#undef PG8_WAIT_L
#undef PG8_BAR
#undef PG8_SCHED
}

template <int ACT  > struct EpiBf16 {
  static constexpr bool PERM = true;
  bf16_t* O; int ldc;
  __device__ __forceinline__ void operator()(const f32x4 (&acc)[2][2][4][2], const Unit& u, int wr, int wc, int fr, int fq) const {
    const int row0 = u.pm * BM + wr * 64 + fr, col0 = u.pn * BM + wc * 32 + 8 * fq;
#pragma unroll
    for (int ai = 0; ai < 2; ++ai)
#pragma unroll
      for (int m = 0; m < 4; ++m) { bf16_t* rowp = O + (size_t)(row0 + ai * HALF + m * 16) * ldc + col0;
#pragma unroll
        for (int bj = 0; bj < 2; ++bj) { f32x4 v0 = acc[ai][bj][m][0], v1 = acc[ai][bj][m][1];
          if (ACT == 1) {
#pragma unroll
            for (int j = 0; j < 4; ++j) { float a = fmaxf(v0[j], 0.f), b = fmaxf(v1[j], 0.f); v0[j] = a * a; v1[j] = b * b; } }
          u32x4 w; w.x = cvt_pk_bf16(v0[0], v0[1]); w.y = cvt_pk_bf16(v0[2], v0[3]); w.z = cvt_pk_bf16(v1[0], v1[1]); w.w = cvt_pk_bf16(v1[2], v1[3]);
          *(u32x4*)(rowp + bj * HALF) = w; } }
  }
};
template <bool XIN_F32> struct EpiResid {
  static constexpr bool PERM = true;
  const void* xin; bf16_t* xout; const float* gate;
  __device__ __forceinline__ void operator()(const f32x4 (&acc)[2][2][4][2], const Unit& u, int wr, int wc, int fr, int fq) const {
    const int rowt = u.pm * BM; const int b = rowt >> 11;
    const int row0 = rowt + wr * 64 + fr, col0 = u.pn * BM + wc * 32 + 8 * fq;
    f32x4 gv[2][2];
#pragma unroll
    for (int bj = 0; bj < 2; ++bj)
#pragma unroll
      for (int n = 0; n < 2; ++n) gv[bj][n] = *(const f32x4*)(gate + (size_t)b * NMOD6 + col0 + bj * HALF + 4 * n);
#pragma unroll
    for (int ai = 0; ai < 2; ++ai)
#pragma unroll
      for (int m = 0; m < 4; ++m) { const size_t ro = (size_t)(row0 + ai * HALF + m * 16) * DM + col0;
#pragma unroll
        for (int bj = 0; bj < 2; ++bj) { f32x4 x0, x1;
          if constexpr (XIN_F32) { x0 = *(const f32x4*)((const float*)xin + ro + bj * HALF); x1 = *(const f32x4*)((const float*)xin + ro + bj * HALF + 4); }
          else { const u32x4 w = *(const u32x4*)((const bf16_t*)xin + ro + bj * HALF);
            x0 = (f32x4){bflo(w.x), bfhi(w.x), bflo(w.y), bfhi(w.y)}; x1 = (f32x4){bflo(w.z), bfhi(w.z), bflo(w.w), bfhi(w.w)}; }
          const f32x4 v0 = x0 + gv[bj][0] * acc[ai][bj][m][0], v1 = x1 + gv[bj][1] * acc[ai][bj][m][1];
          u32x4 o; o.x = cvt_pk_bf16(v0[0], v0[1]); o.y = cvt_pk_bf16(v0[2], v0[3]); o.z = cvt_pk_bf16(v1[0], v1[1]); o.w = cvt_pk_bf16(v1[2], v1[3]);
          *(u32x4*)(xout + ro + bj * HALF) = o; } }
  }
};
struct EpiPartial {
  static constexpr bool PERM = false;
  float* part; const float* gate; int kp2;
  __device__ __forceinline__ void operator()(const f32x4 (&acc)[2][2][4][2], const Unit& u, int wr, int wc, int fr, int fq) const {
    const int row0 = u.pm * BM - ML + wr * 64 + fr, col0 = u.pn * BM + wc * 32 + 4 * fq;
    float* base = part + (size_t)(u.kb / kp2) * MC * DM;
    f32x4 gv[2][2];
#pragma unroll
    for (int bj = 0; bj < 2; ++bj)
#pragma unroll
      for (int n = 0; n < 2; ++n) gv[bj][n] = *(const f32x4*)(gate + (size_t)8 * NMOD6 + col0 + bj * HALF + n * 16);
#pragma unroll
    for (int ai = 0; ai < 2; ++ai)
#pragma unroll
      for (int m = 0; m < 4; ++m) { const size_t ro = (size_t)(row0 + ai * HALF + m * 16) * DM + col0;
#pragma unroll
        for (int bj = 0; bj < 2; ++bj)
#pragma unroll
          for (int n = 0; n < 2; ++n) *(f32x4*)(base + ro + bj * HALF + n * 16) = gv[bj][n] * acc[ai][bj][m][n]; }
  }
};
}

namespace att {
constexpr int NW = 8, QBLK = 32, KVBLK = 64;
constexpr size_t SHM_V = KVBLK * 128 * 2;
#define SBAR() __builtin_amdgcn_sched_barrier(0)
__device__ __forceinline__ int crow(int r, int hi) { return (r & 3) + 8 * (r >> 2) + 4 * hi; }

__device__ __forceinline__ void partialSM(f32x16& p0, f32x16& p1, float& m_reg, float& mn, float& alpha, const float C, const float THRS) {
  float pmax = p0[0];
#pragma unroll
  for (int r = 1; r < 16; ++r) pmax = fmaxf(pmax, p0[r]);
#pragma unroll
  for (int r = 0; r < 16; ++r) pmax = fmaxf(pmax, p1[r]);
  { auto rr = __builtin_amdgcn_permlane32_swap(__float_as_uint(pmax), __float_as_uint(pmax), false, false);
    pmax = fmaxf(__uint_as_float(rr[0]), __uint_as_float(rr[1])); }
  if (__builtin_expect(__all(pmax - m_reg <= THRS), 1)) { mn = m_reg; alpha = 1.f; }
  else { mn = fmaxf(m_reg, pmax); alpha = __builtin_amdgcn_exp2f((m_reg - mn) * C); m_reg = mn; }
  float mnC = -mn * C;
#pragma unroll
  for (int r = 0; r < 16; ++r) p0[r] = fmaf(p0[r], C, mnC);
#pragma unroll
  for (int r = 0; r < 16; ++r) p1[r] = fmaf(p1[r], C, mnC);
#pragma unroll
  for (int r = 0; r < 16; ++r) p0[r] = __builtin_amdgcn_exp2f(p0[r]);
}
__device__ __forceinline__ void finishSM(f32x16& p0, f32x16& p1, float alpha, float& l_reg, bf16x8& pa0, bf16x8& pa1, bf16x8& pa2, bf16x8& pa3) {
#pragma unroll
  for (int r = 0; r < 16; ++r) p1[r] = __builtin_amdgcn_exp2f(p1[r]);
  float ps = 0;
#pragma unroll
  for (int r = 0; r < 16; ++r) ps += p0[r];
#pragma unroll
  for (int r = 0; r < 16; ++r) ps += p1[r];
  { auto rr = __builtin_amdgcn_permlane32_swap(__float_as_uint(ps), __float_as_uint(ps), false, false);
    ps = __uint_as_float(rr[0]) + __uint_as_float(rr[1]); }
  l_reg = l_reg * alpha + ps;
#define PK4(P, BASE, OUT) do { unsigned a0 = cvt_pk_bf16(P[BASE + 0], P[BASE + 1]), a1 = cvt_pk_bf16(P[BASE + 2], P[BASE + 3]);   \
    unsigned b0 = cvt_pk_bf16(P[BASE + 4], P[BASE + 5]), b1 = cvt_pk_bf16(P[BASE + 6], P[BASE + 7]);                              \
    auto r0 = __builtin_amdgcn_permlane32_swap(a0, b0, false, false); auto r1 = __builtin_amdgcn_permlane32_swap(a1, b1, false, false); \
    u32x4 w = {r0[0], r1[0], r0[1], r1[1]}; OUT = *reinterpret_cast<bf16x8*>(&w); } while (0)
  PK4(p0, 0, pa0); PK4(p0, 8, pa1); PK4(p1, 0, pa2); PK4(p1, 8, pa3);
#undef PK4
}
template <int DQK>
__device__ __forceinline__ void qkt(f32x16& p0, f32x16& p1, const char* Ks, const bf16x8* qr, const char* ql, int r32, int hi) {
  p0 = f32x16{}; p1 = f32x16{};
#pragma unroll
  for (int d0 = 0; d0 < DQK / 16; ++d0) { const int cb = (d0 * 16 + hi * 8) * 2;
    bf16x8 b0 = *reinterpret_cast<const bf16x8*>(Ks + r32 * (DQK * 2) + (cb ^ ((r32 & 7) << 4)));
    bf16x8 b1 = *reinterpret_cast<const bf16x8*>(Ks + (32 + r32) * (DQK * 2) + (cb ^ ((r32 & 7) << 4)));
    constexpr int NQR = DQK == 192 ? 4 : 8;
    bf16x8 qv; if (d0 < NQR) qv = qr[d0 < NQR ? d0 : 0]; else qv = *reinterpret_cast<const bf16x8*>(ql + (d0 - NQR) * 1024);
    p0 = __builtin_amdgcn_mfma_f32_32x32x16_bf16(b0, qv, p0, 0, 0, 0);
    p1 = __builtin_amdgcn_mfma_f32_32x32x16_bf16(b1, qv, p1, 0, 0, 0); }
}
__device__ __forceinline__ int v_st(int k, int c) { const int kk = (k & ~0xC) | ((k & 4) << 1) | ((k & 8) >> 1); return ((kk >> 3) * 4 + (c >> 5)) * 512 + ((kk & 7) * 32 + (c & 31)) * 2; }
__device__ __forceinline__ int v_rd_base(int lane) { return ((lane & 3) << 3) | (((lane >> 2) & 3) << 6) | (((lane >> 4) & 1) << 5) | (((lane >> 5) & 1) << 8); }
constexpr int v_rd_off(int d0, int ks, int half) { return d0 * 512 + ks * 4096 + half * 2048; }
template <int OFF> __device__ __forceinline__ s16x4 tr_read(int vb) {
  s16x4 r; asm volatile("ds_read_b64_tr_b16 %0, %1 offset:%2" : "=&v"(r) : "v"(vb), "i"(OFF) : "memory"); return r;
}
template <int D0> __device__ __forceinline__ void pv_one(f32x16& od, int vb, bf16x8 pa0, bf16x8 pa1, bf16x8 pa2, bf16x8 pa3) {
  const s16x4 l0 = tr_read<v_rd_off(D0, 0, 0)>(vb), h0 = tr_read<v_rd_off(D0, 0, 1)>(vb), l1 = tr_read<v_rd_off(D0, 1, 0)>(vb), h1 = tr_read<v_rd_off(D0, 1, 1)>(vb);
  const s16x4 l2 = tr_read<v_rd_off(D0, 2, 0)>(vb), h2 = tr_read<v_rd_off(D0, 2, 1)>(vb), l3 = tr_read<v_rd_off(D0, 3, 0)>(vb), h3 = tr_read<v_rd_off(D0, 3, 1)>(vb);
  asm volatile("s_waitcnt lgkmcnt(0)" ::: "memory"); SBAR();
#define PK(L, H) (bf16x8){L[0], L[1], L[2], L[3], H[0], H[1], H[2], H[3]}
  od = __builtin_amdgcn_mfma_f32_32x32x16_bf16(pa0, PK(l0, h0), od, 0, 0, 0);
  od = __builtin_amdgcn_mfma_f32_32x32x16_bf16(pa1, PK(l1, h1), od, 0, 0, 0);
  od = __builtin_amdgcn_mfma_f32_32x32x16_bf16(pa2, PK(l2, h2), od, 0, 0, 0);
  od = __builtin_amdgcn_mfma_f32_32x32x16_bf16(pa3, PK(l3, h3), od, 0, 0, 0);
#undef PK
}
__device__ __forceinline__ void pv_d0(f32x16* o, int vb, bf16x8 pa0, bf16x8 pa1, bf16x8 pa2, bf16x8 pa3) {
  pv_one<0>(o[0], vb, pa0, pa1, pa2, pa3); pv_one<1>(o[1], vb, pa0, pa1, pa2, pa3); pv_one<2>(o[2], vb, pa0, pa1, pa2, pa3); pv_one<3>(o[3], vb, pa0, pa1, pa2, pa3);
}

struct Job {
  const bf16_t* Qb; int ldq;
  const bf16_t* Kb; const bf16_t* Vb; int ldk;
  const bf16_t* Pe;
  bf16_t* Ob; int ldo;
  int NT;
  int rowA, nA, rowB;
  int qb4;
  int lo, nwin;
  const float* rope; int tok0;
};

template <int MODE>
__device__ __forceinline__ void attn_body(const Job J, char* lds) {
  constexpr int DQK = (MODE == 2) ? 192 : 128;
  constexpr size_t SHM_K = KVBLK * DQK * 2;
  constexpr float SCALE = (MODE == 2) ? 0.07216878364870323f : 0.08838834764831845f;
  constexpr float C = SCALE * 1.4426950408889634f;
  constexpr float THRS = 8.f / SCALE;
  const int tid = otid(), wid = tid >> 6, lane = tid & 63, r32 = lane & 31, hi = lane >> 5;
  char* V_lds = lds; char* K_lds = lds + 2 * SHM_V;
  float* wsf = (float*)(lds + 2 * SHM_V + 2 * SHM_K) + wid * 64; float* li_l = wsf; float* al_l = wsf + 32;
  const float* tab = (const float*)(lds + 2 * SHM_V + 2 * SHM_K + NW * 256) + 64;
  constexpr int NQR = (MODE == 2) ? 4 : 8;
  float m_reg = -1e30f, l_reg = 0; f32x16 o[4] = {}; bf16x8 qr[NQR];
  const bf16_t* Qw = J.Qb + (size_t)(wid * QBLK + r32) * J.ldq + hi * 8;
  char* ql = lds + 2 * SHM_V + 2 * SHM_K + NW * 256 + (wid * 8 * 64 + lane) * 16;
#pragma unroll
  for (int d0 = 0; d0 < NQR; ++d0) qr[d0] = *reinterpret_cast<const bf16x8*>(Qw + d0 * 16);
  if constexpr (MODE == 2) {
#pragma unroll
    for (int d0 = 4; d0 < 8; ++d0) *reinterpret_cast<bf16x8*>(ql + (d0 - 4) * 1024) = *reinterpret_cast<const bf16x8*>(Qw + d0 * 16);
    const int tok = J.tok0 + wid * QBLK + r32; const int prow = tok >> 6, pcol = tok & 63;
#pragma unroll
    for (int ax = 0; ax < 2; ++ax) {
      const float* cs = J.rope + (size_t)((ax == 0 ? prow : pcol) * 16 + hi * 8) * 2;
      bf16x8 x1 = *reinterpret_cast<const bf16x8*>(Qw + (8 + 2 * ax) * 16), x2 = *reinterpret_cast<const bf16x8*>(Qw + (9 + 2 * ax) * 16); u32x4 w1, w2;
#pragma unroll
      for (int i = 0; i < 4; ++i) {
        const f32x4 t = *(const f32x4*)(cs + 4 * i);
        const float a0 = bf2f((bf16_t)x1[2 * i]), a1 = bf2f((bf16_t)x1[2 * i + 1]), b0 = bf2f((bf16_t)x2[2 * i]), b1 = bf2f((bf16_t)x2[2 * i + 1]);
        w1[i] = cvt_pk_bf16(a0 * t[0] - b0 * t[1], a1 * t[2] - b1 * t[3]);
        w2[i] = cvt_pk_bf16(a0 * t[1] + b0 * t[0], a1 * t[3] + b1 * t[2]);
      }
      *reinterpret_cast<u32x4*>(ql + (4 + 2 * ax) * 1024) = w1; *reinterpret_cast<u32x4*>(ql + (5 + 2 * ax) * 1024) = w2;
    }
  }
  const int sr = tid >> 4, sc = (tid & 15) * 8, vst0 = v_st(sr, sc), vst1 = v_st(32 + sr, sc);
  const int pr = tid >> 3, pc = (tid & 7) * 8;
  const int vb0 = (int)(uintptr_t)V_lds + v_rd_base(lane);
  bf16x8 vs0, vs1, ks0, ks1, kp;
  const int rq = J.qb4 + (wid >> 1), qc = (wid & 1) * 32 + r32;
  const int rs = min(max(rq - 4, 0), 24), cs_ = min(max(qc - 8, 0), 48);
#define TROW(t) ((t) < J.nA ? J.rowA + 64 * (t) : J.rowB + 64 * ((t) - J.nA))
#define SLOAD(t) do { const int _r0 = TROW(t); \
    vs0 = *reinterpret_cast<const bf16x8*>(J.Vb + (size_t)(_r0 + sr) * J.ldk + sc); vs1 = *reinterpret_cast<const bf16x8*>(J.Vb + (size_t)(_r0 + 32 + sr) * J.ldk + sc); \
    ks0 = *reinterpret_cast<const bf16x8*>(J.Kb + (size_t)(_r0 + sr) * J.ldk + sc); ks1 = *reinterpret_cast<const bf16x8*>(J.Kb + (size_t)(_r0 + 32 + sr) * J.ldk + sc); \
    if constexpr (MODE == 2) kp = *reinterpret_cast<const bf16x8*>(J.Pe + (size_t)(_r0 + pr) * 64 + pc); } while (0)
#define SWRITE(b) do { *(bf16x8*)(V_lds + (b) * SHM_V + vst0) = vs0; *(bf16x8*)(V_lds + (b) * SHM_V + vst1) = vs1; const int kc = sc * 2; \
    *(bf16x8*)(K_lds + (b) * SHM_K + sr * (DQK * 2) + (kc ^ ((sr & 7) << 4))) = ks0; \
    *(bf16x8*)(K_lds + (b) * SHM_K + (32 + sr) * (DQK * 2) + (kc ^ ((sr & 7) << 4))) = ks1; \
    if constexpr (MODE == 2) *(bf16x8*)(K_lds + (b) * SHM_K + pr * (DQK * 2) + (((128 + pc) * 2) ^ ((pr & 7) << 4))) = kp; } while (0)
#define SWAIT() asm volatile("s_waitcnt vmcnt(0)" ::: "memory")
#define RESC(a) do { if (__any((a) < 1.f)) { if (hi == 0) al_l[r32] = (a); asm volatile("s_waitcnt lgkmcnt(0)" ::: "memory"); \
    _Pragma("unroll") for (int d = 0; d < 4; ++d) _Pragma("unroll") for (int r = 0; r < 16; ++r) o[d][r] *= al_l[crow(r, hi)]; } } while (0)
#define MASK(P0, P1, t) do { if constexpr (MODE == 0) { if ((t) >= J.nA) { const int _w = (t) - J.nA; const int _kr = J.lo + _w; \
      if (_w < J.nwin && _kr >= rs && _kr < rs + 8) { const float* _tr = tab + (_kr - rq + 7) * 31 + 15 - qc; \
        _Pragma("unroll") for (int r = 0; r < 16; ++r) { const int kc0 = crow(r, hi); \
          const float b0 = _tr[kc0], b1 = _tr[kc0 + 32]; \
          P0[r] = ((unsigned)(kc0 - cs_) < 16u) ? P0[r] + b0 : -1e30f; P1[r] = ((unsigned)(kc0 + 32 - cs_) < 16u) ? P1[r] + b1 : -1e30f; } } \
      else { _Pragma("unroll") for (int r = 0; r < 16; ++r) { P0[r] = -1e30f; P1[r] = -1e30f; } } } } } while (0)
  f32x16 pA0, pA1, pB0, pB1; float mnA, mnB, alA, alB; bf16x8 pa0, pa1, pa2, pa3; const int NT = J.NT;
  SLOAD(0); SWAIT(); SWRITE(0); __syncthreads();
  qkt<DQK>(pA0, pA1, K_lds, qr, ql, r32, hi); MASK(pA0, pA1, 0); partialSM(pA0, pA1, m_reg, mnA, alA, C, THRS);
  SLOAD(1);
  SWAIT(); SWRITE(1); __syncthreads();
  for (int j = 1; j + 1 < NT; j += 2) {
    SBAR(); qkt<DQK>(pB0, pB1, K_lds + SHM_K, qr, ql, r32, hi);
    finishSM(pA0, pA1, alA, l_reg, pa0, pa1, pa2, pa3); SBAR();
    SLOAD(j + 1); SBAR();
    pv_d0(o, vb0, pa0, pa1, pa2, pa3); MASK(pB0, pB1, j); partialSM(pB0, pB1, m_reg, mnB, alB, C, THRS);
    __syncthreads(); SWAIT(); SWRITE(0);
    RESC(alB); __syncthreads();
    SBAR(); qkt<DQK>(pA0, pA1, K_lds, qr, ql, r32, hi);
    finishSM(pB0, pB1, alB, l_reg, pa0, pa1, pa2, pa3); SBAR();
    SLOAD(j + 2); SBAR();
    pv_d0(o, vb0 + (int)SHM_V, pa0, pa1, pa2, pa3); MASK(pA0, pA1, j + 1); partialSM(pA0, pA1, m_reg, mnA, alA, C, THRS);
    __syncthreads(); SWAIT(); SWRITE(1);
    RESC(alA); __syncthreads();
  }
  SBAR(); qkt<DQK>(pB0, pB1, K_lds + SHM_K, qr, ql, r32, hi);
  finishSM(pA0, pA1, alA, l_reg, pa0, pa1, pa2, pa3); SBAR();
  pv_d0(o, vb0, pa0, pa1, pa2, pa3); MASK(pB0, pB1, NT - 1); partialSM(pB0, pB1, m_reg, mnB, alB, C, THRS);
  __syncthreads(); RESC(alB);
  finishSM(pB0, pB1, alB, l_reg, pa0, pa1, pa2, pa3); SBAR();
  pv_d0(o, vb0 + (int)SHM_V, pa0, pa1, pa2, pa3);
  if (hi == 0) li_l[r32] = l_reg; asm volatile("s_waitcnt lgkmcnt(0)" ::: "memory");
  float rli[16];
#pragma unroll
  for (int r = 0; r < 16; ++r) rli[r] = __builtin_amdgcn_rcpf(li_l[crow(r, hi)]);
  bf16_t* Ow = J.Ob + (size_t)(wid * QBLK) * J.ldo;
#pragma unroll
  for (int r = 0; r < 16; ++r) { const int orow = crow(r, hi);
#pragma unroll
    for (int d0 = 0; d0 < 4; ++d0) Ow[(size_t)orow * J.ldo + d0 * 32 + r32] = (bf16_t)(cvt_pk_bf16(o[d0][r] * rli[r], 0.f) & 0xffffu); }
#undef TROW
#undef SLOAD
#undef SWRITE
#undef SWAIT
#undef RESC
#undef MASK
}
}

__constant__ int XJOB[11][6] = {
  {10, 0, 2048, 5120, 0, 0},
  {11, 0, 2048, 2048, 0, 640},
  {8, 0, 2048, 8192, 0, 896},
  {20, 0, 2048, 512, 0, 1920},
  {21, 0, 2048, 576, 512, 1984},
  {9, 0, 8192, 2048, 0, 2064},
  {8, 2048 * 8, 2048, 8192, 0, 3088},
  {9, 8192 * 2, 8192, 2048, 0, 4112},
  {23, 0, 512, 3072, 0, 5136},
  {25, 0, 512, 4096, 0, 5232},
  {26, 0, 2048, 2048, 0, 5360},
};
constexpr int N_XT = 5616, N_EARLY = 640, N_SLOTA_END = 2752, N_SLOTB_END = 3088, N_GEMV = 192;

__device__ __forceinline__ size_t xjob_dst(int j) {
  switch (j) {
    case 0: return OFF_WIN; case 1: return OFF_WOUT; case 2: return OFF_W1; case 3: return OFF_WD; case 4: return OFF_WD;
    case 5: return OFF_W2; case 6: return OFF_W1 + (size_t)8192 * 2048 * 2; case 7: return OFF_W2 + (size_t)2048 * 8192 * 2;
    case 8: return OFF_WUQ; case 9: return OFF_WUKV; default: return OFF_WO;
  }
}

__device__ __forceinline__ void xpose_core(const float* src, int N, bf16_t* dst, int K, int k0, int n0, float* fs, int tid);
__device__ __forceinline__ void xpose_tile(const Params& p, int tt, float* fs, int tid) {
  int j = 0;
#pragma unroll
  for (int q = 1; q < 11; ++q) if (tt >= XJOB[q][5]) j = q;
  const int K = XJOB[j][2], N = XJOB[j][3], tl = tt - XJOB[j][5];
  const int tilesN = (N + 127) / 128; const int tk = tl / tilesN, tn = tl % tilesN;
  const float* src = p.in[XJOB[j][0]] + (size_t)XJOB[j][1] * 1024;
  bf16_t* dst = (bf16_t*)(p.ws + xjob_dst(j)) + (size_t)XJOB[j][4] * K;
  xpose_core(src, N, dst, K, tk * 128, tn * 128, fs, tid);
}
__device__ __forceinline__ void xpose_core(const float* src, int N, bf16_t* dst, int K, int k0, int n0, float* fs, int tid) {
  { const int nn = (tid & 31) * 4, kr = tid >> 5; f32x4 v[8];
#pragma unroll
    for (int q = 0; q < 8; ++q) v[q] = (n0 + nn < N) ? *(const f32x4*)(src + (size_t)(k0 + kr + 16 * q) * N + n0 + nn) : (f32x4){0.f, 0.f, 0.f, 0.f};
#pragma unroll
    for (int q = 0; q < 8; ++q) { float* d = fs + (kr + 16 * q) * 129 + nn; d[0] = v[q][0]; d[1] = v[q][1]; d[2] = v[q][2]; d[3] = v[q][3]; } }
  __syncthreads();
  { const int nl = tid >> 4, kc = (tid & 15) * 8;
#pragma unroll
    for (int q = 0; q < 4; ++q) { const int n = nl + 32 * q;
      if (n0 + n < N) { float e[8];
#pragma unroll
        for (int i = 0; i < 8; ++i) e[i] = fs[(kc + i) * 129 + n];
        u32x4 w; w.x = cvt_pk_bf16(e[0], e[1]); w.y = cvt_pk_bf16(e[2], e[3]); w.z = cvt_pk_bf16(e[4], e[5]); w.w = cvt_pk_bf16(e[6], e[7]);
        *(u32x4*)(dst + (size_t)(n0 + n) * K + k0 + kc) = w; } } }
}
__device__ __forceinline__ void xpose_deferred(const Params& p, char* shm, int lo, int hi, int c0) {
  if ((int)blockIdx.x < c0) return;
  const int tid = otid();
  for (int t = lo + (int)blockIdx.x - c0; t < hi; t += (int)gridDim.x - c0) { __syncthreads(); xpose_tile(p, t, (float*)shm, tid); }
}

__device__ __forceinline__ void phase0(const Params& p, char* shm) {
  const int tid = otid();
  float* fs = (float*)shm;
  bool cond_ready = false;
  const int n_xt0 = (gridDim.x == 256) ? N_EARLY : N_XT;
  const int T0_TOTAL = N_GEMV + n_xt0 + 32 + 1 + 1;
  for (int it = 0; ; ++it) {
    int task;
    if (gridDim.x == 256) {
      const int c = blockIdx.x;
      if (c < 192) { if (it == 0) task = c; else if (it == 1 && c < 34) task = N_GEMV + n_xt0 + c; else break; }
      else { if (it < 10) task = N_GEMV + (c - 192) * 10 + it; else break; }
    } else { task = blockIdx.x + it * gridDim.x; if (task >= T0_TOTAL) break; }
    __syncthreads();
    if (task < N_GEMV) {
      float* condS = fs;
      float* red = fs + 9 * 2048;
      if (!cond_ready) {
        for (int i = tid; i < 9 * 2048; i += 512) { const int r = i >> 11, k = i & 2047; const float v = r < 8 ? p.in[1][r * 2048 + k] : p.in[3][k]; condS[i] = v / (1.f + __expf(-v)); }
        cond_ready = true;
        __syncthreads();
      }
      const int l = task / 96, col0 = (task % 96) * 128;
      const int cp = (tid & 63) * 2, ks = tid >> 6;
      const float* W = p.in[4] + ((size_t)l * 2048 + ks * 256) * NMOD6 + col0 + cp;
      float a0[9], a1[9];
#pragma unroll
      for (int r = 0; r < 9; ++r) { a0[r] = 0.f; a1[r] = 0.f; }
      const LAS float* condL = (const LAS float*)(LAS char*)shm;
      for (int k = 0; k < 256; k += 32) {
        f32x2 w[32];
#pragma unroll
        for (int u = 0; u < 32; ++u) w[u] = *(const f32x2*)(W + (size_t)(k + u) * NMOD6);
#pragma unroll
        for (int u4 = 0; u4 < 8; ++u4) {
#pragma unroll
          for (int r = 0; r < 9; ++r) { const f32x4 cv = *(const LAS f32x4*)(condL + r * 2048 + ks * 256 + k + 4 * u4);
#pragma unroll
            for (int e = 0; e < 4; ++e) { a0[r] = fmaf(cv[e], w[4 * u4 + e].x, a0[r]); a1[r] = fmaf(cv[e], w[4 * u4 + e].y, a1[r]); } }
        }
      }
#pragma unroll
      for (int r = 0; r < 9; ++r) { red[(ks * 9 + r) * 128 + cp] = a0[r]; red[(ks * 9 + r) * 128 + cp + 1] = a1[r]; }
      __syncthreads();
      float* modv = (float*)(p.ws + OFF_MODV);
      for (int i = tid; i < 9 * 128; i += 512) { const int r = i >> 7, c = i & 127; float s = 0.f;
#pragma unroll
        for (int q = 0; q < 8; ++q) s += red[(q * 9 + r) * 128 + c];
        modv[((size_t)l * 9 + r) * NMOD6 + col0 + c] = s + p.in[5][(size_t)l * NMOD6 + col0 + c]; }
    } else if (task < N_GEMV + n_xt0) {
      xpose_tile(p, task - N_GEMV, fs, tid);
    } else if (task < N_GEMV + n_xt0 + 32) {
      const int mi = task - (N_GEMV + n_xt0); const int blk = mi >> 2, d = (mi >> 1) & 1, g = mi & 1;
      xpose_core((g ? p.in[17] : p.in[15]) + ((size_t)d * 8 + blk) * 128 * 128, 128, (bf16_t*)(p.ws + OFF_WL) + ((size_t)blk * 512 + d * 256 + g * 128) * 128, 128, 0, 0, fs, tid);
    } else if (task == N_GEMV + n_xt0 + 32) {
      u32x4* z = (u32x4*)(p.ws + OFF_WD + (size_t)1088 * 2048 * 2);
      for (int i = tid; i < 192 * 2048 * 2 / 16; i += 512) z[i] = (u32x4){0u, 0u, 0u, 0u};
    } else {
      float* rt = (float*)(p.ws + OFF_ROPE);
      for (int i = tid; i < 1024; i += 512) { const int pos = i >> 4, f = i & 15; const float ang = (float)pos * p.inv[f]; rt[2 * i] = cosf(ang); rt[2 * i + 1] = sinf(ang); }
    }
  }
}

template <int MODE, bool FIX, bool LAT_F32, bool CTX_F32>
__device__ __forceinline__ void norm_rows(const void* src_lat, const void* src_ctx, int nrows, const float* gain, const float* shift, const float* scale, void* dst,
                                          bf16_t* xfix = nullptr, const float* part = nullptr) {
  const int tid_ = otid(); const int lane = tid_ & 63, wv = tid_ >> 6;
  f32x4 g[4][2];
#pragma unroll
  for (int i = 0; i < 4; ++i) { g[i][0] = *(const f32x4*)(gain + i * 512 + lane * 8); g[i][1] = *(const f32x4*)(gain + i * 512 + lane * 8 + 4); }
  for (int row = blockIdx.x * 8 + wv; row < nrows; row += gridDim.x * 8) {
    f32x4 v[4][2];
    const bool islat = row < ML;
    const bool f32src = islat ? LAT_F32 : CTX_F32;
    const void* sp = islat ? src_lat : src_ctx;
    if (f32src) { const float* s = (const float*)sp + (size_t)row * DM + lane * 8;
#pragma unroll
      for (int i = 0; i < 4; ++i) { v[i][0] = *(const f32x4*)(s + i * 512); v[i][1] = *(const f32x4*)(s + i * 512 + 4); } }
    else { const bf16_t* s = (const bf16_t*)sp + (size_t)row * DM + lane * 8;
#pragma unroll
      for (int i = 0; i < 4; ++i) { const u32x4 w = *(const u32x4*)(s + i * 512);
        v[i][0] = (f32x4){bflo(w.x), bfhi(w.x), bflo(w.y), bfhi(w.y)}; v[i][1] = (f32x4){bflo(w.z), bfhi(w.z), bflo(w.w), bfhi(w.w)}; } }
    if constexpr (FIX) { if (!islat) {
      const float* pp = part + (size_t)(row - ML) * DM + lane * 8;
#pragma unroll
      for (int q = 0; q < 4; ++q)
#pragma unroll
        for (int i = 0; i < 4; ++i) { v[i][0] += *(const f32x4*)(pp + (size_t)q * MC * DM + i * 512); v[i][1] += *(const f32x4*)(pp + (size_t)q * MC * DM + i * 512 + 4); }
#pragma unroll
      for (int i = 0; i < 4; ++i) { u32x4 o; o.x = cvt_pk_bf16(v[i][0][0], v[i][0][1]); o.y = cvt_pk_bf16(v[i][0][2], v[i][0][3]); o.z = cvt_pk_bf16(v[i][1][0], v[i][1][1]); o.w = cvt_pk_bf16(v[i][1][2], v[i][1][3]);
        *(u32x4*)(xfix + (size_t)row * DM + i * 512 + lane * 8) = o;
        v[i][0] = (f32x4){bflo(o.x), bfhi(o.x), bflo(o.y), bfhi(o.y)}; v[i][1] = (f32x4){bflo(o.z), bfhi(o.z), bflo(o.w), bfhi(o.w)}; } } }
    float ss = 0.f;
#pragma unroll
    for (int i = 0; i < 4; ++i)
#pragma unroll
      for (int h = 0; h < 2; ++h) ss += v[i][h][0] * v[i][h][0] + v[i][h][1] * v[i][h][1] + v[i][h][2] * v[i][h][2] + v[i][h][3] * v[i][h][3];
    ss = wave_sum(ss);
    const float rstd = rsqrtf(ss * (1.f / DM) + 1e-6f);
    if constexpr (MODE == 0) {
      const int b = islat ? (row >> 11) : 8;
      const float* sh = shift + (size_t)b * NMOD6 + lane * 8; const float* sc = scale + (size_t)b * NMOD6 + lane * 8;
      bf16_t* d = (bf16_t*)dst + (size_t)row * DM + lane * 8;
#pragma unroll
      for (int i = 0; i < 4; ++i) { f32x4 y[2];
#pragma unroll
        for (int h = 0; h < 2; ++h) { const f32x4 a = *(const f32x4*)(sh + i * 512 + 4 * h), c = *(const f32x4*)(sc + i * 512 + 4 * h);
          y[h] = v[i][h] * rstd * g[i][h]; y[h] = y[h] * (c + 1.f) + a; }
        u32x4 o; o.x = cvt_pk_bf16(y[0][0], y[0][1]); o.y = cvt_pk_bf16(y[0][2], y[0][3]); o.z = cvt_pk_bf16(y[1][0], y[1][1]); o.w = cvt_pk_bf16(y[1][2], y[1][3]);
        *(u32x4*)(d + i * 512) = o; }
    } else {
      float* d = (float*)dst + (size_t)row * DM + lane * 8;
#pragma unroll
      for (int i = 0; i < 4; ++i) { *(f32x4*)(d + i * 512) = v[i][0] * rstd * g[i][0]; *(f32x4*)(d + i * 512 + 4) = v[i][1] * rstd * g[i][1]; }
    }
  }
}

__device__ __forceinline__ void mla_norm_rows(const Params& p) {
  const int tid_ = otid(); const int lane = tid_ & 63, wv = tid_ >> 6;
  const bf16_t* QA = (const bf16_t*)(p.ws + OFF_QA); bf16_t* QN = (bf16_t*)(p.ws + OFF_QN); bf16_t* CK = (bf16_t*)(p.ws + OFF_CKVN); bf16_t* KPE = (bf16_t*)(p.ws + OFF_KPE);
  const float* rope = (const float*)(p.ws + OFF_ROPE);
  float gq[8], gk[8];
#pragma unroll
  for (int i = 0; i < 8; ++i) { gq[i] = p.in[22][lane * 8 + i]; gk[i] = p.in[24][lane * 8 + i]; }
  for (int row = blockIdx.x * 8 + wv; row < MT; row += gridDim.x * 8) {
    const bf16_t* s = QA + (size_t)row * 1280;
    const u32x4 cw = *(const u32x4*)(s + 512 + lane * 8);
    float c[8] = {bflo(cw.x), bfhi(cw.x), bflo(cw.y), bfhi(cw.y), bflo(cw.z), bfhi(cw.z), bflo(cw.w), bfhi(cw.w)};
    float ssc = 0.f;
#pragma unroll
    for (int i = 0; i < 8; ++i) ssc += c[i] * c[i];
    ssc = wave_sum(ssc);
    { const float rstd = rsqrtf(ssc * (1.f / 512.f) + 1e-6f); u32x4 w;
      w.x = cvt_pk_bf16(c[0] * rstd * gk[0], c[1] * rstd * gk[1]); w.y = cvt_pk_bf16(c[2] * rstd * gk[2], c[3] * rstd * gk[3]);
      w.z = cvt_pk_bf16(c[4] * rstd * gk[4], c[5] * rstd * gk[5]); w.w = cvt_pk_bf16(c[6] * rstd * gk[6], c[7] * rstd * gk[7]);
      *(u32x4*)(CK + (size_t)row * 512 + lane * 8) = w; }
    if (row < ML) {
      const u32x4 qw = *(const u32x4*)(s + lane * 8);
      float q[8] = {bflo(qw.x), bfhi(qw.x), bflo(qw.y), bfhi(qw.y), bflo(qw.z), bfhi(qw.z), bflo(qw.w), bfhi(qw.w)};
      float ssq = 0.f;
#pragma unroll
      for (int i = 0; i < 8; ++i) ssq += q[i] * q[i];
      ssq = wave_sum(ssq);
      const float rstd = rsqrtf(ssq * (1.f / 512.f) + 1e-6f); u32x4 w;
      w.x = cvt_pk_bf16(q[0] * rstd * gq[0], q[1] * rstd * gq[1]); w.y = cvt_pk_bf16(q[2] * rstd * gq[2], q[3] * rstd * gq[3]);
      w.z = cvt_pk_bf16(q[4] * rstd * gq[4], q[5] * rstd * gq[5]); w.w = cvt_pk_bf16(q[6] * rstd * gq[6], q[7] * rstd * gq[7]);
      *(u32x4*)(QN + (size_t)row * 512 + lane * 8) = w;
    }
    {
      const int l8 = lane & 7;
      const u32x4 kw = *(const u32x4*)(s + 1024 + l8 * 8);
      float k[8] = {bflo(kw.x), bfhi(kw.x), bflo(kw.y), bfhi(kw.y), bflo(kw.z), bfhi(kw.z), bflo(kw.w), bfhi(kw.w)};
      float o[8];
      if (row < ML) {
        const int tok = row & 2047; const int ax = l8 >> 2, half = (l8 >> 1) & 1; const int pos = ax == 0 ? (tok >> 6) : (tok & 63);
        const float* cs = rope + (size_t)(pos * 16 + (l8 & 1) * 8) * 2;
#pragma unroll
        for (int i = 0; i < 8; ++i) { const float other = __shfl_xor(k[i], 2, 64); const float co = cs[2 * i], si = cs[2 * i + 1];
          o[i] = half == 0 ? (k[i] * co - other * si) : (other * si + k[i] * co); }
      } else {
#pragma unroll
        for (int i = 0; i < 8; ++i) o[i] = k[i];
      }
      if (lane < 8) { u32x4 w; w.x = cvt_pk_bf16(o[0], o[1]); w.y = cvt_pk_bf16(o[2], o[3]); w.z = cvt_pk_bf16(o[4], o[5]); w.w = cvt_pk_bf16(o[6], o[7]);
        *(u32x4*)(KPE + (size_t)row * 64 + lane * 8) = w; }
    }
  }
}

constexpr int XCP = 136;
template <int REV, int EMIT>
__device__ __forceinline__ void lru_dir(const LAS bf16_t* XC, LAS float* HF, const bf16x8 (&Wr)[4], const bf16x8 (&Wi)[4], float ba, float bx, float sp8,
                                        float& carry, float& Atot, int tid, int wv, int fr, int fq, const LAS bf16_t* GE, bf16_t* Op,
                                        unsigned* SDp, const unsigned (&sd)[8][4]) {
  const int lane = fq * 16 + fr;
#pragma unroll
  for (int mm = 0; mm < 8; ++mm) {
    const int m = REV ? 7 - mm : mm;
    float av[4], uv[4];
    if constexpr (EMIT == 0) {
      f32x4 gr = {0.f, 0.f, 0.f, 0.f}, gi = {0.f, 0.f, 0.f, 0.f};
#pragma unroll
      for (int ks = 0; ks < 4; ++ks) {
        const bf16x8 a = *(const LAS bf16x8*)(XC + (16 * m + fr) * XCP + ks * 32 + fq * 8);
        gr = __builtin_amdgcn_mfma_f32_16x16x32_bf16(a, Wr[ks], gr, 0, 0, 0);
        gi = __builtin_amdgcn_mfma_f32_16x16x32_bf16(a, Wi[ks], gi, 0, 0, 0);
      }
#pragma unroll
      for (int j = 0; j < 4; ++j) {
        const float xc = bf2f(XC[(16 * m + 4 * fq + j) * XCP + 16 * wv + fr]);
        const float r = __builtin_amdgcn_rcpf(1.f + __expf(-(gr[j] + ba))), ig = __builtin_amdgcn_rcpf(1.f + __expf(-(gi[j] + bx)));
        const float la = -sp8 * r;
        const float a = __expf(la);
        av[j] = a;
        uv[j] = __builtin_amdgcn_sqrtf(fmaxf(fmaf(-a, a, 1.f), 0.f)) * (ig * xc);
        SDp[(size_t)(16 * m + 4 * fq + j) * 1024] = cvt_pk_bf16(la, uv[j]);
      }
    } else {
#pragma unroll
      for (int j = 0; j < 4; ++j) { av[j] = __expf(bflo(sd[m][j])); uv[j] = bfhi(sd[m][j]); }
    }
    float s[4], P[4];
    if (!REV) { s[0] = uv[0]; P[0] = av[0];
#pragma unroll
      for (int j = 1; j < 4; ++j) { s[j] = fmaf(av[j], s[j - 1], uv[j]); P[j] = av[j] * P[j - 1]; } }
    else { s[3] = uv[3]; P[3] = av[3];
#pragma unroll
      for (int j = 2; j >= 0; --j) { s[j] = fmaf(av[j], s[j + 1], uv[j]); P[j] = av[j] * P[j + 1]; } }
    float A = REV ? P[0] : P[3], U = REV ? s[0] : s[3];
    { const int src = REV ? lane + 16 : lane - 16; const float Ap = __shfl(A, src & 63, 64), Up = __shfl(U, src & 63, 64);
      const bool on = REV ? (fq <= 2) : (fq >= 1); if (on) { U = fmaf(A, Up, U); A = A * Ap; } }
    { const int src = REV ? lane + 32 : lane - 32; const float Ap = __shfl(A, src & 63, 64), Up = __shfl(U, src & 63, 64);
      const bool on = REV ? (fq <= 1) : (fq >= 2); if (on) { U = fmaf(A, Up, U); A = A * Ap; } }
    float Ae, Ue;
    { const int src = REV ? lane + 16 : lane - 16; Ae = __shfl(A, src & 63, 64); Ue = __shfl(U, src & 63, 64);
      const bool first = REV ? (fq == 3) : (fq == 0); if (first) { Ae = 1.f; Ue = 0.f; } }
    const float cr = fmaf(Ae, carry, Ue);
    if (EMIT == 1) {
#pragma unroll
      for (int j = 0; j < 4; ++j) HF[(m * 4 + j) * 512 + tid] = fmaf(P[j], cr, s[j]);
    }
    if (EMIT == 2) {
#pragma unroll
      for (int j = 0; j < 4; ++j) { const float hsum = HF[(m * 4 + j) * 512 + tid] + fmaf(P[j], cr, s[j]);
        const int tl = 16 * m + 4 * fq + j;
        const float ge = bf2f(GE[tl * XCP + 16 * wv + fr]);
        Op[(size_t)tl * DM] = (bf16_t)(cvt_pk_bf16(hsum * ge, 0.f) & 0xffffu); }
    }
    const int lastl = REV ? fr : 48 + fr;
    const float At = __shfl(A, lastl, 64), Ut = __shfl(U, lastl, 64);
    carry = fmaf(At, carry, Ut); Atot *= At;
  }
}

template <int PASS>
__device__ __forceinline__ void lru_task(const Params& p, int task, char* shm) {
  const int tid = otid(), lane = tid & 63, wv = tid >> 6, fr = lane & 15, fq = lane >> 4;
  const int ci = task % 18, blk = (task / 18) & 7, b = task / 144;
  const bf16_t* P = (const bf16_t*)(p.ws + OFF_P);
  LAS bf16_t* XC = (LAS bf16_t*)shm;
  LAS float* HF = (LAS float*)(shm + 128 * XCP * 2);
  LAS bf16_t* GE = (LAS bf16_t*)(shm + 128 * XCP * 2 + 32 * 512 * 4);
  const int L = ci < 2 ? 256 : 2048, tl0 = ci < 2 ? ci * 128 : (ci - 2) * 128;
  const size_t rowbase = ci < 2 ? (size_t)ML + b * 256 : (size_t)b * 2048;
  const int ch = blk * 128 + 16 * wv + fr;
  unsigned* SD0 = (unsigned*)(p.ws + OFF_X) + (rowbase + tl0) * 1024 + ch;
  unsigned* SD1 = SD0 + (size_t)MT * 1024;
  float* LS = (float*)(p.ws + OFF_LSUM) + (size_t)((b * 8 + blk) * 18) * 2 * 128 * 2;
  bf16_t* Op = (bf16_t*)(p.ws + OFF_MIX) + (rowbase + tl0) * DM + 1024 + ch;
  __syncthreads();
  if constexpr (PASS == 1) {
    {
      const int cg = tid & 15; const int ch0 = blk * 128 + cg * 8;
      float cw[4][8], cb[8];
#pragma unroll
      for (int e = 0; e < 8; ++e) { cb[e] = p.in[14][ch0 + e];
#pragma unroll
        for (int tp = 0; tp < 4; ++tp) cw[tp][e] = p.in[13][tp * 1024 + ch0 + e]; }
      u32x4 wld[4][4];
#pragma unroll
      for (int it = 0; it < 4; ++it)
#pragma unroll
        for (int tp = 0; tp < 4; ++tp) { const int tl = tl0 + (tid >> 4) + 32 * it + tp - 2; const int tlc = min(max(tl, 0), L - 1);
          wld[it][tp] = *(const u32x4*)(P + (rowbase + tlc) * ABIN + 3072 + ch0); }
#pragma unroll
      for (int it = 0; it < 4; ++it) { const int t = (tid >> 4) + 32 * it; float acc[8];
#pragma unroll
        for (int e = 0; e < 8; ++e) acc[e] = cb[e];
#pragma unroll
        for (int tp = 0; tp < 4; ++tp) { const int tl = tl0 + t + tp - 2; const bool ok = (tl >= 0 && tl < L);
          const u32x4 w = wld[it][tp];
          const float x[8] = {bflo(w.x), bfhi(w.x), bflo(w.y), bfhi(w.y), bflo(w.z), bfhi(w.z), bflo(w.w), bfhi(w.w)};
#pragma unroll
          for (int e = 0; e < 8; ++e) acc[e] = fmaf(cw[tp][e], ok ? x[e] : 0.f, acc[e]); }
        u32x4 o; o.x = cvt_pk_bf16(acc[0], acc[1]); o.y = cvt_pk_bf16(acc[2], acc[3]); o.z = cvt_pk_bf16(acc[4], acc[5]); o.w = cvt_pk_bf16(acc[6], acc[7]);
        *(LAS u32x4*)(XC + t * XCP + cg * 8) = o; }
    }
    __syncthreads();
    const bf16_t* WL = (const bf16_t*)(p.ws + OFF_WL) + (size_t)blk * 512 * 128;
    const unsigned nosd[8][4] = {};
#pragma unroll
    for (int d = 0; d < 2; ++d) {
      bf16x8 Wr[4], Wi[4];
#pragma unroll
      for (int ks = 0; ks < 4; ++ks) { Wr[ks] = *(const bf16x8*)(WL + (size_t)(256 * d + 16 * wv + fr) * 128 + ks * 32 + fq * 8); Wi[ks] = *(const bf16x8*)(WL + (size_t)(256 * d + 128 + 16 * wv + fr) * 128 + ks * 32 + fq * 8); }
      const float ba = p.in[16][1024 * d + ch], bx = p.in[18][1024 * d + ch]; const float lam = p.in[19][1024 * d + ch];
      const float sp8 = 8.f * (fmaxf(-lam, 0.f) + log1pf(__expf(-fabsf(lam))));
      float carry = 0.f, Atot = 1.f;
      if (d == 0) lru_dir<0, 0>(XC, HF, Wr, Wi, ba, bx, sp8, carry, Atot, tid, wv, fr, fq, GE, Op, SD0, nosd);
      else        lru_dir<1, 0>(XC, HF, Wr, Wi, ba, bx, sp8, carry, Atot, tid, wv, fr, fq, GE, Op, SD1, nosd);
      if (fq == 0) *(f32x2*)(LS + ((size_t)(ci * 2 + d) * 128 + 16 * wv + fr) * 2) = (f32x2){Atot, carry};
    }
  } else {
    unsigned sdf[8][4], sdr[8][4];
#pragma unroll
    for (int m = 0; m < 8; ++m)
#pragma unroll
      for (int j = 0; j < 4; ++j) { sdf[m][j] = SD0[(size_t)(16 * m + 4 * fq + j) * 1024]; sdr[m][j] = SD1[(size_t)(16 * m + 4 * fq + j) * 1024]; }
    {
      const int cg = tid & 15; const int ch0 = blk * 128 + cg * 8;
      u32x4 gl[4];
#pragma unroll
      for (int it = 0; it < 4; ++it) gl[it] = *(const u32x4*)(P + (rowbase + tl0 + (tid >> 4) + 32 * it) * ABIN + 4096 + ch0);
#pragma unroll
      for (int it = 0; it < 4; ++it) { const u32x4 w = gl[it];
        float x[8] = {bflo(w.x), bfhi(w.x), bflo(w.y), bfhi(w.y), bflo(w.z), bfhi(w.z), bflo(w.w), bfhi(w.w)};
#pragma unroll
        for (int e = 0; e < 8; ++e) { const float g = x[e]; const float z = 0.7978845608028654f * (g + 0.044715f * g * g * g); x[e] = g * __builtin_amdgcn_rcpf(1.f + __expf(-2.f * z)); }
        u32x4 o; o.x = cvt_pk_bf16(x[0], x[1]); o.y = cvt_pk_bf16(x[2], x[3]); o.z = cvt_pk_bf16(x[4], x[5]); o.w = cvt_pk_bf16(x[6], x[7]);
        *(LAS u32x4*)(GE + ((tid >> 4) + 32 * it) * XCP + cg * 8) = o; }
    }
    float carryF = 0.f, carryR = 0.f;
    { f32x2 su[17];
#pragma unroll
      for (int c2 = 0; c2 < 17; ++c2) su[c2] = (c2 < ci) ? *(const f32x2*)(LS + ((size_t)(c2 * 2 + 0) * 128 + 16 * wv + fr) * 2) : (f32x2){1.f, 0.f};
#pragma unroll
      for (int c2 = 0; c2 < 17; ++c2) carryF = fmaf(su[c2].x, carryF, su[c2].y); }
    { const int pos = ci < 2 ? (1 - ci) : (19 - ci);
      f32x2 su[17];
#pragma unroll
      for (int q = 0; q < 17; ++q) { const int c2 = q < 2 ? 1 - q : 19 - q; su[q] = (q < pos) ? *(const f32x2*)(LS + ((size_t)(c2 * 2 + 1) * 128 + 16 * wv + fr) * 2) : (f32x2){1.f, 0.f}; }
#pragma unroll
      for (int q = 0; q < 17; ++q) carryR = fmaf(su[q].x, carryR, su[q].y); }
    __syncthreads();
    const bf16x8 nw[4] = {};
    float At0 = 1.f, At1 = 1.f;
    lru_dir<0, 1>(XC, HF, nw, nw, 0.f, 0.f, 0.f, carryF, At0, tid, wv, fr, fq, GE, Op, SD0, sdf);
    lru_dir<1, 2>(XC, HF, nw, nw, 0.f, 0.f, 0.f, carryR, At1, tid, wv, fr, fq, GE, Op, SD1, sdr);
  }
}

__device__ __forceinline__ void na_task(const Params& p, int task, char* shm) {
  const int qb = task & 7, h = (task >> 3) & 7, b = task >> 6;
  const bf16_t* P = (const bf16_t*)(p.ws + OFF_P); bf16_t* MIX = (bf16_t*)(p.ws + OFF_MIX);
  __syncthreads();
  { float* tb = (float*)(shm + 2 * att::SHM_V + 2 * (64 * 128 * 2) + att::NW * 256) + 64;
    for (int i = otid(); i < 15 * 31; i += 512) tb[i] = p.in[12][h * 465 + i] * 11.313708498984761f; }
  att::Job J;
  J.Qb = P + (size_t)(b * 2048 + qb * 256) * ABIN + h * 128; J.ldq = ABIN;
  J.Kb = P + 1024 + h * 128; J.Vb = P + 2048 + h * 128; J.ldk = ABIN; J.Pe = nullptr;
  J.Ob = MIX + (size_t)(b * 2048 + qb * 256) * DM + h * 128; J.ldo = DM;
  const int r0 = qb * 4; const int lo = min(max(r0 - 4, 0), 24), hiw = min(max(r0 - 1, 0), 24) + 7;
  J.lo = lo; J.nwin = hiw - lo + 1; J.qb4 = r0;
  J.nA = 4; J.rowA = ML + b * 256; J.rowB = b * 2048 + lo * 64;
  J.NT = (4 + J.nwin + 1) & ~1;
  J.rope = nullptr; J.tok0 = 0;
  __syncthreads();
  att::attn_body<0>(J, shm);
}
__device__ __forceinline__ void ctxattn_task(const Params& p, int task, char* shm) {
  const int h = task & 7, b = task >> 3;
  const bf16_t* P = (const bf16_t*)(p.ws + OFF_P); bf16_t* MIX = (bf16_t*)(p.ws + OFF_MIX);
  __syncthreads();
  att::Job J;
  J.Qb = P + (size_t)(ML + b * 256) * ABIN + h * 128; J.ldq = ABIN;
  J.Kb = P + 1024 + h * 128; J.Vb = P + 2048 + h * 128; J.ldk = ABIN; J.Pe = nullptr;
  J.Ob = MIX + (size_t)(ML + b * 256) * DM + h * 128; J.ldo = DM;
  J.NT = 4; J.nA = 4; J.rowA = ML + b * 256; J.rowB = 0; J.qb4 = 0; J.lo = 0; J.nwin = 0; J.rope = nullptr; J.tok0 = 0;
  att::attn_body<1>(J, shm);
}
__device__ __forceinline__ void mla_task(const Params& p, int task, char* shm) {
  const int qb = task & 7, h = (task >> 3) & 15, b = task >> 7;
  const bf16_t* Q = (const bf16_t*)(p.ws + OFF_Q); const bf16_t* KV = (const bf16_t*)(p.ws + OFF_KV); bf16_t* ATT = (bf16_t*)(p.ws + OFF_H);
  __syncthreads();
  att::Job J;
  J.Qb = Q + (size_t)(b * 2048 + qb * 256) * 3072 + h * 192; J.ldq = 3072;
  J.Kb = KV + h * 256; J.Vb = KV + h * 256 + 128; J.ldk = 4096; J.Pe = (const bf16_t*)(p.ws + OFF_KPE);
  J.Ob = ATT + (size_t)(b * 2048 + qb * 256) * DM + h * 128; J.ldo = DM;
  J.NT = 36; J.nA = 32; J.rowA = b * 2048; J.rowB = ML + b * 256; J.qb4 = 0; J.lo = 0; J.nwin = 0;
  J.rope = (const float*)(p.ws + OFF_ROPE); J.tok0 = qb * 256;
  att::attn_body<2>(J, shm);
}

#define XB_TMO      128
#define XB_XCNT(j)  (256  + 64 * (j))
#define XB_XSUB(j)  (1280 + 64 * (j))
#define XB_XGEN(j)  (2304 + 64 * (j))
#define XB_TOP      3328
#define XB_TOPGEN   3392
#define XCD_BAR_WORDS 3456
#define XB_SPIN_CAP (1u << 18)
__device__ __forceinline__ unsigned xb_ld(unsigned* p)              { return __hip_atomic_load(p, __ATOMIC_RELAXED, __HIP_MEMORY_SCOPE_AGENT); }
__device__ __forceinline__ unsigned xb_add(unsigned* p, unsigned v) { return __hip_atomic_fetch_add(p, v, __ATOMIC_RELAXED, __HIP_MEMORY_SCOPE_AGENT); }
__device__ __forceinline__ unsigned xb_xcc_id() { return (unsigned)__builtin_amdgcn_s_getreg((3 << 11) | 20) & 0xFu; }
#define XB_SPIN(cond, bar) do { unsigned _sp = 0; while (cond) { __builtin_amdgcn_s_sleep(1); \
    if ((++_sp & 255u) == 0u) { if (xb_ld(&(bar)[XB_TMO])) break; if (_sp > XB_SPIN_CAP) { atomicAdd(&(bar)[XB_TMO], 1u); break; } } } } while (0)
struct XcdBarrier { unsigned* bar; unsigned x; volatile LAS unsigned* st; };
__device__ __forceinline__ XcdBarrier xcd_barrier_post(unsigned* bar, volatile LAS unsigned* st) {
  XcdBarrier b; b.bar = bar; b.x = xb_xcc_id(); b.st = st;
  if (threadIdx.x == 0) (void)xb_add(&bar[XB_XCNT(b.x)], 1u);
  return b;
}
__device__ __forceinline__ void xcd_barrier_complete(unsigned* bar, unsigned x, unsigned& nloc, unsigned& nx) {
  const unsigned G = gridDim.x * gridDim.y * gridDim.z;
  unsigned sum, cnt, mine, sp = 0u;
  for (;;) {
    sum = 0u; cnt = 0u; mine = 0u;
#pragma unroll
    for (unsigned j = 0; j < 16; ++j) { const unsigned c = xb_ld(&bar[XB_XCNT(j)]); sum += c; cnt += (c > 0u) ? 1u : 0u; mine = (j == x) ? c : mine; }
    if (sum == G) break;
    __builtin_amdgcn_s_sleep(1);
    if ((++sp & 255u) == 0u) { if (xb_ld(&bar[XB_TMO])) break; if (sp > XB_SPIN_CAP) { atomicAdd(&bar[XB_TMO], 1u); break; } }
  }
  nloc = mine > 0u ? mine : 1u; nx = cnt > 0u ? cnt : 1u;
}
__device__ __forceinline__ void xcd_barrier(const XcdBarrier& b) {
  asm volatile("s_waitcnt vmcnt(0)" ::: "memory");
  __syncthreads();
  if (threadIdx.x == 0) {
    unsigned* bar = b.bar;
    __builtin_amdgcn_s_waitcnt(0);
    unsigned nloc = b.st[0], nx = b.st[1];
    if (nloc == 0u) { xcd_barrier_complete(bar, b.x, nloc, nx); b.st[0] = nloc; b.st[1] = nx; }
    const unsigned old = xb_add(&bar[XB_XSUB(b.x)], 1u);
    const unsigned gen = old / nloc;
    if (old + 1u == (gen + 1u) * nloc) {
      __builtin_amdgcn_fence(__ATOMIC_RELEASE, "agent");
      asm volatile("s_waitcnt vmcnt(0)" ::: "memory");
      const unsigned og = xb_add(&bar[XB_TOP], 1u);
      const unsigned tg = og / nx;
      if (og + 1u == (tg + 1u) * nx) xb_add(&bar[XB_TOPGEN], 1u);
      else XB_SPIN(xb_ld(&bar[XB_TOPGEN]) == tg, bar);
      __builtin_amdgcn_fence(__ATOMIC_ACQUIRE, "agent");
      xb_add(&bar[XB_XGEN(b.x)], 1u);
      asm volatile("s_waitcnt vmcnt(0)" ::: "memory");
    } else {
      XB_SPIN(xb_ld(&bar[XB_XGEN(b.x)]) == gen, bar);
      __builtin_amdgcn_fence(__ATOMIC_ACQUIRE, "agent");
      asm volatile("s_waitcnt vmcnt(0)" ::: "memory");
    }
  }
  __syncthreads();
}

template <class Epi>
__device__ __forceinline__ void run_gemm(char* shm, const bf16_t* A, int lda, const bf16_t* Bt, int ldb, int K, int nM, int nN, const Epi& E, int krev = 0) {
  pg8::Gemm g; g.A = A; g.Bt = Bt; g.lda = lda; g.ldb = ldb; g.K = K; g.nM = nM; g.nN = nN; g.krev = krev;
  pg8::StaticOrder S; S.init(nM, nN, gridDim.x, blockIdx.x);
  __syncthreads();
  pg8::gemm_phase<Epi, pg8::StaticOrder>((LAS unsigned char*)shm, g, S, E);
}
template <class Epi>
__device__ __forceinline__ void run_gemm_split(char* shm, const bf16_t* A, int lda, const bf16_t* Bt, int ldb, int K, int pm0, int nMs, int nN, int NS, const Epi& E, int krev = 0) {
  pg8::Gemm g; g.A = A; g.Bt = Bt; g.lda = lda; g.ldb = ldb; g.K = K / NS; g.nM = nMs; g.nN = nN; g.krev = krev;
  pg8::SplitOrder S; S.init(pm0, nMs, nN, NS, K / NS, gridDim.x, blockIdx.x);
  __syncthreads();
  pg8::gemm_phase<Epi, pg8::SplitOrder>((LAS unsigned char*)shm, g, S, E);
}

#ifndef NO_MEGA
__global__ void __launch_bounds__(512, 2) fwd_megakernel(Params p) {
  extern __shared__ __attribute__((aligned(16))) char shm[];
  cg::grid_group grid = cg::this_grid();
  char* ws = p.ws;
  const float* modv = (const float*)(ws + OFF_MODV);
  bf16_t* X = (bf16_t*)(ws + OFF_X);
  bf16_t* H = (bf16_t*)(ws + OFF_H);

  volatile LAS unsigned* xst = (volatile LAS unsigned*)((LAS char*)shm + (LDS_BYTES - 16));
  if (threadIdx.x == 0) { xst[0] = 0u; xst[1] = 0u; }
  __syncthreads();
  const XcdBarrier xbar = xcd_barrier_post((unsigned*)(ws + OFF_BAR), xst);
  phase0(p, shm);
  grid.sync();
  norm_rows<0, false, true, true>(p.in[0], p.in[2] - (size_t)ML * DM, MT, p.in[6], modv + 0 * DM, modv + 1 * DM, H);
  xcd_barrier(xbar);
  { pg8::EpiBf16<0> E; E.O = (bf16_t*)(ws + OFF_P); E.ldc = ABIN;
    run_gemm(shm, H, DM, (const bf16_t*)(ws + OFF_WIN), DM, DM, MT / 256, ABIN / 256, E); }
  if (gridDim.x == 256) xpose_deferred(p, shm, N_EARLY, N_SLOTA_END, 160);
  xcd_barrier(xbar);
  { const int nxb = (gridDim.x == 256) ? (N_SLOTB_END - N_SLOTA_END) : 0;
    const int tid0 = otid();
    for (int t = blockIdx.x; t < 512 + 64 + 1152 + nxb; t += gridDim.x) {
      if (t < 512) na_task(p, t, shm);
      else if (t < 576) ctxattn_task(p, t - 512, shm);
      else if (t < 1728) lru_task<1>(p, t - 576, shm);
      else { __syncthreads(); xpose_tile(p, N_SLOTA_END + (t - 1728), (float*)shm, tid0); }
    } }
  xcd_barrier(xbar);
  for (int t = blockIdx.x; t < 1152; t += gridDim.x) lru_task<2>(p, t, shm);
  xcd_barrier(xbar);
  { pg8::EpiResid<true> E; E.xin = p.in[0]; E.xout = X; E.gate = modv + 2 * DM;
    run_gemm(shm, (const bf16_t*)(ws + OFF_MIX), DM, (const bf16_t*)(ws + OFF_WOUT), DM, DM, ML / 256, DM / 256, E); }
  { pg8::EpiPartial E; E.part = (float*)(ws + OFF_PART); E.gate = modv + 2 * DM; E.kp2 = (DM / 4) * 2;
    run_gemm_split(shm, (const bf16_t*)(ws + OFF_MIX), DM, (const bf16_t*)(ws + OFF_WOUT), DM, DM, ML / 256, MC / 256, DM / 256, 4, E); }
  xcd_barrier(xbar);
  norm_rows<0, true, false, true>(X, p.in[2] - (size_t)ML * DM, MT, p.in[7], modv + 3 * DM, modv + 4 * DM, H, X, (const float*)(ws + OFF_PART));
  xcd_barrier(xbar);
  { pg8::EpiBf16<1> E; E.O = (bf16_t*)(ws + OFF_HID); E.ldc = DFF;
    run_gemm(shm, H, DM, (const bf16_t*)(ws + OFF_W1), DM, DM, MT / 256, DFF / 256, E); }
  xcd_barrier(xbar);
  { pg8::EpiResid<false> E; E.xin = X; E.xout = X; E.gate = modv + 5 * DM;
    run_gemm(shm, (const bf16_t*)(ws + OFF_HID), DFF, (const bf16_t*)(ws + OFF_W2), DFF, DFF, ML / 256, DM / 256, E, 1); }
  { pg8::EpiPartial E; E.part = (float*)(ws + OFF_PART); E.gate = modv + 5 * DM; E.kp2 = (DFF / 4) * 2;
    run_gemm_split(shm, (const bf16_t*)(ws + OFF_HID), DFF, (const bf16_t*)(ws + OFF_W2), DFF, DFF, ML / 256, MC / 256, DM / 256, 4, E, 1); }
  xcd_barrier(xbar);
  const float* modv1 = modv + (size_t)9 * NMOD6;
  norm_rows<0, true, false, false>(X, X, MT, p.in[6] + DM, modv1 + 0 * DM, modv1 + 1 * DM, H, X, (const float*)(ws + OFF_PART));
  xcd_barrier(xbar);
  { pg8::EpiBf16<0> E; E.O = (bf16_t*)(ws + OFF_QA); E.ldc = 1280;
    run_gemm(shm, H, DM, (const bf16_t*)(ws + OFF_WD), DM, DM, MT / 256, 1280 / 256, E); }
  if (gridDim.x == 256) xpose_deferred(p, shm, N_SLOTB_END, N_XT, 104);
  xcd_barrier(xbar);
  mla_norm_rows(p);
  xcd_barrier(xbar);
  { pg8::EpiBf16<0> E; E.O = (bf16_t*)(ws + OFF_Q); E.ldc = 3072;
    run_gemm(shm, (const bf16_t*)(ws + OFF_QN), 512, (const bf16_t*)(ws + OFF_WUQ), 512, 512, ML / 256, 3072 / 256, E); }
  { pg8::EpiBf16<0> E; E.O = (bf16_t*)(ws + OFF_KV); E.ldc = 4096;
    run_gemm(shm, (const bf16_t*)(ws + OFF_CKVN), 512, (const bf16_t*)(ws + OFF_WUKV), 512, 512, MT / 256, 4096 / 256, E); }
  xcd_barrier(xbar);
  for (int t = blockIdx.x; t < 1024; t += gridDim.x) mla_task(p, t, shm);
  xcd_barrier(xbar);
  { pg8::EpiResid<false> E; E.xin = X; E.xout = X; E.gate = modv1 + 2 * DM;
    run_gemm(shm, H, DM, (const bf16_t*)(ws + OFF_WO), DM, DM, ML / 256, DM / 256, E); }
  xcd_barrier(xbar);
  norm_rows<0, false, false, false>(X, X, ML, p.in[7] + DM, modv1 + 3 * DM, modv1 + 4 * DM, H);
  xcd_barrier(xbar);
  { pg8::EpiBf16<1> E; E.O = (bf16_t*)(ws + OFF_HID); E.ldc = DFF;
    run_gemm(shm, H, DM, (const bf16_t*)(ws + OFF_W1 + (size_t)8192 * 2048 * 2), DM, DM, ML / 256, DFF / 256, E); }
  xcd_barrier(xbar);
  { pg8::EpiResid<false> E; E.xin = X; E.xout = X; E.gate = modv1 + 5 * DM;
    run_gemm(shm, (const bf16_t*)(ws + OFF_HID), DFF, (const bf16_t*)(ws + OFF_W2 + (size_t)2048 * 8192 * 2), DFF, DFF, ML / 256, DM / 256, E, 1); }
  xcd_barrier(xbar);
  norm_rows<1, false, false, false>(X, X, ML, p.in[27], nullptr, nullptr, p.out);
}

extern "C" void kernel_launch(void* const* d_in, const int* in_sizes, int n_in, void* d_out, int out_size, void* d_ws, size_t ws_size, hipStream_t stream) {
  static int grid_blocks = 0;
  if (!grid_blocks) {
    if (n_in != 28 || ws_size < WS_NEED || out_size != ML * DM) { fprintf(stderr, "kernel_launch: unexpected shapes (n_in %d, ws %zu need %zu, out %d)\n", n_in, ws_size, (size_t)WS_NEED, out_size); return; }
    if (hipFuncSetAttribute((const void*)fwd_megakernel, hipFuncAttributeMaxDynamicSharedMemorySize, LDS_BYTES) != hipSuccess) { fprintf(stderr, "kernel_launch: LDS attribute failed\n"); return; }
    int dev = 0, cus = 0, per_cu = 0;
    hipGetDevice(&dev);
    hipDeviceGetAttribute(&cus, hipDeviceAttributeMultiprocessorCount, dev);
    hipOccupancyMaxActiveBlocksPerMultiprocessor(&per_cu, fwd_megakernel, 512, LDS_BYTES);
    if (per_cu < 1) { fprintf(stderr, "kernel_launch: occupancy query gave %d\n", per_cu); return; }
    grid_blocks = cus;
  }
  Params p{};
  for (int i = 0; i < 28; ++i) p.in[i] = (const float*)d_in[i];
  p.out = (float*)d_out; p.ws = (char*)d_ws;
  for (int i = 0; i < 16; ++i) p.inv[i] = (float)pow(10000.0, -(double)i / 16.0);
  hipMemsetAsync((char*)d_ws + OFF_BAR, 0, 16384, stream);
  void* args[] = {&p};
  hipError_t e = hipLaunchCooperativeKernel((void*)fwd_megakernel, dim3(grid_blocks), dim3(512), args, LDS_BYTES, stream);
  if (e != hipSuccess) fprintf(stderr, "cooperative launch failed: %s (grid %d)\n", hipGetErrorString(e), grid_blocks);
}
#endif
```

```cpp
#include <hip/hip_runtime.h>
#include <hip/hip_cooperative_groups.h>
#include <cstdio>
#include <cmath>
#include <cstdint>
namespace cg = cooperative_groups;

#define LAS __attribute__((address_space(3)))
typedef unsigned short bf16_t;
typedef short bf16x8 __attribute__((ext_vector_type(8)));
typedef short s16x4 __attribute__((ext_vector_type(4)));
typedef float f32x4 __attribute__((ext_vector_type(4)));
typedef float f32x2 __attribute__((ext_vector_type(2)));
typedef float f32x16 __attribute__((ext_vector_type(16)));
typedef unsigned u32x4 __attribute__((ext_vector_type(4)));
typedef unsigned u32x2 __attribute__((ext_vector_type(2)));

constexpr int DM = 2048, NBATCH = 8, SEQ = 2048, CTXL = 256, ML = NBATCH * SEQ, MC = NBATCH * CTXL, MT = ML + MC;
constexpr int DFF = 8192, ABIN = 5120, NMOD6 = 6 * DM;
constexpr int LDS_BYTES = 155648;

constexpr size_t OFF_WIN  = 0;
constexpr size_t OFF_WOUT = OFF_WIN  + (size_t)5120 * 2048 * 2;
constexpr size_t OFF_W1   = OFF_WOUT + (size_t)2048 * 2048 * 2;
constexpr size_t OFF_W2   = OFF_W1   + (size_t)2 * 8192 * 2048 * 2;
constexpr size_t OFF_WD   = OFF_W2   + (size_t)2 * 2048 * 8192 * 2;
constexpr size_t OFF_WUQ  = OFF_WD   + (size_t)1280 * 2048 * 2;
constexpr size_t OFF_WUKV = OFF_WUQ  + (size_t)3072 * 512 * 2;
constexpr size_t OFF_WO   = OFF_WUKV + (size_t)4096 * 512 * 2;
constexpr size_t OFF_WL   = OFF_WO   + (size_t)2048 * 2048 * 2;
constexpr size_t OFF_MODV = OFF_WL   + (size_t)8 * 512 * 128 * 2;
constexpr size_t OFF_ROPE = OFF_MODV + (size_t)2 * 9 * NMOD6 * 4;
constexpr size_t OFF_LSUM = OFF_ROPE + (size_t)64 * 16 * 2 * 4;
constexpr size_t OFF_X    = OFF_LSUM + (size_t)8 * 8 * 18 * 2 * 128 * 2 * 4;
constexpr size_t OFF_H    = OFF_X    + (size_t)MT * DM * 4;
constexpr size_t OFF_R    = OFF_H    + (size_t)MT * DM * 2;
constexpr size_t OFF_P    = OFF_R;
constexpr size_t OFF_MIX  = OFF_R + (size_t)MT * ABIN * 2;
constexpr size_t OFF_QA   = OFF_R;
constexpr size_t OFF_QN   = OFF_QA   + (size_t)MT * 1280 * 2;
constexpr size_t OFF_CKVN = OFF_QN   + (size_t)ML * 512 * 2;
constexpr size_t OFF_KPE  = OFF_CKVN + (size_t)MT * 512 * 2;
constexpr size_t OFF_Q    = OFF_KPE  + (size_t)MT * 64 * 2;
constexpr size_t OFF_KV   = OFF_Q    + (size_t)ML * 3072 * 2;
constexpr size_t WS_END   = OFF_KV   + (size_t)MT * 4096 * 2;
constexpr size_t OFF_HID  = OFF_R;
constexpr size_t OFF_PART = OFF_R + (size_t)MT * DFF * 2;
constexpr size_t OFF_BAR  = OFF_PART + (size_t)4 * MC * DM * 4;
constexpr size_t WS_NEED  = OFF_BAR + 16384;

struct Params {
  const float* in[28];
  float* out;
  char* ws;
  float inv[16];
};

__device__ __forceinline__ unsigned cvt_pk_bf16(float lo, float hi) { unsigned r; asm volatile("v_cvt_pk_bf16_f32 %0, %1, %2" : "=v"(r) : "v"(lo), "v"(hi)); return r; }
__device__ __forceinline__ float bf2f(bf16_t b) { return __uint_as_float(((unsigned)b) << 16); }
__device__ __forceinline__ float bflo(unsigned w) { return __uint_as_float(w << 16); }
__device__ __forceinline__ float bfhi(unsigned w) { return __uint_as_float(w & 0xffff0000u); }
__device__ __forceinline__ float wave_sum(float v) {
#pragma unroll
  for (int o = 32; o >= 1; o >>= 1) v += __shfl_xor(v, o, 64);
  return v;
}
__device__ __forceinline__ int otid() { int t = threadIdx.x; asm volatile("" : "+v"(t)); return t; }
__device__ __forceinline__ float sigmoidf_(float x) { return 1.f / (1.f + __expf(-x)); }

namespace pg8 {
constexpr int BM = 256, BK = 64, HALF = 128, HTB = HALF * BK * 2, NXCD = 8, WGM = 8;
__device__ __forceinline__ int lds_byte(int r, int c) { const int st = (r >> 4) * 2 + (c >> 5), rr = r & 15, cc = c & 31, ob = rr * 64 + cc * 2; return st * 1024 + (ob ^ (((ob >> 9) & 1) << 5)); }
__device__ __forceinline__ void stage_rc(int b, int& R, int& C) { const int st = b / 1024, sb = b % 1024, swz = sb ^ (((sb >> 9) & 1) << 5); R = (st >> 1) * 16 + swz / 64; C = (st & 1) * 32 + (swz % 64) / 2; }
__device__ __forceinline__ int perm32(int rho) { const int n = rho >> 4, i = rho & 15; return 8 * (i >> 2) + 4 * n + (i & 3); }
struct Unit { int pm, pn, kb, kr; };
struct Gemm { const bf16_t* A; const bf16_t* Bt; int lda, ldb, K, nM, nN; int krev = 0; };
struct StaticOrder {
  int nM, nN, nwg, G, c; int kmode = 0;
  __device__ void init(int nM_, int nN_, int G_, int c_) { nM = nM_; nN = nN_; nwg = nM * nN; G = G_; c = c_; }
  __device__ bool next(int i, Unit& u) const {
    const long L = (long)i * G + c; if (L >= nwg) return false;
    int wgid = (int)L; { const int q = nwg / NXCD, r = nwg % NXCD, xcd = wgid % NXCD, off = wgid / NXCD; wgid = (xcd < r ? xcd * (q + 1) : r * (q + 1) + (xcd - r) * q) + off; }
    const int nig = WGM * nN, gid = wgid / nig, fm = gid * WGM, gsz = (nM - fm) < WGM ? (nM - fm) : WGM;
    u.pm = fm + ((wgid % nig) % gsz); u.pn = (wgid % nig) / gsz; u.kb = 0; u.kr = (kmode == 2) ? ((i & 1) ^ 1) : kmode; return true;
  }
};
struct SplitOrder {
  int pm0, nMs, nN, NS, Kp, nwg, G, c; int kmode = 0;
  __device__ void init(int pm0_, int nMs_, int nN_, int NS_, int Kp_, int G_, int c_) { pm0 = pm0_; nMs = nMs_; nN = nN_; NS = NS_; Kp = Kp_; nwg = nMs * nN * NS; G = G_; c = c_; }
  __device__ bool next(int i, Unit& u) const {
    const long L = (long)i * G + c; if (L >= nwg) return false;
    const int l = (int)L; const int part = l % NS, tile = l / NS;
    u.pm = pm0 + tile % nMs; u.pn = tile / nMs; u.kb = part * Kp * 2; u.kr = kmode ? 1 : 0; return true;
  }
};

template <class Epi, class Sched, bool ALIGN_EPI = true>
__device__ __forceinline__ void gemm_phase(LAS unsigned char* lds, const Gemm g, const Sched& S, const Epi& E) {
  const int tid = otid(), wid = __builtin_amdgcn_readfirstlane(tid >> 6), lane = tid & 63, wr = wid >> 2, wc = wid & 3, fr = lane & 15, fq = lane >> 4;
  const int K = g.K, nt = K / BK;
  unsigned voffA[2], voffB[2];
#pragma unroll
  for (int i = 0; i < 2; ++i) { int R, C; stage_rc(tid * 16 + i * 8192, R, C); const int Rb = Epi::PERM ? ((R & ~31) + perm32(R & 31)) : R;
    voffA[i] = (unsigned)(R * g.lda + C) * 2u; voffB[i] = (unsigned)(Rb * g.ldb + C) * 2u; }
  const size_t koffL = (size_t)(nt - 1) * (BK * 2);
  const size_t hstepA = (size_t)HALF * g.lda * 2, hstepB = (size_t)HALF * g.ldb * 2;
  const size_t tstepA = 2 * hstepA, tstepB = 2 * hstepB;
  const unsigned ldsw = (unsigned)wid * 1024u;
  const int aoff = lds_byte(wr * 64 + fr, fq * 8), boff = lds_byte(wc * 32 + fr, fq * 8);
#define PG8_SA(b, h) (((b) * 2 + (h)) * HTB)
#define PG8_SB(b, h) ((4 + (b) * 2 + (h)) * HTB)
#define PG8_STAGE(bufoff, gbase, voff) do { _Pragma("unroll") for (int _i = 0; _i < 2; ++_i) \
    __builtin_amdgcn_global_load_lds((const unsigned*)((const char*)(gbase) + (voff)[_i]), (LAS unsigned*)(lds + (bufoff) + ldsw + _i * 8192), 16, 0, 0); } while (0)
#define PG8_LDA(dst, b, h) do { _Pragma("unroll") for (int m = 0; m < 4; ++m) _Pragma("unroll") for (int k = 0; k < 2; ++k) dst[m][k] = *(const LAS bf16x8*)(lds + PG8_SA(b, h) + aoff + m * 2048 + k * 1024); } while (0)
#define PG8_LDB(dst, b, h) do { _Pragma("unroll") for (int n = 0; n < 2; ++n) _Pragma("unroll") for (int k = 0; k < 2; ++k) dst[n][k] = *(const LAS bf16x8*)(lds + PG8_SB(b, h) + boff + n * 2048 + k * 1024); } while (0)
#define PG8_MMA(ai, bj, At, Bt) do { __builtin_amdgcn_s_setprio(1); _Pragma("unroll") for (int m = 0; m < 4; ++m) _Pragma("unroll") for (int n = 0; n < 2; ++n) _Pragma("unroll") for (int k = 0; k < 2; ++k) \
    acc[ai][bj][m][n] = __builtin_amdgcn_mfma_f32_16x16x32_bf16(Bt[n][k], At[m][k], acc[ai][bj][m][n], 0, 0, 0); __builtin_amdgcn_s_setprio(0); } while (0)
#define PG8_WAIT_V(n) asm volatile("s_waitcnt vmcnt(" #n ")" ::: "memory")
#define PG8_WAIT_L(n) asm volatile("s_waitcnt lgkmcnt(" #n ")" ::: "memory")
#define PG8_BAR __builtin_amdgcn_s_barrier()
#define PG8_SCHED __builtin_amdgcn_sched_barrier(0)
  Unit cur, nxt; int ui = 0;
  if (!S.next(0, cur)) return;
  f32x4 acc[2][2][4][2];
#pragma unroll
  for (int a = 0; a < 2; ++a)
#pragma unroll
    for (int b = 0; b < 2; ++b)
#pragma unroll
      for (int m = 0; m < 4; ++m)
#pragma unroll
        for (int n = 0; n < 2; ++n) acc[a][b][m][n] = (f32x4){0.f, 0.f, 0.f, 0.f};
  bf16x8 At[4][2], B0[2][2], B1[2][2];
  ptrdiff_t kstep = cur.kr ? -(ptrdiff_t)(BK * 2) : (ptrdiff_t)(BK * 2);
  const char* cA = (const char*)g.A + (size_t)cur.pm * tstepA + cur.kb + (cur.kr ? koffL : 0); const char* cB = (const char*)g.Bt + (size_t)cur.pn * tstepB + cur.kb + (cur.kr ? koffL : 0);
  PG8_STAGE(PG8_SB(0, 0), cB, voffB); PG8_STAGE(PG8_SB(0, 1), cB + hstepB, voffB); PG8_STAGE(PG8_SA(0, 0), cA, voffA); PG8_STAGE(PG8_SA(0, 1), cA + hstepA, voffA);
  if (wr == 1) PG8_BAR;
  PG8_WAIT_V(2); PG8_BAR;
  PG8_STAGE(PG8_SB(1, 0), cB + kstep, voffB); PG8_STAGE(PG8_SA(1, 0), cA + kstep, voffA); PG8_STAGE(PG8_SB(1, 1), cB + hstepB + kstep, voffB);
  PG8_WAIT_V(6); PG8_BAR;
  for (;;) {
    const bool has_next = S.next(ui + 1, nxt);
    const ptrdiff_t kstepN = has_next ? (nxt.kr ? -(ptrdiff_t)(BK * 2) : (ptrdiff_t)(BK * 2)) : kstep;
    const char* nA = has_next ? (const char*)g.A + (size_t)nxt.pm * tstepA + nxt.kb + (nxt.kr ? koffL : 0) : cA; const char* nB = has_next ? (const char*)g.Bt + (size_t)nxt.pn * tstepB + nxt.kb + (nxt.kr ? koffL : 0) : cB;
    for (int t = 0; t < nt; t += 2) {
      const bool last = (t == nt - 2);
      const char* a1 = cA + (ptrdiff_t)(t + 1) * kstep;
      const char* a2 = last ? nA : cA + (ptrdiff_t)(t + 2) * kstep; const char* b2 = last ? nB : cB + (ptrdiff_t)(t + 2) * kstep;
      const char* a3 = a2 + (last ? kstepN : kstep); const char* b3 = b2 + (last ? kstepN : kstep);
      PG8_LDB(B0, 0, 0); PG8_LDB(B1, 0, 1); PG8_SCHED; PG8_LDA(At, 0, 0); PG8_STAGE(PG8_SA(1, 1), a1 + hstepA, voffA);
      PG8_WAIT_V(8); PG8_WAIT_L(0); PG8_BAR; PG8_MMA(0, 0, At, B0); PG8_MMA(0, 1, At, B1); PG8_BAR; PG8_SCHED;
      PG8_LDA(At, 0, 1); PG8_STAGE(PG8_SB(0, 0), b2, voffB); PG8_STAGE(PG8_SB(0, 1), b2 + hstepB, voffB); PG8_STAGE(PG8_SA(0, 0), a2, voffA);
      PG8_WAIT_V(8); PG8_WAIT_L(0); PG8_BAR; PG8_MMA(1, 0, At, B0); PG8_MMA(1, 1, At, B1); PG8_BAR; PG8_SCHED;
      PG8_LDB(B0, 1, 0); PG8_LDB(B1, 1, 1); PG8_SCHED; PG8_LDA(At, 1, 0); PG8_STAGE(PG8_SA(0, 1), a2 + hstepA, voffA);
      PG8_WAIT_V(8); PG8_WAIT_L(0); PG8_BAR; PG8_MMA(0, 0, At, B0); PG8_MMA(0, 1, At, B1); PG8_BAR; PG8_SCHED;
      PG8_LDA(At, 1, 1); PG8_STAGE(PG8_SB(1, 0), b3, voffB); PG8_STAGE(PG8_SB(1, 1), b3 + hstepB, voffB); PG8_STAGE(PG8_SA(1, 0), a3, voffA);
      PG8_WAIT_V(8); PG8_WAIT_L(0); PG8_BAR; PG8_MMA(1, 0, At, B0); PG8_MMA(1, 1, At, B1); PG8_BAR; PG8_SCHED;
    }
    if constexpr (ALIGN_EPI) { if (wr == 0) PG8_BAR; }
    E(acc, cur, wr, wc, fr, fq);
    if (!has_next) break;
#pragma unroll
    for (int a = 0; a < 2; ++a)
#pragma unroll
      for (int b = 0; b < 2; ++b)
#pragma unroll
        for (int m = 0; m < 4; ++m)
#pragma unroll
          for (int n = 0; n < 2; ++n) acc[a][b][m][n] = (f32x4){0.f, 0.f, 0.f, 0.f};
    cur = nxt; cA = nA; cB = nB; kstep = kstepN; ++ui;
    if constexpr (ALIGN_EPI) { if (wr == 1) PG8_BAR; }
  }
  PG8_WAIT_V(0);
  if constexpr (!ALIGN_EPI) { if (wr == 0) PG8_BAR; }
  PG8_BAR;
#undef PG8_SA
#undef PG8_SB
#undef PG8_STAGE
#undef PG8_LDA
#undef PG8_LDB
#undef PG8_MMA
#undef PG8_WAIT_V
#undef PG8_WAIT_L
#undef PG8_BAR
#undef PG8_SCHED
}

template <int ACT  > struct EpiBf16 {
  static constexpr bool PERM = true;
  bf16_t* O; int ldc;
  __device__ __forceinline__ void operator()(const f32x4 (&acc)[2][2][4][2], const Unit& u, int wr, int wc, int fr, int fq) const {
    const int row0 = u.pm * BM + wr * 64 + fr, col0 = u.pn * BM + wc * 32 + 8 * fq;
#pragma unroll
    for (int ai = 0; ai < 2; ++ai)
#pragma unroll
      for (int m = 0; m < 4; ++m) { bf16_t* rowp = O + (size_t)(row0 + ai * HALF + m * 16) * ldc + col0;
#pragma unroll
        for (int bj = 0; bj < 2; ++bj) { f32x4 v0 = acc[ai][bj][m][0], v1 = acc[ai][bj][m][1];
          if (ACT == 1) {
#pragma unroll
            for (int j = 0; j < 4; ++j) { float a = fmaxf(v0[j], 0.f), b = fmaxf(v1[j], 0.f); v0[j] = a * a; v1[j] = b * b; } }
          u32x4 w; w.x = cvt_pk_bf16(v0[0], v0[1]); w.y = cvt_pk_bf16(v0[2], v0[3]); w.z = cvt_pk_bf16(v1[0], v1[1]); w.w = cvt_pk_bf16(v1[2], v1[3]);
          *(u32x4*)(rowp + bj * HALF) = w; } }
  }
};
template <bool XIN_F32> struct EpiResid {
  static constexpr bool PERM = true;
  const void* xin; bf16_t* xout; const float* gate;
  __device__ __forceinline__ void operator()(const f32x4 (&acc)[2][2][4][2], const Unit& u, int wr, int wc, int fr, int fq) const {
    const int rowt = u.pm * BM; const int b = rowt >> 11;
    const int row0 = rowt + wr * 64 + fr, col0 = u.pn * BM + wc * 32 + 8 * fq;
    f32x4 gv[2][2];
#pragma unroll
    for (int bj = 0; bj < 2; ++bj)
#pragma unroll
      for (int n = 0; n < 2; ++n) gv[bj][n] = *(const f32x4*)(gate + (size_t)b * NMOD6 + col0 + bj * HALF + 4 * n);
#pragma unroll
    for (int ai = 0; ai < 2; ++ai)
#pragma unroll
      for (int m = 0; m < 4; ++m) { const size_t ro = (size_t)(row0 + ai * HALF + m * 16) * DM + col0;
#pragma unroll
        for (int bj = 0; bj < 2; ++bj) { f32x4 x0, x1;
          if constexpr (XIN_F32) { x0 = *(const f32x4*)((const float*)xin + ro + bj * HALF); x1 = *(const f32x4*)((const float*)xin + ro + bj * HALF + 4); }
          else { const u32x4 w = *(const u32x4*)((const bf16_t*)xin + ro + bj * HALF);
            x0 = (f32x4){bflo(w.x), bfhi(w.x), bflo(w.y), bfhi(w.y)}; x1 = (f32x4){bflo(w.z), bfhi(w.z), bflo(w.w), bfhi(w.w)}; }
          const f32x4 v0 = x0 + gv[bj][0] * acc[ai][bj][m][0], v1 = x1 + gv[bj][1] * acc[ai][bj][m][1];
          u32x4 o; o.x = cvt_pk_bf16(v0[0], v0[1]); o.y = cvt_pk_bf16(v0[2], v0[3]); o.z = cvt_pk_bf16(v1[0], v1[1]); o.w = cvt_pk_bf16(v1[2], v1[3]);
          *(u32x4*)(xout + ro + bj * HALF) = o; } }
  }
};
struct EpiPartial {
  static constexpr bool PERM = false;
  float* part; const float* gate; int kp2;
  __device__ __forceinline__ void operator()(const f32x4 (&acc)[2][2][4][2], const Unit& u, int wr, int wc, int fr, int fq) const {
    const int row0 = u.pm * BM - ML + wr * 64 + fr, col0 = u.pn * BM + wc * 32 + 4 * fq;
    float* base = part + (size_t)(u.kb / kp2) * MC * DM;
    f32x4 gv[2][2];
#pragma unroll
    for (int bj = 0; bj < 2; ++bj)
#pragma unroll
      for (int n = 0; n < 2; ++n) gv[bj][n] = *(const f32x4*)(gate + (size_t)8 * NMOD6 + col0 + bj * HALF + n * 16);
#pragma unroll
    for (int ai = 0; ai < 2; ++ai)
#pragma unroll
      for (int m = 0; m < 4; ++m) { const size_t ro = (size_t)(row0 + ai * HALF + m * 16) * DM + col0;
#pragma unroll
        for (int bj = 0; bj < 2; ++bj)
#pragma unroll
          for (int n = 0; n < 2; ++n) *(f32x4*)(base + ro + bj * HALF + n * 16) = gv[bj][n] * acc[ai][bj][m][n]; }
  }
};
}

namespace att {
constexpr int NW = 8, QBLK = 32, KVBLK = 64;
constexpr size_t SHM_V = KVBLK * 128 * 2;
#define SBAR() __builtin_amdgcn_sched_barrier(0)
__device__ __forceinline__ int crow(int r, int hi) { return (r & 3) + 8 * (r >> 2) + 4 * hi; }

__device__ __forceinline__ void partialSM(f32x16& p0, f32x16& p1, float& m_reg, float& mn, float& alpha, const float C, const float THRS) {
  float pmax = p0[0];
#pragma unroll
  for (int r = 1; r < 16; ++r) pmax = fmaxf(pmax, p0[r]);
#pragma unroll
  for (int r = 0; r < 16; ++r) pmax = fmaxf(pmax, p1[r]);
  { auto rr = __builtin_amdgcn_permlane32_swap(__float_as_uint(pmax), __float_as_uint(pmax), false, false);
    pmax = fmaxf(__uint_as_float(rr[0]), __uint_as_float(rr[1])); }
  if (__builtin_expect(__all(pmax - m_reg <= THRS), 1)) { mn = m_reg; alpha = 1.f; }
  else { mn = fmaxf(m_reg, pmax); alpha = __builtin_amdgcn_exp2f((m_reg - mn) * C); m_reg = mn; }
  float mnC = -mn * C;
#pragma unroll
  for (int r = 0; r < 16; ++r) p0[r] = fmaf(p0[r], C, mnC);
#pragma unroll
  for (int r = 0; r < 16; ++r) p1[r] = fmaf(p1[r], C, mnC);
#pragma unroll
  for (int r = 0; r < 16; ++r) p0[r] = __builtin_amdgcn_exp2f(p0[r]);
}
__device__ __forceinline__ void finishSM(f32x16& p0, f32x16& p1, float alpha, float& l_reg, bf16x8& pa0, bf16x8& pa1, bf16x8& pa2, bf16x8& pa3) {
#pragma unroll
  for (int r = 0; r < 16; ++r) p1[r] = __builtin_amdgcn_exp2f(p1[r]);
  float ps = 0;
#pragma unroll
  for (int r = 0; r < 16; ++r) ps += p0[r];
#pragma unroll
  for (int r = 0; r < 16; ++r) ps += p1[r];
  { auto rr = __builtin_amdgcn_permlane32_swap(__float_as_uint(ps), __float_as_uint(ps), false, false);
    ps = __uint_as_float(rr[0]) + __uint_as_float(rr[1]); }
  l_reg = l_reg * alpha + ps;
#define PK4(P, BASE, OUT) do { unsigned a0 = cvt_pk_bf16(P[BASE + 0], P[BASE + 1]), a1 = cvt_pk_bf16(P[BASE + 2], P[BASE + 3]);   \
    unsigned b0 = cvt_pk_bf16(P[BASE + 4], P[BASE + 5]), b1 = cvt_pk_bf16(P[BASE + 6], P[BASE + 7]);                              \
    auto r0 = __builtin_amdgcn_permlane32_swap(a0, b0, false, false); auto r1 = __builtin_amdgcn_permlane32_swap(a1, b1, false, false); \
    u32x4 w = {r0[0], r1[0], r0[1], r1[1]}; OUT = *reinterpret_cast<bf16x8*>(&w); } while (0)
  PK4(p0, 0, pa0); PK4(p0, 8, pa1); PK4(p1, 0, pa2); PK4(p1, 8, pa3);
#undef PK4
}
template <int DQK>
__device__ __forceinline__ void qkt(f32x16& p0, f32x16& p1, const char* Ks, const bf16x8* qr, const char* ql, int r32, int hi) {
  p0 = f32x16{}; p1 = f32x16{};
#pragma unroll
  for (int d0 = 0; d0 < DQK / 16; ++d0) { const int cb = (d0 * 16 + hi * 8) * 2;
    bf16x8 b0 = *reinterpret_cast<const bf16x8*>(Ks + r32 * (DQK * 2) + (cb ^ ((r32 & 7) << 4)));
    bf16x8 b1 = *reinterpret_cast<const bf16x8*>(Ks + (32 + r32) * (DQK * 2) + (cb ^ ((r32 & 7) << 4)));
    constexpr int NQR = DQK == 192 ? 4 : 8;
    bf16x8 qv; if (d0 < NQR) qv = qr[d0 < NQR ? d0 : 0]; else qv = *reinterpret_cast<const bf16x8*>(ql + (d0 - NQR) * 1024);
    p0 = __builtin_amdgcn_mfma_f32_32x32x16_bf16(b0, qv, p0, 0, 0, 0);
    p1 = __builtin_amdgcn_mfma_f32_32x32x16_bf16(b1, qv, p1, 0, 0, 0); }
}
__device__ __forceinline__ int v_st(int k, int c) { const int kk = (k & ~0xC) | ((k & 4) << 1) | ((k & 8) >> 1); return ((kk >> 3) * 4 + (c >> 5)) * 512 + ((kk & 7) * 32 + (c & 31)) * 2; }
__device__ __forceinline__ int v_rd_base(int lane) { return ((lane & 3) << 3) | (((lane >> 2) & 3) << 6) | (((lane >> 4) & 1) << 5) | (((lane >> 5) & 1) << 8); }
constexpr int v_rd_off(int d0, int ks, int half) { return d0 * 512 + ks * 4096 + half * 2048; }
template <int OFF> __device__ __forceinline__ s16x4 tr_read(int vb) {
  s16x4 r; asm volatile("ds_read_b64_tr_b16 %0, %1 offset:%2" : "=&v"(r) : "v"(vb), "i"(OFF) : "memory"); return r;
}
template <int D0> __device__ __forceinline__ void pv_one(f32x16& od, int vb, bf16x8 pa0, bf16x8 pa1, bf16x8 pa2, bf16x8 pa3) {
  const s16x4 l0 = tr_read<v_rd_off(D0, 0, 0)>(vb), h0 = tr_read<v_rd_off(D0, 0, 1)>(vb), l1 = tr_read<v_rd_off(D0, 1, 0)>(vb), h1 = tr_read<v_rd_off(D0, 1, 1)>(vb);
  const s16x4 l2 = tr_read<v_rd_off(D0, 2, 0)>(vb), h2 = tr_read<v_rd_off(D0, 2, 1)>(vb), l3 = tr_read<v_rd_off(D0, 3, 0)>(vb), h3 = tr_read<v_rd_off(D0, 3, 1)>(vb);
  asm volatile("s_waitcnt lgkmcnt(0)" ::: "memory"); SBAR();
#define PK(L, H) (bf16x8){L[0], L[1], L[2], L[3], H[0], H[1], H[2], H[3]}
  od = __builtin_amdgcn_mfma_f32_32x32x16_bf16(pa0, PK(l0, h0), od, 0, 0, 0);
  od = __builtin_amdgcn_mfma_f32_32x32x16_bf16(pa1, PK(l1, h1), od, 0, 0, 0);
  od = __builtin_amdgcn_mfma_f32_32x32x16_bf16(pa2, PK(l2, h2), od, 0, 0, 0);
  od = __builtin_amdgcn_mfma_f32_32x32x16_bf16(pa3, PK(l3, h3), od, 0, 0, 0);
#undef PK
}
__device__ __forceinline__ void pv_d0(f32x16* o, int vb, bf16x8 pa0, bf16x8 pa1, bf16x8 pa2, bf16x8 pa3) {
  pv_one<0>(o[0], vb, pa0, pa1, pa2, pa3); pv_one<1>(o[1], vb, pa0, pa1, pa2, pa3); pv_one<2>(o[2], vb, pa0, pa1, pa2, pa3); pv_one<3>(o[3], vb, pa0, pa1, pa2, pa3);
}

struct Job {
  const bf16_t* Qb; int ldq;
  const bf16_t* Kb; const bf16_t* Vb; int ldk;
  const bf16_t* Pe;
  bf16_t* Ob; int ldo;
  int NT;
  int rowA, nA, rowB;
  int qb4;
  int lo, nwin;
  const float* rope; int tok0;
};

template <int MODE>
__device__ __forceinline__ void attn_body(const Job J, char* lds) {
  constexpr int DQK = (MODE == 2) ? 192 : 128;
  constexpr size_t SHM_K = KVBLK * DQK * 2;
  constexpr float SCALE = (MODE == 2) ? 0.07216878364870323f : 0.08838834764831845f;
  constexpr float C = SCALE * 1.4426950408889634f;
  constexpr float THRS = 8.f / SCALE;
  const int tid = otid(), wid = tid >> 6, lane = tid & 63, r32 = lane & 31, hi = lane >> 5;
  char* V_lds = lds; char* K_lds = lds + 2 * SHM_V;
  float* wsf = (float*)(lds + 2 * SHM_V + 2 * SHM_K) + wid * 64; float* li_l = wsf; float* al_l = wsf + 32;
  const float* tab = (const float*)(lds + 2 * SHM_V + 2 * SHM_K + NW * 256) + 64;
  constexpr int NQR = (MODE == 2) ? 4 : 8;
  float m_reg = -1e30f, l_reg = 0; f32x16 o[4] = {}; bf16x8 qr[NQR];
  const bf16_t* Qw = J.Qb + (size_t)(wid * QBLK + r32) * J.ldq + hi * 8;
  char* ql = lds + 2 * SHM_V + 2 * SHM_K + NW * 256 + (wid * 8 * 64 + lane) * 16;
#pragma unroll
  for (int d0 = 0; d0 < NQR; ++d0) qr[d0] = *reinterpret_cast<const bf16x8*>(Qw + d0 * 16);
  if constexpr (MODE == 2) {
#pragma unroll
    for (int d0 = 4; d0 < 8; ++d0) *reinterpret_cast<bf16x8*>(ql + (d0 - 4) * 1024) = *reinterpret_cast<const bf16x8*>(Qw + d0 * 16);
    const int tok = J.tok0 + wid * QBLK + r32; const int prow = tok >> 6, pcol = tok & 63;
#pragma unroll
    for (int ax = 0; ax < 2; ++ax) {
      const float* cs = J.rope + (size_t)((ax == 0 ? prow : pcol) * 16 + hi * 8) * 2;
      bf16x8 x1 = *reinterpret_cast<const bf16x8*>(Qw + (8 + 2 * ax) * 16), x2 = *reinterpret_cast<const bf16x8*>(Qw + (9 + 2 * ax) * 16); u32x4 w1, w2;
#pragma unroll
      for (int i = 0; i < 4; ++i) {
        const f32x4 t = *(const f32x4*)(cs + 4 * i);
        const float a0 = bf2f((bf16_t)x1[2 * i]), a1 = bf2f((bf16_t)x1[2 * i + 1]), b0 = bf2f((bf16_t)x2[2 * i]), b1 = bf2f((bf16_t)x2[2 * i + 1]);
        w1[i] = cvt_pk_bf16(a0 * t[0] - b0 * t[1], a1 * t[2] - b1 * t[3]);
        w2[i] = cvt_pk_bf16(a0 * t[1] + b0 * t[0], a1 * t[3] + b1 * t[2]);
      }
      *reinterpret_cast<u32x4*>(ql + (4 + 2 * ax) * 1024) = w1; *reinterpret_cast<u32x4*>(ql + (5 + 2 * ax) * 1024) = w2;
    }
  }
  const int sr = tid >> 4, sc = (tid & 15) * 8, vst0 = v_st(sr, sc), vst1 = v_st(32 + sr, sc);
  const int pr = tid >> 3, pc = (tid & 7) * 8;
  const int vb0 = (int)(uintptr_t)V_lds + v_rd_base(lane);
  bf16x8 vs0, vs1, ks0, ks1, kp;
  const int rq = J.qb4 + (wid >> 1), qc = (wid & 1) * 32 + r32;
  const int rs = min(max(rq - 4, 0), 24), cs_ = min(max(qc - 8, 0), 48);
#define TROW(t) ((t) < J.nA ? J.rowA + 64 * (t) : J.rowB + 64 * ((t) - J.nA))
#define SLOAD(t) do { const int _r0 = TROW(t); \
    vs0 = *reinterpret_cast<const bf16x8*>(J.Vb + (size_t)(_r0 + sr) * J.ldk + sc); vs1 = *reinterpret_cast<const bf16x8*>(J.Vb + (size_t)(_r0 + 32 + sr) * J.ldk + sc); \
    ks0 = *reinterpret_cast<const bf16x8*>(J.Kb + (size_t)(_r0 + sr) * J.ldk + sc); ks1 = *reinterpret_cast<const bf16x8*>(J.Kb + (size_t)(_r0 + 32 + sr) * J.ldk + sc); \
    if constexpr (MODE == 2) kp = *reinterpret_cast<const bf16x8*>(J.Pe + (size_t)(_r0 + pr) * 64 + pc); } while (0)
#define SWRITE(b) do { *(bf16x8*)(V_lds + (b) * SHM_V + vst0) = vs0; *(bf16x8*)(V_lds + (b) * SHM_V + vst1) = vs1; const int kc = sc * 2; \
    *(bf16x8*)(K_lds + (b) * SHM_K + sr * (DQK * 2) + (kc ^ ((sr & 7) << 4))) = ks0; \
    *(bf16x8*)(K_lds + (b) * SHM_K + (32 + sr) * (DQK * 2) + (kc ^ ((sr & 7) << 4))) = ks1; \
    if constexpr (MODE == 2) *(bf16x8*)(K_lds + (b) * SHM_K + pr * (DQK * 2) + (((128 + pc) * 2) ^ ((pr & 7) << 4))) = kp; } while (0)
#define SWAIT() asm volatile("s_waitcnt vmcnt(0)" ::: "memory")
#define RESC(a) do { if (__any((a) < 1.f)) { if (hi == 0) al_l[r32] = (a); asm volatile("s_waitcnt lgkmcnt(0)" ::: "memory"); \
    _Pragma("unroll") for (int d = 0; d < 4; ++d) _Pragma("unroll") for (int r = 0; r < 16; ++r) o[d][r] *= al_l[crow(r, hi)]; } } while (0)
#define MASK(P0, P1, t) do { if constexpr (MODE == 0) { if ((t) >= J.nA) { const int _w = (t) - J.nA; const int _kr = J.lo + _w; \
      if (_w < J.nwin && _kr >= rs && _kr < rs + 8) { const float* _tr = tab + (_kr - rq + 7) * 31 + 15 - qc; \
        _Pragma("unroll") for (int r = 0; r < 16; ++r) { const int kc0 = crow(r, hi); \
          const float b0 = _tr[kc0], b1 = _tr[kc0 + 32]; \
          P0[r] = ((unsigned)(kc0 - cs_) < 16u) ? P0[r] + b0 : -1e30f; P1[r] = ((unsigned)(kc0 + 32 - cs_) < 16u) ? P1[r] + b1 : -1e30f; } } \
      else { _Pragma("unroll") for (int r = 0; r < 16; ++r) { P0[r] = -1e30f; P1[r] = -1e30f; } } } } } while (0)
  f32x16 pA0, pA1, pB0, pB1; float mnA, mnB, alA, alB; bf16x8 pa0, pa1, pa2, pa3; const int NT = J.NT;
  SLOAD(0); SWAIT(); SWRITE(0); __syncthreads();
  qkt<DQK>(pA0, pA1, K_lds, qr, ql, r32, hi); MASK(pA0, pA1, 0); partialSM(pA0, pA1, m_reg, mnA, alA, C, THRS);
  SLOAD(1);
  SWAIT(); SWRITE(1); __syncthreads();
  for (int j = 1; j + 1 < NT; j += 2) {
    SBAR(); qkt<DQK>(pB0, pB1, K_lds + SHM_K, qr, ql, r32, hi);
    finishSM(pA0, pA1, alA, l_reg, pa0, pa1, pa2, pa3); SBAR();
    SLOAD(j + 1); SBAR();
    pv_d0(o, vb0, pa0, pa1, pa2, pa3); MASK(pB0, pB1, j); partialSM(pB0, pB1, m_reg, mnB, alB, C, THRS);
    __syncthreads(); SWAIT(); SWRITE(0);
    RESC(alB); __syncthreads();
    SBAR(); qkt<DQK>(pA0, pA1, K_lds, qr, ql, r32, hi);
    finishSM(pB0, pB1, alB, l_reg, pa0, pa1, pa2, pa3); SBAR();
    SLOAD(j + 2); SBAR();
    pv_d0(o, vb0 + (int)SHM_V, pa0, pa1, pa2, pa3); MASK(pA0, pA1, j + 1); partialSM(pA0, pA1, m_reg, mnA, alA, C, THRS);
    __syncthreads(); SWAIT(); SWRITE(1);
    RESC(alA); __syncthreads();
  }
  SBAR(); qkt<DQK>(pB0, pB1, K_lds + SHM_K, qr, ql, r32, hi);
  finishSM(pA0, pA1, alA, l_reg, pa0, pa1, pa2, pa3); SBAR();
  pv_d0(o, vb0, pa0, pa1, pa2, pa3); MASK(pB0, pB1, NT - 1); partialSM(pB0, pB1, m_reg, mnB, alB, C, THRS);
  __syncthreads(); RESC(alB);
  finishSM(pB0, pB1, alB, l_reg, pa0, pa1, pa2, pa3); SBAR();
  pv_d0(o, vb0 + (int)SHM_V, pa0, pa1, pa2, pa3);
  if (hi == 0) li_l[r32] = l_reg; asm volatile("s_waitcnt lgkmcnt(0)" ::: "memory");
  float rli[16];
#pragma unroll
  for (int r = 0; r < 16; ++r) rli[r] = __builtin_amdgcn_rcpf(li_l[crow(r, hi)]);
  bf16_t* Ow = J.Ob + (size_t)(wid * QBLK) * J.ldo;
#pragma unroll
  for (int r = 0; r < 16; ++r) { const int orow = crow(r, hi);
#pragma unroll
    for (int d0 = 0; d0 < 4; ++d0) Ow[(size_t)orow * J.ldo + d0 * 32 + r32] = (bf16_t)(cvt_pk_bf16(o[d0][r] * rli[r], 0.f) & 0xffffu); }
#undef TROW
#undef SLOAD
#undef SWRITE
#undef SWAIT
#undef RESC
#undef MASK
}
}

__constant__ int XJOB[11][6] = {
  {10, 0, 2048, 5120, 0, 0},
  {11, 0, 2048, 2048, 0, 640},
  {8, 0, 2048, 8192, 0, 896},
  {20, 0, 2048, 512, 0, 1920},
  {21, 0, 2048, 576, 512, 1984},
  {9, 0, 8192, 2048, 0, 2064},
  {8, 2048 * 8, 2048, 8192, 0, 3088},
  {9, 8192 * 2, 8192, 2048, 0, 4112},
  {23, 0, 512, 3072, 0, 5136},
  {25, 0, 512, 4096, 0, 5232},
  {26, 0, 2048, 2048, 0, 5360},
};
constexpr int N_XT = 5616, N_EARLY = 640, N_SLOTA_END = 2752, N_SLOTB_END = 3088, N_GEMV = 192;

__device__ __forceinline__ size_t xjob_dst(int j) {
  switch (j) {
    case 0: return OFF_WIN; case 1: return OFF_WOUT; case 2: return OFF_W1; case 3: return OFF_WD; case 4: return OFF_WD;
    case 5: return OFF_W2; case 6: return OFF_W1 + (size_t)8192 * 2048 * 2; case 7: return OFF_W2 + (size_t)2048 * 8192 * 2;
    case 8: return OFF_WUQ; case 9: return OFF_WUKV; default: return OFF_WO;
  }
}

__device__ __forceinline__ void xpose_core(const float* src, int N, bf16_t* dst, int K, int k0, int n0, float* fs, int tid);
__device__ __forceinline__ void xpose_tile(const Params& p, int tt, float* fs, int tid) {
  int j = 0;
#pragma unroll
  for (int q = 1; q < 11; ++q) if (tt >= XJOB[q][5]) j = q;
  const int K = XJOB[j][2], N = XJOB[j][3], tl = tt - XJOB[j][5];
  const int tilesN = (N + 127) / 128; const int tk = tl / tilesN, tn = tl % tilesN;
  const float* src = p.in[XJOB[j][0]] + (size_t)XJOB[j][1] * 1024;
  bf16_t* dst = (bf16_t*)(p.ws + xjob_dst(j)) + (size_t)XJOB[j][4] * K;
  xpose_core(src, N, dst, K, tk * 128, tn * 128, fs, tid);
}
__device__ __forceinline__ void xpose_core(const float* src, int N, bf16_t* dst, int K, int k0, int n0, float* fs, int tid) {
  { const int nn = (tid & 31) * 4, kr = tid >> 5; f32x4 v[8];
#pragma unroll
    for (int q = 0; q < 8; ++q) v[q] = (n0 + nn < N) ? *(const f32x4*)(src + (size_t)(k0 + kr + 16 * q) * N + n0 + nn) : (f32x4){0.f, 0.f, 0.f, 0.f};
#pragma unroll
    for (int q = 0; q < 8; ++q) { float* d = fs + (kr + 16 * q) * 129 + nn; d[0] = v[q][0]; d[1] = v[q][1]; d[2] = v[q][2]; d[3] = v[q][3]; } }
  __syncthreads();
  { const int nl = tid >> 4, kc = (tid & 15) * 8;
#pragma unroll
    for (int q = 0; q < 4; ++q) { const int n = nl + 32 * q;
      if (n0 + n < N) { float e[8];
#pragma unroll
        for (int i = 0; i < 8; ++i) e[i] = fs[(kc + i) * 129 + n];
        u32x4 w; w.x = cvt_pk_bf16(e[0], e[1]); w.y = cvt_pk_bf16(e[2], e[3]); w.z = cvt_pk_bf16(e[4], e[5]); w.w = cvt_pk_bf16(e[6], e[7]);
        *(u32x4*)(dst + (size_t)(n0 + n) * K + k0 + kc) = w; } } }
}
__device__ __forceinline__ void xpose_deferred(const Params& p, char* shm, int lo, int hi, int c0) {
  if ((int)blockIdx.x < c0) return;
  const int tid = otid();
  for (int t = lo + (int)blockIdx.x - c0; t < hi; t += (int)gridDim.x - c0) { __syncthreads(); xpose_tile(p, t, (float*)shm, tid); }
}

__device__ __forceinline__ void phase0(const Params& p, char* shm) {
  const int tid = otid();
  float* fs = (float*)shm;
  bool cond_ready = false;
  const int n_xt0 = (gridDim.x == 256) ? N_EARLY : N_XT;
  const int T0_TOTAL = N_GEMV + n_xt0 + 32 + 1 + 1;
  for (int it = 0; ; ++it) {
    int task;
    if (gridDim.x == 256) {
      const int c = blockIdx.x;
      if (c < 192) { if (it == 0) task = c; else if (it == 1 && c < 34) task = N_GEMV + n_xt0 + c; else break; }
      else { if (it < 10) task = N_GEMV + (c - 192) * 10 + it; else break; }
    } else { task = blockIdx.x + it * gridDim.x; if (task >= T0_TOTAL) break; }
    __syncthreads();
    if (task < N_GEMV) {
      float* condS = fs;
      float* red = fs + 9 * 2048;
      if (!cond_ready) {
        for (int i = tid; i < 9 * 2048; i += 512) { const int r = i >> 11, k = i & 2047; const float v = r < 8 ? p.in[1][r * 2048 + k] : p.in[3][k]; condS[i] = v / (1.f + __expf(-v)); }
        cond_ready = true;
        __syncthreads();
      }
      const int l = task / 96, col0 = (task % 96) * 128;
      const int cp = (tid & 63) * 2, ks = tid >> 6;
      const float* W = p.in[4] + ((size_t)l * 2048 + ks * 256) * NMOD6 + col0 + cp;
      float a0[9], a1[9];
#pragma unroll
      for (int r = 0; r < 9; ++r) { a0[r] = 0.f; a1[r] = 0.f; }
      const LAS float* condL = (const LAS float*)(LAS char*)shm;
      for (int k = 0; k < 256; k += 32) {
        f32x2 w[32];
#pragma unroll
        for (int u = 0; u < 32; ++u) w[u] = *(const f32x2*)(W + (size_t)(k + u) * NMOD6);
#pragma unroll
        for (int u4 = 0; u4 < 8; ++u4) {
#pragma unroll
          for (int r = 0; r < 9; ++r) { const f32x4 cv = *(const LAS f32x4*)(condL + r * 2048 + ks * 256 + k + 4 * u4);
#pragma unroll
            for (int e = 0; e < 4; ++e) { a0[r] = fmaf(cv[e], w[4 * u4 + e].x, a0[r]); a1[r] = fmaf(cv[e], w[4 * u4 + e].y, a1[r]); } }
        }
      }
#pragma unroll
      for (int r = 0; r < 9; ++r) { red[(ks * 9 + r) * 128 + cp] = a0[r]; red[(ks * 9 + r) * 128 + cp + 1] = a1[r]; }
      __syncthreads();
      float* modv = (float*)(p.ws + OFF_MODV);
      for (int i = tid; i < 9 * 128; i += 512) { const int r = i >> 7, c = i & 127; float s = 0.f;
#pragma unroll
        for (int q = 0; q < 8; ++q) s += red[(q * 9 + r) * 128 + c];
        modv[((size_t)l * 9 + r) * NMOD6 + col0 + c] = s + p.in[5][(size_t)l * NMOD6 + col0 + c]; }
    } else if (task < N_GEMV + n_xt0) {
      xpose_tile(p, task - N_GEMV, fs, tid);
    } else if (task < N_GEMV + n_xt0 + 32) {
      const int mi = task - (N_GEMV + n_xt0); const int blk = mi >> 2, d = (mi >> 1) & 1, g = mi & 1;
      xpose_core((g ? p.in[17] : p.in[15]) + ((size_t)d * 8 + blk) * 128 * 128, 128, (bf16_t*)(p.ws + OFF_WL) + ((size_t)blk * 512 + d * 256 + g * 128) * 128, 128, 0, 0, fs, tid);
    } else if (task == N_GEMV + n_xt0 + 32) {
      u32x4* z = (u32x4*)(p.ws + OFF_WD + (size_t)1088 * 2048 * 2);
      for (int i = tid; i < 192 * 2048 * 2 / 16; i += 512) z[i] = (u32x4){0u, 0u, 0u, 0u};
    } else {
      float* rt = (float*)(p.ws + OFF_ROPE);
      for (int i = tid; i < 1024; i += 512) { const int pos = i >> 4, f = i & 15; const float ang = (float)pos * p.inv[f]; rt[2 * i] = cosf(ang); rt[2 * i + 1] = sinf(ang); }
    }
  }
}

template <int MODE, bool FIX, bool LAT_F32, bool CTX_F32>
__device__ __forceinline__ void norm_rows(const void* src_lat, const void* src_ctx, int nrows, const float* gain, const float* shift, const float* scale, void* dst,
                                          bf16_t* xfix = nullptr, const float* part = nullptr) {
  const int tid_ = otid(); const int lane = tid_ & 63, wv = tid_ >> 6;
  f32x4 g[4][2];
#pragma unroll
  for (int i = 0; i < 4; ++i) { g[i][0] = *(const f32x4*)(gain + i * 512 + lane * 8); g[i][1] = *(const f32x4*)(gain + i * 512 + lane * 8 + 4); }
  for (int row = blockIdx.x * 8 + wv; row < nrows; row += gridDim.x * 8) {
    f32x4 v[4][2];
    const bool islat = row < ML;
    const bool f32src = islat ? LAT_F32 : CTX_F32;
    const void* sp = islat ? src_lat : src_ctx;
    if (f32src) { const float* s = (const float*)sp + (size_t)row * DM + lane * 8;
#pragma unroll
      for (int i = 0; i < 4; ++i) { v[i][0] = *(const f32x4*)(s + i * 512); v[i][1] = *(const f32x4*)(s + i * 512 + 4); } }
    else { const bf16_t* s = (const bf16_t*)sp + (size_t)row * DM + lane * 8;
#pragma unroll
      for (int i = 0; i < 4; ++i) { const u32x4 w = *(const u32x4*)(s + i * 512);
        v[i][0] = (f32x4){bflo(w.x), bfhi(w.x), bflo(w.y), bfhi(w.y)}; v[i][1] = (f32x4){bflo(w.z), bfhi(w.z), bflo(w.w), bfhi(w.w)}; } }
    if constexpr (FIX) { if (!islat) {
      const float* pp = part + (size_t)(row - ML) * DM + lane * 8;
#pragma unroll
      for (int q = 0; q < 4; ++q)
#pragma unroll
        for (int i = 0; i < 4; ++i) { v[i][0] += *(const f32x4*)(pp + (size_t)q * MC * DM + i * 512); v[i][1] += *(const f32x4*)(pp + (size_t)q * MC * DM + i * 512 + 4); }
#pragma unroll
      for (int i = 0; i < 4; ++i) { u32x4 o; o.x = cvt_pk_bf16(v[i][0][0], v[i][0][1]); o.y = cvt_pk_bf16(v[i][0][2], v[i][0][3]); o.z = cvt_pk_bf16(v[i][1][0], v[i][1][1]); o.w = cvt_pk_bf16(v[i][1][2], v[i][1][3]);
        *(u32x4*)(xfix + (size_t)row * DM + i * 512 + lane * 8) = o;
        v[i][0] = (f32x4){bflo(o.x), bfhi(o.x), bflo(o.y), bfhi(o.y)}; v[i][1] = (f32x4){bflo(o.z), bfhi(o.z), bflo(o.w), bfhi(o.w)}; } } }
    float ss = 0.f;
#pragma unroll
    for (int i = 0; i < 4; ++i)
#pragma unroll
      for (int h = 0; h < 2; ++h) ss += v[i][h][0] * v[i][h][0] + v[i][h][1] * v[i][h][1] + v[i][h][2] * v[i][h][2] + v[i][h][3] * v[i][h][3];
    ss = wave_sum(ss);
    const float rstd = rsqrtf(ss * (1.f / DM) + 1e-6f);
    if constexpr (MODE == 0) {
      const int b = islat ? (row >> 11) : 8;
      const float* sh = shift + (size_t)b * NMOD6 + lane * 8; const float* sc = scale + (size_t)b * NMOD6 + lane * 8;
      bf16_t* d = (bf16_t*)dst + (size_t)row * DM + lane * 8;
#pragma unroll
      for (int i = 0; i < 4; ++i) { f32x4 y[2];
#pragma unroll
        for (int h = 0; h < 2; ++h) { const f32x4 a = *(const f32x4*)(sh + i * 512 + 4 * h), c = *(const f32x4*)(sc + i * 512 + 4 * h);
          y[h] = v[i][h] * rstd * g[i][h]; y[h] = y[h] * (c + 1.f) + a; }
        u32x4 o; o.x = cvt_pk_bf16(y[0][0], y[0][1]); o.y = cvt_pk_bf16(y[0][2], y[0][3]); o.z = cvt_pk_bf16(y[1][0], y[1][1]); o.w = cvt_pk_bf16(y[1][2], y[1][3]);
        *(u32x4*)(d + i * 512) = o; }
    } else {
      float* d = (float*)dst + (size_t)row * DM + lane * 8;
#pragma unroll
      for (int i = 0; i < 4; ++i) { *(f32x4*)(d + i * 512) = v[i][0] * rstd * g[i][0]; *(f32x4*)(d + i * 512 + 4) = v[i][1] * rstd * g[i][1]; }
    }
  }
}

__device__ __forceinline__ void mla_norm_rows(const Params& p) {
  const int tid_ = otid(); const int lane = tid_ & 63, wv = tid_ >> 6;
  const bf16_t* QA = (const bf16_t*)(p.ws + OFF_QA); bf16_t* QN = (bf16_t*)(p.ws + OFF_QN); bf16_t* CK = (bf16_t*)(p.ws + OFF_CKVN); bf16_t* KPE = (bf16_t*)(p.ws + OFF_KPE);
  const float* rope = (const float*)(p.ws + OFF_ROPE);
  float gq[8], gk[8];
#pragma unroll
  for (int i = 0; i < 8; ++i) { gq[i] = p.in[22][lane * 8 + i]; gk[i] = p.in[24][lane * 8 + i]; }
  for (int row = blockIdx.x * 8 + wv; row < MT; row += gridDim.x * 8) {
    const bf16_t* s = QA + (size_t)row * 1280;
    const u32x4 cw = *(const u32x4*)(s + 512 + lane * 8);
    float c[8] = {bflo(cw.x), bfhi(cw.x), bflo(cw.y), bfhi(cw.y), bflo(cw.z), bfhi(cw.z), bflo(cw.w), bfhi(cw.w)};
    float ssc = 0.f;
#pragma unroll
    for (int i = 0; i < 8; ++i) ssc += c[i] * c[i];
    ssc = wave_sum(ssc);
    { const float rstd = rsqrtf(ssc * (1.f / 512.f) + 1e-6f); u32x4 w;
      w.x = cvt_pk_bf16(c[0] * rstd * gk[0], c[1] * rstd * gk[1]); w.y = cvt_pk_bf16(c[2] * rstd * gk[2], c[3] * rstd * gk[3]);
      w.z = cvt_pk_bf16(c[4] * rstd * gk[4], c[5] * rstd * gk[5]); w.w = cvt_pk_bf16(c[6] * rstd * gk[6], c[7] * rstd * gk[7]);
      *(u32x4*)(CK + (size_t)row * 512 + lane * 8) = w; }
    if (row < ML) {
      const u32x4 qw = *(const u32x4*)(s + lane * 8);
      float q[8] = {bflo(qw.x), bfhi(qw.x), bflo(qw.y), bfhi(qw.y), bflo(qw.z), bfhi(qw.z), bflo(qw.w), bfhi(qw.w)};
      float ssq = 0.f;
#pragma unroll
      for (int i = 0; i < 8; ++i) ssq += q[i] * q[i];
      ssq = wave_sum(ssq);
      const float rstd = rsqrtf(ssq * (1.f / 512.f) + 1e-6f); u32x4 w;
      w.x = cvt_pk_bf16(q[0] * rstd * gq[0], q[1] * rstd * gq[1]); w.y = cvt_pk_bf16(q[2] * rstd * gq[2], q[3] * rstd * gq[3]);
      w.z = cvt_pk_bf16(q[4] * rstd * gq[4], q[5] * rstd * gq[5]); w.w = cvt_pk_bf16(q[6] * rstd * gq[6], q[7] * rstd * gq[7]);
      *(u32x4*)(QN + (size_t)row * 512 + lane * 8) = w;
    }
    {
      const int l8 = lane & 7;
      const u32x4 kw = *(const u32x4*)(s + 1024 + l8 * 8);
      float k[8] = {bflo(kw.x), bfhi(kw.x), bflo(kw.y), bfhi(kw.y), bflo(kw.z), bfhi(kw.z), bflo(kw.w), bfhi(kw.w)};
      float o[8];
      if (row < ML) {
        const int tok = row & 2047; const int ax = l8 >> 2, half = (l8 >> 1) & 1; const int pos = ax == 0 ? (tok >> 6) : (tok & 63);
        const float* cs = rope + (size_t)(pos * 16 + (l8 & 1) * 8) * 2;
#pragma unroll
        for (int i = 0; i < 8; ++i) { const float other = __shfl_xor(k[i], 2, 64); const float co = cs[2 * i], si = cs[2 * i + 1];
          o[i] = half == 0 ? (k[i] * co - other * si) : (other * si + k[i] * co); }
      } else {
#pragma unroll
        for (int i = 0; i < 8; ++i) o[i] = k[i];
      }
      if (lane < 8) { u32x4 w; w.x = cvt_pk_bf16(o[0], o[1]); w.y = cvt_pk_bf16(o[2], o[3]); w.z = cvt_pk_bf16(o[4], o[5]); w.w = cvt_pk_bf16(o[6], o[7]);
        *(u32x4*)(KPE + (size_t)row * 64 + lane * 8) = w; }
    }
  }
}

constexpr int XCP = 136;
template <int REV, int EMIT>
__device__ __forceinline__ void lru_dir(const LAS bf16_t* XC, LAS float* HF, const bf16x8 (&Wr)[4], const bf16x8 (&Wi)[4], float ba, float bx, float sp8,
                                        float& carry, float& Atot, int tid, int wv, int fr, int fq, const LAS bf16_t* GE, bf16_t* Op,
                                        unsigned* SDp, const unsigned (&sd)[8][4]) {
  const int lane = fq * 16 + fr;
#pragma unroll
  for (int mm = 0; mm < 8; ++mm) {
    const int m = REV ? 7 - mm : mm;
    float av[4], uv[4];
    if constexpr (EMIT == 0) {
      f32x4 gr = {0.f, 0.f, 0.f, 0.f}, gi = {0.f, 0.f, 0.f, 0.f};
#pragma unroll
      for (int ks = 0; ks < 4; ++ks) {
        const bf16x8 a = *(const LAS bf16x8*)(XC + (16 * m + fr) * XCP + ks * 32 + fq * 8);
        gr = __builtin_amdgcn_mfma_f32_16x16x32_bf16(a, Wr[ks], gr, 0, 0, 0);
        gi = __builtin_amdgcn_mfma_f32_16x16x32_bf16(a, Wi[ks], gi, 0, 0, 0);
      }
#pragma unroll
      for (int j = 0; j < 4; ++j) {
        const float xc = bf2f(XC[(16 * m + 4 * fq + j) * XCP + 16 * wv + fr]);
        const float r = __builtin_amdgcn_rcpf(1.f + __expf(-(gr[j] + ba))), ig = __builtin_amdgcn_rcpf(1.f + __expf(-(gi[j] + bx)));
        const float la = -sp8 * r;
        const float a = __expf(la);
        av[j] = a;
        uv[j] = __builtin_amdgcn_sqrtf(fmaxf(fmaf(-a, a, 1.f), 0.f)) * (ig * xc);
        SDp[(size_t)(16 * m + 4 * fq + j) * 1024] = cvt_pk_bf16(la, uv[j]);
      }
    } else {
#pragma unroll
      for (int j = 0; j < 4; ++j) { av[j] = __expf(bflo(sd[m][j])); uv[j] = bfhi(sd[m][j]); }
    }
    float s[4], P[4];
    if (!REV) { s[0] = uv[0]; P[0] = av[0];
#pragma unroll
      for (int j = 1; j < 4; ++j) { s[j] = fmaf(av[j], s[j - 1], uv[j]); P[j] = av[j] * P[j - 1]; } }
    else { s[3] = uv[3]; P[3] = av[3];
#pragma unroll
      for (int j = 2; j >= 0; --j) { s[j] = fmaf(av[j], s[j + 1], uv[j]); P[j] = av[j] * P[j + 1]; } }
    float A = REV ? P[0] : P[3], U = REV ? s[0] : s[3];
    { const int src = REV ? lane + 16 : lane - 16; const float Ap = __shfl(A, src & 63, 64), Up = __shfl(U, src & 63, 64);
      const bool on = REV ? (fq <= 2) : (fq >= 1); if (on) { U = fmaf(A, Up, U); A = A * Ap; } }
    { const int src = REV ? lane + 32 : lane - 32; const float Ap = __shfl(A, src & 63, 64), Up = __shfl(U, src & 63, 64);
      const bool on = REV ? (fq <= 1) : (fq >= 2); if (on) { U = fmaf(A, Up, U); A = A * Ap; } }
    float Ae, Ue;
    { const int src = REV ? lane + 16 : lane - 16; Ae = __shfl(A, src & 63, 64); Ue = __shfl(U, src & 63, 64);
      const bool first = REV ? (fq == 3) : (fq == 0); if (first) { Ae = 1.f; Ue = 0.f; } }
    const float cr = fmaf(Ae, carry, Ue);
    if (EMIT == 1) {
#pragma unroll
      for (int j = 0; j < 4; ++j) HF[(m * 4 + j) * 512 + tid] = fmaf(P[j], cr, s[j]);
    }
    if (EMIT == 2) {
#pragma unroll
      for (int j = 0; j < 4; ++j) { const float hsum = HF[(m * 4 + j) * 512 + tid] + fmaf(P[j], cr, s[j]);
        const int tl = 16 * m + 4 * fq + j;
        const float ge = bf2f(GE[tl * XCP + 16 * wv + fr]);
        Op[(size_t)tl * DM] = (bf16_t)(cvt_pk_bf16(hsum * ge, 0.f) & 0xffffu); }
    }
    const int lastl = REV ? fr : 48 + fr;
    const float At = __shfl(A, lastl, 64), Ut = __shfl(U, lastl, 64);
    carry = fmaf(At, carry, Ut); Atot *= At;
  }
}

template <int PASS>
__device__ __forceinline__ void lru_task(const Params& p, int task, char* shm) {
  const int tid = otid(), lane = tid & 63, wv = tid >> 6, fr = lane & 15, fq = lane >> 4;
  const int ci = task % 18, blk = (task / 18) & 7, b = task / 144;
  const bf16_t* P = (const bf16_t*)(p.ws + OFF_P);
  LAS bf16_t* XC = (LAS bf16_t*)shm;
  LAS float* HF = (LAS float*)(shm + 128 * XCP * 2);
  LAS bf16_t* GE = (LAS bf16_t*)(shm + 128 * XCP * 2 + 32 * 512 * 4);
  const int L = ci < 2 ? 256 : 2048, tl0 = ci < 2 ? ci * 128 : (ci - 2) * 128;
  const size_t rowbase = ci < 2 ? (size_t)ML + b * 256 : (size_t)b * 2048;
  const int ch = blk * 128 + 16 * wv + fr;
  unsigned* SD0 = (unsigned*)(p.ws + OFF_X) + (rowbase + tl0) * 1024 + ch;
  unsigned* SD1 = SD0 + (size_t)MT * 1024;
  float* LS = (float*)(p.ws + OFF_LSUM) + (size_t)((b * 8 + blk) * 18) * 2 * 128 * 2;
  bf16_t* Op = (bf16_t*)(p.ws + OFF_MIX) + (rowbase + tl0) * DM + 1024 + ch;
  __syncthreads();
  if constexpr (PASS == 1) {
    {
      const int cg = tid & 15; const int ch0 = blk * 128 + cg * 8;
      float cw[4][8], cb[8];
#pragma unroll
      for (int e = 0; e < 8; ++e) { cb[e] = p.in[14][ch0 + e];
#pragma unroll
        for (int tp = 0; tp < 4; ++tp) cw[tp][e] = p.in[13][tp * 1024 + ch0 + e]; }
      u32x4 wld[4][4];
#pragma unroll
      for (int it = 0; it < 4; ++it)
#pragma unroll
        for (int tp = 0; tp < 4; ++tp) { const int tl = tl0 + (tid >> 4) + 32 * it + tp - 2; const int tlc = min(max(tl, 0), L - 1);
          wld[it][tp] = *(const u32x4*)(P + (rowbase + tlc) * ABIN + 3072 + ch0); }
#pragma unroll
      for (int it = 0; it < 4; ++it) { const int t = (tid >> 4) + 32 * it; float acc[8];
#pragma unroll
        for (int e = 0; e < 8; ++e) acc[e] = cb[e];
#pragma unroll
        for (int tp = 0; tp < 4; ++tp) { const int tl = tl0 + t + tp - 2; const bool ok = (tl >= 0 && tl < L);
          const u32x4 w = wld[it][tp];
          const float x[8] = {bflo(w.x), bfhi(w.x), bflo(w.y), bfhi(w.y), bflo(w.z), bfhi(w.z), bflo(w.w), bfhi(w.w)};
#pragma unroll
          for (int e = 0; e < 8; ++e) acc[e] = fmaf(cw[tp][e], ok ? x[e] : 0.f, acc[e]); }
        u32x4 o; o.x = cvt_pk_bf16(acc[0], acc[1]); o.y = cvt_pk_bf16(acc[2], acc[3]); o.z = cvt_pk_bf16(acc[4], acc[5]); o.w = cvt_pk_bf16(acc[6], acc[7]);
        *(LAS u32x4*)(XC + t * XCP + cg * 8) = o; }
    }
    __syncthreads();
    const bf16_t* WL = (const bf16_t*)(p.ws + OFF_WL) + (size_t)blk * 512 * 128;
    const unsigned nosd[8][4] = {};
#pragma unroll
    for (int d = 0; d < 2; ++d) {
      bf16x8 Wr[4], Wi[4];
#pragma unroll
      for (int ks = 0; ks < 4; ++ks) { Wr[ks] = *(const bf16x8*)(WL + (size_t)(256 * d + 16 * wv + fr) * 128 + ks * 32 + fq * 8); Wi[ks] = *(const bf16x8*)(WL + (size_t)(256 * d + 128 + 16 * wv + fr) * 128 + ks * 32 + fq * 8); }
      const float ba = p.in[16][1024 * d + ch], bx = p.in[18][1024 * d + ch]; const float lam = p.in[19][1024 * d + ch];
      const float sp8 = 8.f * (fmaxf(-lam, 0.f) + log1pf(__expf(-fabsf(lam))));
      float carry = 0.f, Atot = 1.f;
      if (d == 0) lru_dir<0, 0>(XC, HF, Wr, Wi, ba, bx, sp8, carry, Atot, tid, wv, fr, fq, GE, Op, SD0, nosd);
      else        lru_dir<1, 0>(XC, HF, Wr, Wi, ba, bx, sp8, carry, Atot, tid, wv, fr, fq, GE, Op, SD1, nosd);
      if (fq == 0) *(f32x2*)(LS + ((size_t)(ci * 2 + d) * 128 + 16 * wv + fr) * 2) = (f32x2){Atot, carry};
    }
  } else {
    unsigned sdf[8][4], sdr[8][4];
#pragma unroll
    for (int m = 0; m < 8; ++m)
#pragma unroll
      for (int j = 0; j < 4; ++j) { sdf[m][j] = SD0[(size_t)(16 * m + 4 * fq + j) * 1024]; sdr[m][j] = SD1[(size_t)(16 * m + 4 * fq + j) * 1024]; }
    {
      const int cg = tid & 15; const int ch0 = blk * 128 + cg * 8;
      u32x4 gl[4];
#pragma unroll
      for (int it = 0; it < 4; ++it) gl[it] = *(const u32x4*)(P + (rowbase + tl0 + (tid >> 4) + 32 * it) * ABIN + 4096 + ch0);
#pragma unroll
      for (int it = 0; it < 4; ++it) { const u32x4 w = gl[it];
        float x[8] = {bflo(w.x), bfhi(w.x), bflo(w.y), bfhi(w.y), bflo(w.z), bfhi(w.z), bflo(w.w), bfhi(w.w)};
#pragma unroll
        for (int e = 0; e < 8; ++e) { const float g = x[e]; const float z = 0.7978845608028654f * (g + 0.044715f * g * g * g); x[e] = g * __builtin_amdgcn_rcpf(1.f + __expf(-2.f * z)); }
        u32x4 o; o.x = cvt_pk_bf16(x[0], x[1]); o.y = cvt_pk_bf16(x[2], x[3]); o.z = cvt_pk_bf16(x[4], x[5]); o.w = cvt_pk_bf16(x[6], x[7]);
        *(LAS u32x4*)(GE + ((tid >> 4) + 32 * it) * XCP + cg * 8) = o; }
    }
    float carryF = 0.f, carryR = 0.f;
    { f32x2 su[17];
#pragma unroll
      for (int c2 = 0; c2 < 17; ++c2) su[c2] = (c2 < ci) ? *(const f32x2*)(LS + ((size_t)(c2 * 2 + 0) * 128 + 16 * wv + fr) * 2) : (f32x2){1.f, 0.f};
#pragma unroll
      for (int c2 = 0; c2 < 17; ++c2) carryF = fmaf(su[c2].x, carryF, su[c2].y); }
    { const int pos = ci < 2 ? (1 - ci) : (19 - ci);
      f32x2 su[17];
#pragma unroll
      for (int q = 0; q < 17; ++q) { const int c2 = q < 2 ? 1 - q : 19 - q; su[q] = (q < pos) ? *(const f32x2*)(LS + ((size_t)(c2 * 2 + 1) * 128 + 16 * wv + fr) * 2) : (f32x2){1.f, 0.f}; }
#pragma unroll
      for (int q = 0; q < 17; ++q) carryR = fmaf(su[q].x, carryR, su[q].y); }
    __syncthreads();
    const bf16x8 nw[4] = {};
    float At0 = 1.f, At1 = 1.f;
    lru_dir<0, 1>(XC, HF, nw, nw, 0.f, 0.f, 0.f, carryF, At0, tid, wv, fr, fq, GE, Op, SD0, sdf);
    lru_dir<1, 2>(XC, HF, nw, nw, 0.f, 0.f, 0.f, carryR, At1, tid, wv, fr, fq, GE, Op, SD1, sdr);
  }
}

__device__ __forceinline__ void na_task(const Params& p, int task, char* shm) {
  const int qb = task & 7, h = (task >> 3) & 7, b = task >> 6;
  const bf16_t* P = (const bf16_t*)(p.ws + OFF_P); bf16_t* MIX = (bf16_t*)(p.ws + OFF_MIX);
  __syncthreads();
  { float* tb = (float*)(shm + 2 * att::SHM_V + 2 * (64 * 128 * 2) + att::NW * 256) + 64;
    for (int i = otid(); i < 15 * 31; i += 512) tb[i] = p.in[12][h * 465 + i] * 11.313708498984761f; }
  att::Job J;
  J.Qb = P + (size_t)(b * 2048 + qb * 256) * ABIN + h * 128; J.ldq = ABIN;
  J.Kb = P + 1024 + h * 128; J.Vb = P + 2048 + h * 128; J.ldk = ABIN; J.Pe = nullptr;
  J.Ob = MIX + (size_t)(b * 2048 + qb * 256) * DM + h * 128; J.ldo = DM;
  const int r0 = qb * 4; const int lo = min(max(r0 - 4, 0), 24), hiw = min(max(r0 - 1, 0), 24) + 7;
  J.lo = lo; J.nwin = hiw - lo + 1; J.qb4 = r0;
  J.nA = 4; J.rowA = ML + b * 256; J.rowB = b * 2048 + lo * 64;
  J.NT = (4 + J.nwin + 1) & ~1;
  J.rope = nullptr; J.tok0 = 0;
  __syncthreads();
  att::attn_body<0>(J, shm);
}
__device__ __forceinline__ void ctxattn_task(const Params& p, int task, char* shm) {
  const int h = task & 7, b = task >> 3;
  const bf16_t* P = (const bf16_t*)(p.ws + OFF_P); bf16_t* MIX = (bf16_t*)(p.ws + OFF_MIX);
  __syncthreads();
  att::Job J;
  J.Qb = P + (size_t)(ML + b * 256) * ABIN + h * 128; J.ldq = ABIN;
  J.Kb = P + 1024 + h * 128; J.Vb = P + 2048 + h * 128; J.ldk = ABIN; J.Pe = nullptr;
  J.Ob = MIX + (size_t)(ML + b * 256) * DM + h * 128; J.ldo = DM;
  J.NT = 4; J.nA = 4; J.rowA = ML + b * 256; J.rowB = 0; J.qb4 = 0; J.lo = 0; J.nwin = 0; J.rope = nullptr; J.tok0 = 0;
  att::attn_body<1>(J, shm);
}
__device__ __forceinline__ void mla_task(const Params& p, int task, char* shm) {
  const int qb = task & 7, h = (task >> 3) & 15, b = task >> 7;
  const bf16_t* Q = (const bf16_t*)(p.ws + OFF_Q); const bf16_t* KV = (const bf16_t*)(p.ws + OFF_KV); bf16_t* ATT = (bf16_t*)(p.ws + OFF_H);
  __syncthreads();
  att::Job J;
  J.Qb = Q + (size_t)(b * 2048 + qb * 256) * 3072 + h * 192; J.ldq = 3072;
  J.Kb = KV + h * 256; J.Vb = KV + h * 256 + 128; J.ldk = 4096; J.Pe = (const bf16_t*)(p.ws + OFF_KPE);
  J.Ob = ATT + (size_t)(b * 2048 + qb * 256) * DM + h * 128; J.ldo = DM;
  J.NT = 36; J.nA = 32; J.rowA = b * 2048; J.rowB = ML + b * 256; J.qb4 = 0; J.lo = 0; J.nwin = 0;
  J.rope = (const float*)(p.ws + OFF_ROPE); J.tok0 = qb * 256;
  att::attn_body<2>(J, shm);
}

#define XB_TMO      128
#define XB_XCNT(j)  (256  + 64 * (j))
#define XB_XSUB(j)  (1280 + 64 * (j))
#define XB_XGEN(j)  (2304 + 64 * (j))
#define XB_TOP      3328
#define XB_TOPGEN   3392
#define XCD_BAR_WORDS 3456
#define XB_SPIN_CAP (1u << 18)
__device__ __forceinline__ unsigned xb_ld(unsigned* p)              { return __hip_atomic_load(p, __ATOMIC_RELAXED, __HIP_MEMORY_SCOPE_AGENT); }
__device__ __forceinline__ unsigned xb_add(unsigned* p, unsigned v) { return __hip_atomic_fetch_add(p, v, __ATOMIC_RELAXED, __HIP_MEMORY_SCOPE_AGENT); }
__device__ __forceinline__ unsigned xb_xcc_id() { return (unsigned)__builtin_amdgcn_s_getreg((3 << 11) | 20) & 0xFu; }
#define XB_SPIN(cond, bar) do { unsigned _sp = 0; while (cond) { __builtin_amdgcn_s_sleep(1); \
    if ((++_sp & 255u) == 0u) { if (xb_ld(&(bar)[XB_TMO])) break; if (_sp > XB_SPIN_CAP) { atomicAdd(&(bar)[XB_TMO], 1u); break; } } } } while (0)
struct XcdBarrier { unsigned* bar; unsigned x; volatile LAS unsigned* st; };
__device__ __forceinline__ XcdBarrier xcd_barrier_post(unsigned* bar, volatile LAS unsigned* st) {
  XcdBarrier b; b.bar = bar; b.x = xb_xcc_id(); b.st = st;
  if (threadIdx.x == 0) (void)xb_add(&bar[XB_XCNT(b.x)], 1u);
  return b;
}
__device__ __forceinline__ void xcd_barrier_complete(unsigned* bar, unsigned x, unsigned& nloc, unsigned& nx) {
  const unsigned G = gridDim.x * gridDim.y * gridDim.z;
  unsigned sum, cnt, mine, sp = 0u;
  for (;;) {
    sum = 0u; cnt = 0u; mine = 0u;
#pragma unroll
    for (unsigned j = 0; j < 16; ++j) { const unsigned c = xb_ld(&bar[XB_XCNT(j)]); sum += c; cnt += (c > 0u) ? 1u : 0u; mine = (j == x) ? c : mine; }
    if (sum == G) break;
    __builtin_amdgcn_s_sleep(1);
    if ((++sp & 255u) == 0u) { if (xb_ld(&bar[XB_TMO])) break; if (sp > XB_SPIN_CAP) { atomicAdd(&bar[XB_TMO], 1u); break; } }
  }
  nloc = mine > 0u ? mine : 1u; nx = cnt > 0u ? cnt : 1u;
}
__device__ __forceinline__ void xcd_barrier(const XcdBarrier& b) {
  asm volatile("s_waitcnt vmcnt(0)" ::: "memory");
  __syncthreads();
  if (threadIdx.x == 0) {
    unsigned* bar = b.bar;
    __builtin_amdgcn_s_waitcnt(0);
    unsigned nloc = b.st[0], nx = b.st[1];
    if (nloc == 0u) { xcd_barrier_complete(bar, b.x, nloc, nx); b.st[0] = nloc; b.st[1] = nx; }
    const unsigned old = xb_add(&bar[XB_XSUB(b.x)], 1u);
    const unsigned gen = old / nloc;
    if (old + 1u == (gen + 1u) * nloc) {
      __builtin_amdgcn_fence(__ATOMIC_RELEASE, "agent");
      asm volatile("s_waitcnt vmcnt(0)" ::: "memory");
      const unsigned og = xb_add(&bar[XB_TOP], 1u);
      const unsigned tg = og / nx;
      if (og + 1u == (tg + 1u) * nx) xb_add(&bar[XB_TOPGEN], 1u);
      else XB_SPIN(xb_ld(&bar[XB_TOPGEN]) == tg, bar);
      __builtin_amdgcn_fence(__ATOMIC_ACQUIRE, "agent");
      xb_add(&bar[XB_XGEN(b.x)], 1u);
      asm volatile("s_waitcnt vmcnt(0)" ::: "memory");
    } else {
      XB_SPIN(xb_ld(&bar[XB_XGEN(b.x)]) == gen, bar);
      __builtin_amdgcn_fence(__ATOMIC_ACQUIRE, "agent");
      asm volatile("s_waitcnt vmcnt(0)" ::: "memory");
    }
  }
  __syncthreads();
}

template <class Epi>
__device__ __forceinline__ void run_gemm(char* shm, const bf16_t* A, int lda, const bf16_t* Bt, int ldb, int K, int nM, int nN, const Epi& E, int krev = 0) {
  pg8::Gemm g; g.A = A; g.Bt = Bt; g.lda = lda; g.ldb = ldb; g.K = K; g.nM = nM; g.nN = nN; g.krev = krev;
  pg8::StaticOrder S; S.init(nM, nN, gridDim.x, blockIdx.x); S.kmode = krev;
  __syncthreads();
  pg8::gemm_phase<Epi, pg8::StaticOrder>((LAS unsigned char*)shm, g, S, E);
}
template <class Epi>
__device__ __forceinline__ void run_gemm_split(char* shm, const bf16_t* A, int lda, const bf16_t* Bt, int ldb, int K, int pm0, int nMs, int nN, int NS, const Epi& E, int krev = 0) {
  pg8::Gemm g; g.A = A; g.Bt = Bt; g.lda = lda; g.ldb = ldb; g.K = K / NS; g.nM = nMs; g.nN = nN; g.krev = krev;
  pg8::SplitOrder S; S.init(pm0, nMs, nN, NS, K / NS, gridDim.x, blockIdx.x); S.kmode = krev;
  __syncthreads();
  pg8::gemm_phase<Epi, pg8::SplitOrder>((LAS unsigned char*)shm, g, S, E);
}

#ifndef NO_MEGA
__global__ void __launch_bounds__(512, 2) fwd_megakernel(Params p) {
  extern __shared__ __attribute__((aligned(16))) char shm[];
  cg::grid_group grid = cg::this_grid();
  char* ws = p.ws;
  const float* modv = (const float*)(ws + OFF_MODV);
  bf16_t* X = (bf16_t*)(ws + OFF_X);
  bf16_t* H = (bf16_t*)(ws + OFF_H);

  volatile LAS unsigned* xst = (volatile LAS unsigned*)((LAS char*)shm + (LDS_BYTES - 16));
  if (threadIdx.x == 0) { xst[0] = 0u; xst[1] = 0u; }
  __syncthreads();
  const XcdBarrier xbar = xcd_barrier_post((unsigned*)(ws + OFF_BAR), xst);
  phase0(p, shm);
  grid.sync();
  norm_rows<0, false, true, true>(p.in[0], p.in[2] - (size_t)ML * DM, MT, p.in[6], modv + 0 * DM, modv + 1 * DM, H);
  xcd_barrier(xbar);
  { pg8::EpiBf16<0> E; E.O = (bf16_t*)(ws + OFF_P); E.ldc = ABIN;
    run_gemm(shm, H, DM, (const bf16_t*)(ws + OFF_WIN), DM, DM, MT / 256, ABIN / 256, E); }
  if (gridDim.x == 256) xpose_deferred(p, shm, N_EARLY, N_SLOTA_END, 160);
  xcd_barrier(xbar);
  { const int nxb = (gridDim.x == 256) ? (N_SLOTB_END - N_SLOTA_END) : 0;
    const int tid0 = otid();
    for (int t = blockIdx.x; t < 512 + 64 + 1152 + nxb; t += gridDim.x) {
      if (t < 512) na_task(p, t, shm);
      else if (t < 576) ctxattn_task(p, t - 512, shm);
      else if (t < 1728) lru_task<1>(p, t - 576, shm);
      else { __syncthreads(); xpose_tile(p, N_SLOTA_END + (t - 1728), (float*)shm, tid0); }
    } }
  xcd_barrier(xbar);
  for (int t = blockIdx.x; t < 1152; t += gridDim.x) lru_task<2>(p, t, shm);
  xcd_barrier(xbar);
  { pg8::EpiResid<true> E; E.xin = p.in[0]; E.xout = X; E.gate = modv + 2 * DM;
    run_gemm(shm, (const bf16_t*)(ws + OFF_MIX), DM, (const bf16_t*)(ws + OFF_WOUT), DM, DM, ML / 256, DM / 256, E); }
  { pg8::EpiPartial E; E.part = (float*)(ws + OFF_PART); E.gate = modv + 2 * DM; E.kp2 = (DM / 4) * 2;
    run_gemm_split(shm, (const bf16_t*)(ws + OFF_MIX), DM, (const bf16_t*)(ws + OFF_WOUT), DM, DM, ML / 256, MC / 256, DM / 256, 4, E); }
  xcd_barrier(xbar);
  norm_rows<0, true, false, true>(X, p.in[2] - (size_t)ML * DM, MT, p.in[7], modv + 3 * DM, modv + 4 * DM, H, X, (const float*)(ws + OFF_PART));
  xcd_barrier(xbar);
  { pg8::EpiBf16<1> E; E.O = (bf16_t*)(ws + OFF_HID); E.ldc = DFF;
    run_gemm(shm, H, DM, (const bf16_t*)(ws + OFF_W1), DM, DM, MT / 256, DFF / 256, E); }
  xcd_barrier(xbar);
  { pg8::EpiResid<false> E; E.xin = X; E.xout = X; E.gate = modv + 5 * DM;
    run_gemm(shm, (const bf16_t*)(ws + OFF_HID), DFF, (const bf16_t*)(ws + OFF_W2), DFF, DFF, ML / 256, DM / 256, E, 2); }
  { pg8::EpiPartial E; E.part = (float*)(ws + OFF_PART); E.gate = modv + 5 * DM; E.kp2 = (DFF / 4) * 2;
    run_gemm_split(shm, (const bf16_t*)(ws + OFF_HID), DFF, (const bf16_t*)(ws + OFF_W2), DFF, DFF, ML / 256, MC / 256, DM / 256, 4, E, 1); }
  xcd_barrier(xbar);
  const float* modv1 = modv + (size_t)9 * NMOD6;
  norm_rows<0, true, false, false>(X, X, MT, p.in[6] + DM, modv1 + 0 * DM, modv1 + 1 * DM, H, X, (const float*)(ws + OFF_PART));
  xcd_barrier(xbar);
  { pg8::EpiBf16<0> E; E.O = (bf16_t*)(ws + OFF_QA); E.ldc = 1280;
    run_gemm(shm, H, DM, (const bf16_t*)(ws + OFF_WD), DM, DM, MT / 256, 1280 / 256, E); }
  if (gridDim.x == 256) xpose_deferred(p, shm, N_SLOTB_END, N_XT, 104);
  xcd_barrier(xbar);
  mla_norm_rows(p);
  xcd_barrier(xbar);
  { pg8::EpiBf16<0> E; E.O = (bf16_t*)(ws + OFF_Q); E.ldc = 3072;
    run_gemm(shm, (const bf16_t*)(ws + OFF_QN), 512, (const bf16_t*)(ws + OFF_WUQ), 512, 512, ML / 256, 3072 / 256, E); }
  { pg8::EpiBf16<0> E; E.O = (bf16_t*)(ws + OFF_KV); E.ldc = 4096;
    run_gemm(shm, (const bf16_t*)(ws + OFF_CKVN), 512, (const bf16_t*)(ws + OFF_WUKV), 512, 512, MT / 256, 4096 / 256, E); }
  xcd_barrier(xbar);
  for (int t = blockIdx.x; t < 1024; t += gridDim.x) mla_task(p, t, shm);
  xcd_barrier(xbar);
  { pg8::EpiResid<false> E; E.xin = X; E.xout = X; E.gate = modv1 + 2 * DM;
    run_gemm(shm, H, DM, (const bf16_t*)(ws + OFF_WO), DM, DM, ML / 256, DM / 256, E); }
  xcd_barrier(xbar);
  norm_rows<0, false, false, false>(X, X, ML, p.in[7] + DM, modv1 + 3 * DM, modv1 + 4 * DM, H);
  xcd_barrier(xbar);
  { pg8::EpiBf16<1> E; E.O = (bf16_t*)(ws + OFF_HID); E.ldc = DFF;
    run_gemm(shm, H, DM, (const bf16_t*)(ws + OFF_W1 + (size_t)8192 * 2048 * 2), DM, DM, ML / 256, DFF / 256, E); }
  xcd_barrier(xbar);
  { pg8::EpiResid<false> E; E.xin = X; E.xout = X; E.gate = modv1 + 5 * DM;
    run_gemm(shm, (const bf16_t*)(ws + OFF_HID), DFF, (const bf16_t*)(ws + OFF_W2 + (size_t)2048 * 8192 * 2), DFF, DFF, ML / 256, DM / 256, E, 2); }
  xcd_barrier(xbar);
  norm_rows<1, false, false, false>(X, X, ML, p.in[27], nullptr, nullptr, p.out);
}

extern "C" void kernel_launch(void* const* d_in, const int* in_sizes, int n_in, void* d_out, int out_size, void* d_ws, size_t ws_size, hipStream_t stream) {
  static int grid_blocks = 0;
  if (!grid_blocks) {
    if (n_in != 28 || ws_size < WS_NEED || out_size != ML * DM) { fprintf(stderr, "kernel_launch: unexpected shapes (n_in %d, ws %zu need %zu, out %d)\n", n_in, ws_size, (size_t)WS_NEED, out_size); return; }
    if (hipFuncSetAttribute((const void*)fwd_megakernel, hipFuncAttributeMaxDynamicSharedMemorySize, LDS_BYTES) != hipSuccess) { fprintf(stderr, "kernel_launch: LDS attribute failed\n"); return; }
    int dev = 0, cus = 0, per_cu = 0;
    hipGetDevice(&dev);
    hipDeviceGetAttribute(&cus, hipDeviceAttributeMultiprocessorCount, dev);
    hipOccupancyMaxActiveBlocksPerMultiprocessor(&per_cu, fwd_megakernel, 512, LDS_BYTES);
    if (per_cu < 1) { fprintf(stderr, "kernel_launch: occupancy query gave %d\n", per_cu); return; }
    grid_blocks = cus;
  }
  Params p{};
  for (int i = 0; i < 28; ++i) p.in[i] = (const float*)d_in[i];
  p.out = (float*)d_out; p.ws = (char*)d_ws;
  for (int i = 0; i < 16; ++i) p.inv[i] = (float)pow(10000.0, -(double)i / 16.0);
  hipMemsetAsync((char*)d_ws + OFF_BAR, 0, 16384, stream);
  void* args[] = {&p};
  hipError_t e = hipLaunchCooperativeKernel((void*)fwd_megakernel, dim3(grid_blocks), dim3(512), args, LDS_BYTES, stream);
  if (e != hipSuccess) fprintf(stderr, "cooperative launch failed: %s (grid %d)\n", hipGetErrorString(e), grid_blocks);
}
#endif
```
